# Optimizing an MI355X kernel written in HIP

```python
import jax, jax.numpy as jnp
from jax import lax
import numpy as np

D_MODEL = 1024
BATCH = 2
SEQ = 8192
DEPTH = 2

GRID_W = 64
CTX_LEN = 256
ROPE_BASE = 10000.0
Q_BLOCK = 128
DEEPNORM_ALPHA = (2 * DEPTH) ** 0.25
DEEPNORM_BETA = (8 * DEPTH) ** -0.25
LN_EPS = 1e-5

MLA_HEADS = 8
MLA_Q_RANK = 256
MLA_KV_RANK = 128
MLA_NOPE = 64
MLA_ROPE = 32
MLA_V = 64
MLA_IN = MLA_Q_RANK + MLA_KV_RANK + MLA_ROPE
MLA_OUT = MLA_HEADS * MLA_V

RWKV_HEADS = 8
RWKV_HEAD = 64
RWKV_DIM = RWKV_HEADS * RWKV_HEAD
RWKV_DECAY_LORA = 64
RWKV_AAA_LORA = 64
RWKV_GATE_LORA = 128
RWKV_IN = 3 * RWKV_DIM + 2 * RWKV_DECAY_LORA + 2 * RWKV_AAA_LORA + RWKV_GATE_LORA
RWKV_LNX_EPS = 64e-5

EVEN_IN = MLA_IN + RWKV_IN
EVEN_MIX = MLA_OUT + RWKV_DIM

RET_HEADS = 4
RET_KEY = 256
RET_VAL = 512
RET_CHUNK = 128
RET_QK = RET_HEADS * RET_KEY
RET_VD = RET_HEADS * RET_VAL
ODD_IN = 2 * RET_QK + 3 * RET_VD

D_FF = 2816
N_EXPERTS = 8
TOP_K = 2
D_FF_EXPERT = 3584
MOE_BLOCK = 128

kernel_name = 'hybrid_mla_rwkv7_retention_moe_block'


def _silu(t):
    return t * jax.nn.sigmoid(t)


def _normalize(t, eps):
    tf = t.astype(jnp.float32)
    mu = jnp.mean(tf, axis=-1, keepdims=True)
    var = jnp.mean(jnp.square(tf - mu), axis=-1, keepdims=True)
    return ((tf - mu) * lax.rsqrt(var + eps)).astype(t.dtype)


def _layer_norm(t, g, b):
    return _normalize(t, LN_EPS) * g + b


def _rms_norm(t, g, eps=1e-6):
    tf = t.astype(jnp.float32)
    return (tf * lax.rsqrt(jnp.mean(tf * tf, axis=-1, keepdims=True) + eps)).astype(t.dtype) * g


def _l2_normalize(t, eps=1e-12):
    tf = t.astype(jnp.float32)
    return (tf / jnp.maximum(jnp.linalg.norm(tf, axis=-1, keepdims=True), eps)).astype(t.dtype)


def _post_norm(x, update, g, b):
    return _layer_norm(DEEPNORM_ALPHA * x + update, g, b)


def _modulate(h, shift, scale):
    return h * (1.0 + scale) + shift


def _adaln(cond, mod_w, mod_b):
    return jnp.split(cond @ mod_w + mod_b, 6, axis=-1)


def _swiglu(h, w_gate, w_up, w_down):
    return (_silu(h @ w_gate) * (h @ w_up)) @ w_down


def _centred_conv3(t, w):
    tp = jnp.pad(t, ((0, 0), (1, 1), (0, 0)))
    return tp[:, :-2] * w[0] + tp[:, 1:-1] * w[1] + tp[:, 2:] * w[2]


def _grid_positions(n_tokens):
    rows = n_tokens // GRID_W
    row = jnp.repeat(jnp.arange(rows, dtype=jnp.float32), GRID_W)
    col = jnp.tile(jnp.arange(GRID_W, dtype=jnp.float32), rows)
    return row, col


def _rotate(t, pos):
    nf = t.shape[-1] // 2
    inv_freq = ROPE_BASE ** (-jnp.arange(nf, dtype=jnp.float32) / nf)
    ang = pos[:, None] * inv_freq[None, :]
    cos = jnp.cos(ang)[None, :, None, :].astype(t.dtype)
    sin = jnp.sin(ang)[None, :, None, :].astype(t.dtype)
    t1, t2 = t[..., :nf], t[..., nf:]
    return jnp.concatenate([t1 * cos - t2 * sin, t1 * sin + t2 * cos], axis=-1)


def _axial_rope(t, row, col):
    half = t.shape[-1] // 2
    return jnp.concatenate([_rotate(t[..., :half], row), _rotate(t[..., half:], col)], axis=-1)


def _block_attention(q, k, v):
    b, t, h, dq = q.shape
    nb = t // Q_BLOCK
    scale = dq ** -0.5
    qb = jnp.moveaxis(q.reshape(b, nb, Q_BLOCK, h, dq), 1, 0)

    def one_block(q_blk):
        s = jnp.einsum('bqhd,bkhd->bhqk', q_blk, k).astype(jnp.float32) * scale
        p = jax.nn.softmax(s, axis=-1).astype(v.dtype)
        return jnp.einsum('bhqk,bkhd->bqhd', p, v)

    ob = lax.map(one_block, qb)
    return jnp.moveaxis(ob, 0, 1).reshape(b, t, h, v.shape[-1])


def _mla_project(zz, q_norm, wq_up, kv_norm, wkv_up):
    b, t, _ = zz.shape
    cq, ckv, k_rope = jnp.split(zz, [MLA_Q_RANK, MLA_Q_RANK + MLA_KV_RANK], axis=-1)
    q = (_rms_norm(cq, q_norm) @ wq_up).reshape(b, t, MLA_HEADS, MLA_NOPE + MLA_ROPE)
    kv = (_rms_norm(ckv, kv_norm) @ wkv_up).reshape(b, t, MLA_HEADS, MLA_NOPE + MLA_V)
    return q, kv[..., :MLA_NOPE], k_rope[:, :, None, :], kv[..., MLA_NOPE:]


def _mla_keys(k_nope, k_rope):
    b, t, h, _ = k_nope.shape
    return jnp.concatenate([k_nope, jnp.broadcast_to(k_rope, (b, t, h, MLA_ROPE))], axis=-1)


def _mla_mixer(z, zc, q_norm, wq_up, kv_norm, wkv_up):
    b, t, _ = z.shape
    row, col = _grid_positions(t)
    q, k_nope, k_rope, v = _mla_project(z, q_norm, wq_up, kv_norm, wkv_up)
    qc, k_nope_c, k_rope_c, vc = _mla_project(zc, q_norm, wq_up, kv_norm, wkv_up)
    q = jnp.concatenate([q[..., :MLA_NOPE], _axial_rope(q[..., MLA_NOPE:], row, col)], axis=-1)
    k = _mla_keys(k_nope, _axial_rope(k_rope, row, col))
    kc = _mla_keys(k_nope_c, k_rope_c)
    o = _block_attention(q, jnp.concatenate([kc, k], axis=1), jnp.concatenate([vc, v], axis=1))
    oc = _block_attention(qc, kc, vc)
    return o.reshape(b, t, MLA_OUT), oc.reshape(b, zc.shape[1], MLA_OUT)


def _rwkv7_scan(s0, r, w, k, v, a, b, reverse):
    def step(s, xs):
        rt, wt, kt, vt, at, bt = xs
        sa = jnp.einsum('bhvk,bhk->bhv', s, at)
        s = s * wt[:, :, None, :] + sa[..., None] * bt[:, :, None, :] + vt[..., None] * kt[:, :, None, :]
        return s, jnp.einsum('bhvk,bhk->bhv', s, rt)

    xs = tuple(jnp.moveaxis(t.astype(jnp.float32), 1, 0) for t in (r, w, k, v, a, b))
    s_fin, y = lax.scan(step, s0, xs, reverse=reverse)
    return jnp.moveaxis(y, 0, 1), s_fin


def _rwkv7_features(z, conv_w, w0_f, w2_f, w0_b, w2_b, a0_f, a2_f, a0_b, a2_b, g2, k_k, k_a):
    b, t, _ = z.shape
    c0 = 3 * RWKV_DIM
    c1 = c0 + RWKV_DECAY_LORA
    c2 = c1 + RWKV_DECAY_LORA
    c3 = c2 + RWKV_AAA_LORA
    c4 = c3 + RWKV_AAA_LORA
    rkv_raw, wd_f, wd_b, ad_f, ad_b, gd = jnp.split(z, [c0, c1, c2, c3, c4], axis=-1)
    rkv = _centred_conv3(rkv_raw, conv_w)
    r, k, v = jnp.split(rkv, 3, axis=-1)
    g = jax.nn.sigmoid(gd) @ g2

    def heads(u):
        return u.reshape(b, t, RWKV_HEADS, RWKV_HEAD)

    kk = _l2_normalize(heads(k * k_k))

    def direction(wd, w0, w2, ad, a0, a2):
        logw = -jax.nn.softplus(-(w0 + jnp.tanh(wd) @ w2)) - 0.5
        decay = jnp.exp(-jnp.exp(logw.astype(jnp.float32)))
        lr = jax.nn.sigmoid(a0 + ad @ a2)
        kd = k * (1.0 + (lr - 1.0) * k_a)
        return heads(decay), heads(kd), heads(lr)

    fwd = direction(wd_f, w0_f, w2_f, ad_f, a0_f, a2_f)
    bwd = direction(wd_b, w0_b, w2_b, ad_b, a0_b, a2_b)
    return heads(r), heads(v), kk, g, fwd, bwd


def _rwkv7_readout(y_f, y_b, r, k_f, k_b, v, g, r_k, lnx_g, lnx_b):
    b, t = r.shape[:2]
    y = _normalize(y_f + y_b, RWKV_LNX_EPS).astype(r.dtype).reshape(b, t, RWKV_DIM) * lnx_g + lnx_b
    bonus = jnp.sum(r * (k_f + k_b) * r_k, axis=-1, keepdims=True) * v
    return (y + bonus.reshape(b, t, RWKV_DIM)) * g


def _rwkv7_mixer(z, zc, conv_w, w0_f, w2_f, w0_b, w2_b, a0_f, a2_f, a0_b, a2_b, g2, k_k, k_a,
                 r_k, lnx_g, lnx_b):
    p = (conv_w, w0_f, w2_f, w0_b, w2_b, a0_f, a2_f, a0_b, a2_b, g2, k_k, k_a)
    r, v, kk, g, (w_f, k_f, l_f), (w_b, k_b, l_b) = _rwkv7_features(z, *p)
    rc, vc, kkc, gc, (wc_f, kc_f, lc_f), (wc_b, kc_b, lc_b) = _rwkv7_features(zc, *p)
    s0 = jnp.zeros((zc.shape[0], RWKV_HEADS, RWKV_HEAD, RWKV_HEAD), jnp.float32)
    yc_f, sc_f = _rwkv7_scan(s0, rc, wc_f, kc_f, vc, -kkc, kkc * lc_f, reverse=False)
    yc_b, sc_b = _rwkv7_scan(s0, rc, wc_b, kc_b, vc, -kkc, kkc * lc_b, reverse=True)
    y_f, _ = _rwkv7_scan(sc_f, r, w_f, k_f, v, -kk, kk * l_f, reverse=False)
    y_b, _ = _rwkv7_scan(sc_b, r, w_b, k_b, v, -kk, kk * l_b, reverse=True)
    o = _rwkv7_readout(y_f, y_b, r, k_f, k_b, v, g, r_k, lnx_g, lnx_b)
    oc = _rwkv7_readout(yc_f, yc_b, rc, kc_f, kc_b, vc, gc, r_k, lnx_g, lnx_b)
    return o, oc


def _retention_chunkwise(q, k, v, gamma, s0):
    b, t, h, dk = q.shape
    dv = v.shape[-1]
    nc = t // RET_CHUNK
    log_g = jnp.log(gamma)
    pos = jnp.arange(RET_CHUNK, dtype=jnp.float32)
    rel = pos[:, None] - pos[None, :]
    intra = jnp.where(rel >= 0, jnp.exp(jnp.maximum(rel, 0.0)[None] * log_g[:, None, None]), 0.0)
    q_dec = jnp.exp((pos[:, None] + 1.0) * log_g[None, :])
    k_dec = jnp.exp((RET_CHUNK - 1.0 - pos[:, None]) * log_g[None, :])
    c_dec = jnp.exp(RET_CHUNK * log_g)

    def chunks(u):
        return jnp.moveaxis(u.astype(jnp.float32).reshape(b, nc, RET_CHUNK, h, u.shape[-1]), 1, 0)

    def step(s, xs):
        qi, ki, vi = xs
        att = jnp.einsum('bihd,bjhd->bhij', qi, ki) * intra
        o = (jnp.einsum('bhij,bjhe->bihe', att, vi)
             + jnp.einsum('bihd,bhde->bihe', qi * q_dec[None, :, :, None], s))
        s = s * c_dec[None, :, None, None] + jnp.einsum('bjhd,bjhe->bhde', ki * k_dec[None, :, :, None], vi)
        return s, o

    s_fin, o = lax.scan(step, s0, (chunks(q), chunks(k), chunks(v)))
    return jnp.moveaxis(o, 0, 1).reshape(b, t, h, dv).astype(q.dtype), s_fin


def _retention_state(k, v, gamma):
    n = k.shape[1]
    w = jnp.exp((n - 1.0 - jnp.arange(n, dtype=jnp.float32))[:, None] * jnp.log(gamma)[None, :])
    return jnp.einsum('blhd,lh,blhe->bhde', k.astype(jnp.float32), w, v.astype(jnp.float32))


def _retention_mixer(z, kc, vc, decay_f, decay_b):
    b, t, _ = z.shape
    row, col = _grid_positions(t)
    q, k, v, g_f, g_b = jnp.split(z, [RET_QK, 2 * RET_QK, 2 * RET_QK + RET_VD, 2 * RET_QK + 2 * RET_VD], axis=-1)
    q = _axial_rope(q.reshape(b, t, RET_HEADS, RET_KEY), row, col)
    k = _axial_rope(k.reshape(b, t, RET_HEADS, RET_KEY), row, col) * (RET_KEY ** -0.5)
    v = v.reshape(b, t, RET_HEADS, RET_VAL)
    kc = kc.reshape(b, kc.shape[1], RET_HEADS, RET_KEY) * (RET_KEY ** -0.5)
    vc = vc.reshape(b, vc.shape[1], RET_HEADS, RET_VAL)
    gamma_f = 1.0 - jnp.exp2(-decay_f.astype(jnp.float32))
    gamma_b = 1.0 - jnp.exp2(-decay_b.astype(jnp.float32))
    s_cf = _retention_state(kc, vc, gamma_f)
    s_cb = _retention_state(kc[:, ::-1], vc[:, ::-1], gamma_b)
    o_f, _ = _retention_chunkwise(q, k, v, gamma_f, s_cf)
    o_b, _ = _retention_chunkwise(q[:, ::-1], k[:, ::-1], v[:, ::-1], gamma_b, s_cb)
    o_b = o_b[:, ::-1]

    def group_norm(o):
        return _normalize(o, 1e-6).reshape(b, t, RET_VD)

    return _silu(g_f) * group_norm(o_f) + _silu(g_b) * group_norm(o_b)


def _moe_swiglu(h, router, w_gate, w_up, w_down):
    b, t, d = h.shape
    n = b * t
    hf = h.reshape(n, d)
    logits = (hf @ router).astype(jnp.float32)
    top_val, top_idx = lax.top_k(logits, TOP_K)
    gate = jax.nn.softmax(top_val, axis=-1)
    n_assign = n * TOP_K
    flat_e = top_idx.reshape(-1)
    order = jnp.argsort(flat_e)
    sorted_e = flat_e[order]
    sorted_tok = (order // TOP_K).astype(jnp.int32)
    sorted_gate = gate.reshape(-1)[order]
    counts = jnp.zeros((N_EXPERTS,), jnp.int32).at[flat_e].add(1)
    padded = (counts + MOE_BLOCK - 1) // MOE_BLOCK * MOE_BLOCK
    pad_end = jnp.cumsum(padded)
    pad_start = pad_end - padded
    start = jnp.cumsum(counts) - counts
    dest = pad_start[sorted_e] + jnp.arange(n_assign, dtype=jnp.int32) - start[sorted_e]
    n_blocks = n_assign // MOE_BLOCK + N_EXPERTS
    slots = n_blocks * MOE_BLOCK
    slot_tok = jnp.full((slots,), n, jnp.int32).at[dest].set(sorted_tok)
    slot_gate = jnp.zeros((slots,), jnp.float32).at[dest].set(sorted_gate)
    block_start = jnp.arange(n_blocks, dtype=jnp.int32) * MOE_BLOCK
    block_expert = jnp.minimum(jnp.sum(pad_end[None, :] <= block_start[:, None], axis=1), N_EXPERTS - 1)
    h_pad = jnp.concatenate([hf, jnp.zeros((1, d), hf.dtype)], axis=0)
    xb = h_pad[slot_tok].reshape(n_blocks, MOE_BLOCK, d)

    def expert_block(args):
        x_blk, e = args
        return _swiglu(x_blk, w_gate[e], w_up[e], w_down[e])

    yb = lax.map(expert_block, (xb, block_expert)).reshape(slots, d)
    out = jnp.zeros((n + 1, d), jnp.float32).at[slot_tok].add(yb.astype(jnp.float32) * slot_gate[:, None])
    return out[:n].astype(h.dtype).reshape(b, t, d)


def _even_layer(x, xc, sc, scc, mod_w, mod_b, w_in, mla_q_norm, mla_wq_up, mla_kv_norm, mla_wkv_up,
                rwkv_conv, rwkv_w0_f, rwkv_w2_f, rwkv_w0_b, rwkv_w2_b, rwkv_a0_f, rwkv_a2_f, rwkv_a0_b,
                rwkv_a2_b, rwkv_g2, rwkv_k_k, rwkv_k_a, rwkv_r_k, rwkv_lnx_g, rwkv_lnx_b, w_out,
                ln1_g, ln1_b, ffn_w_gate, ffn_w_up, ffn_w_down, ln2_g, ln2_b):
    m = [u[:, None, :] for u in _adaln(sc, mod_w, mod_b)]
    mc = _adaln(scc, mod_w, mod_b)
    z = _modulate(x, m[0], m[1]) @ w_in
    zc = _modulate(xc, mc[0], mc[1]) @ w_in
    o_mla, oc_mla = _mla_mixer(z[..., :MLA_IN], zc[..., :MLA_IN],
                               mla_q_norm, mla_wq_up, mla_kv_norm, mla_wkv_up)
    o_rwkv, oc_rwkv = _rwkv7_mixer(z[..., MLA_IN:], zc[..., MLA_IN:], rwkv_conv, rwkv_w0_f, rwkv_w2_f,
                                   rwkv_w0_b, rwkv_w2_b, rwkv_a0_f, rwkv_a2_f, rwkv_a0_b, rwkv_a2_b,
                                   rwkv_g2, rwkv_k_k, rwkv_k_a, rwkv_r_k, rwkv_lnx_g, rwkv_lnx_b)
    o = jnp.concatenate([o_mla, o_rwkv], axis=-1) @ w_out
    oc = jnp.concatenate([oc_mla, oc_rwkv], axis=-1) @ w_out
    x = _post_norm(x, m[2] * o, ln1_g, ln1_b)
    xc = _post_norm(xc, mc[2] * oc, ln1_g, ln1_b)
    x = _post_norm(x, m[5] * _swiglu(_modulate(x, m[3], m[4]), ffn_w_gate, ffn_w_up, ffn_w_down), ln2_g, ln2_b)
    xc = _post_norm(xc, mc[5] * _swiglu(_modulate(xc, mc[3], mc[4]), ffn_w_gate, ffn_w_up, ffn_w_down),
                    ln2_g, ln2_b)
    return x, xc


def _odd_layer(x, xc, sc, scc, mod_w, mod_b, w_in, ret_decay_f, ret_decay_b, w_out, ln1_g, ln1_b,
               router, moe_w_gate, moe_w_up, moe_w_down, ln2_g, ln2_b):
    m = [u[:, None, :] for u in _adaln(sc, mod_w, mod_b)]
    c_shift, c_scale = jnp.split(scc @ mod_w[:, :2 * D_MODEL] + mod_b[:2 * D_MODEL], 2)
    z = _modulate(x, m[0], m[1]) @ w_in
    zc = _modulate(xc, c_shift, c_scale) @ w_in[:, RET_QK:2 * RET_QK + RET_VD]
    kc, vc = jnp.split(zc, [RET_QK], axis=-1)
    o = _retention_mixer(z, kc, vc, ret_decay_f, ret_decay_b) @ w_out
    x = _post_norm(x, m[2] * o, ln1_g, ln1_b)
    y = _moe_swiglu(_modulate(x, m[3], m[4]), router, moe_w_gate, moe_w_up, moe_w_down)
    return _post_norm(x, m[5] * y, ln2_g, ln2_b)


def setup_inputs(seed: int = 0) -> dict:
    key = jax.random.key(seed)
    ks = jax.random.split(key, 64)
    counter = iter(range(64))

    def nrm(shape, scale):
        return scale * jax.random.normal(ks[next(counter)], shape, jnp.float32)

    def uni(shape, lo, hi):
        return jax.random.uniform(ks[next(counter)], shape, jnp.float32, lo, hi)

    def gain(n):
        return 1.0 + nrm((n,), 0.1)

    def bias(n):
        return nrm((n,), 0.01)

    d = D_MODEL
    d_inv = d ** -0.5
    return {
        'x': nrm((BATCH, SEQ, d), 1.0),
        'c': nrm((BATCH, d), 1.0),
        'ctx': nrm((BATCH, CTX_LEN, d), 1.0),
        'c_ctx': nrm((d,), 1.0),
        'l0_mod_w': nrm((d, 6 * d), 0.5 * d_inv),
        'l0_mod_b': nrm((6 * d,), 0.02),
        'l0_w_in': nrm((d, EVEN_IN), d_inv),
        'l0_mla_q_norm': gain(MLA_Q_RANK),
        'l0_mla_wq_up': nrm((MLA_Q_RANK, MLA_HEADS * (MLA_NOPE + MLA_ROPE)), MLA_Q_RANK ** -0.5),
        'l0_mla_kv_norm': gain(MLA_KV_RANK),
        'l0_mla_wkv_up': nrm((MLA_KV_RANK, MLA_HEADS * (MLA_NOPE + MLA_V)), MLA_KV_RANK ** -0.5),
        'l0_rwkv_conv': jnp.array([[0.15], [1.0], [0.15]], jnp.float32) + nrm((3, 3 * RWKV_DIM), 0.05),
        'l0_rwkv_w0_f': uni((RWKV_DIM,), -2.5, 0.5),
        'l0_rwkv_w2_f': nrm((RWKV_DECAY_LORA, RWKV_DIM), 0.5 * RWKV_DECAY_LORA ** -0.5),
        'l0_rwkv_w0_b': uni((RWKV_DIM,), -2.5, 0.5),
        'l0_rwkv_w2_b': nrm((RWKV_DECAY_LORA, RWKV_DIM), 0.5 * RWKV_DECAY_LORA ** -0.5),
        'l0_rwkv_a0_f': nrm((RWKV_DIM,), 0.5),
        'l0_rwkv_a2_f': nrm((RWKV_AAA_LORA, RWKV_DIM), 0.5 * RWKV_AAA_LORA ** -0.5),
        'l0_rwkv_a0_b': nrm((RWKV_DIM,), 0.5),
        'l0_rwkv_a2_b': nrm((RWKV_AAA_LORA, RWKV_DIM), 0.5 * RWKV_AAA_LORA ** -0.5),
        'l0_rwkv_g2': nrm((RWKV_GATE_LORA, RWKV_DIM), RWKV_GATE_LORA ** -0.5),
        'l0_rwkv_k_k': 0.85 + nrm((RWKV_DIM,), 0.1),
        'l0_rwkv_k_a': gain(RWKV_DIM),
        'l0_rwkv_r_k': nrm((RWKV_HEADS, RWKV_HEAD), 0.1),
        'l0_rwkv_lnx_g': gain(RWKV_DIM),
        'l0_rwkv_lnx_b': bias(RWKV_DIM),
        'l0_w_out': nrm((EVEN_MIX, d), EVEN_MIX ** -0.5 * DEEPNORM_BETA),
        'l0_ln1_g': gain(d),
        'l0_ln1_b': bias(d),
        'l0_ffn_w_gate': nrm((d, D_FF), d_inv),
        'l0_ffn_w_up': nrm((d, D_FF), d_inv),
        'l0_ffn_w_down': nrm((D_FF, d), D_FF ** -0.5 * DEEPNORM_BETA),
        'l0_ln2_g': gain(d),
        'l0_ln2_b': bias(d),
        'l1_mod_w': nrm((d, 6 * d), 0.5 * d_inv),
        'l1_mod_b': nrm((6 * d,), 0.02),
        'l1_w_in': nrm((d, ODD_IN), d_inv),
        'l1_ret_decay_f': 5.0 + jnp.arange(RET_HEADS, dtype=jnp.float32) + uni((RET_HEADS,), -0.25, 0.25),
        'l1_ret_decay_b': 5.0 + jnp.arange(RET_HEADS, dtype=jnp.float32) + uni((RET_HEADS,), -0.25, 0.25),
        'l1_w_out': nrm((RET_VD, d), RET_VD ** -0.5 * DEEPNORM_BETA),
        'l1_ln1_g': gain(d),
        'l1_ln1_b': bias(d),
        'l1_router': nrm((d, N_EXPERTS), d_inv),
        'l1_moe_w_gate': nrm((N_EXPERTS, d, D_FF_EXPERT), d_inv),
        'l1_moe_w_up': nrm((N_EXPERTS, d, D_FF_EXPERT), d_inv),
        'l1_moe_w_down': nrm((N_EXPERTS, D_FF_EXPERT, d), D_FF_EXPERT ** -0.5 * DEEPNORM_BETA),
        'l1_ln2_g': gain(d),
        'l1_ln2_b': bias(d),
    }


def reference(x, c, ctx, c_ctx,
              l0_mod_w, l0_mod_b, l0_w_in, l0_mla_q_norm, l0_mla_wq_up, l0_mla_kv_norm, l0_mla_wkv_up,
              l0_rwkv_conv, l0_rwkv_w0_f, l0_rwkv_w2_f, l0_rwkv_w0_b, l0_rwkv_w2_b, l0_rwkv_a0_f,
              l0_rwkv_a2_f, l0_rwkv_a0_b, l0_rwkv_a2_b, l0_rwkv_g2, l0_rwkv_k_k, l0_rwkv_k_a, l0_rwkv_r_k,
              l0_rwkv_lnx_g, l0_rwkv_lnx_b, l0_w_out, l0_ln1_g, l0_ln1_b, l0_ffn_w_gate, l0_ffn_w_up,
              l0_ffn_w_down, l0_ln2_g, l0_ln2_b,
              l1_mod_w, l1_mod_b, l1_w_in, l1_ret_decay_f, l1_ret_decay_b, l1_w_out, l1_ln1_g, l1_ln1_b,
              l1_router, l1_moe_w_gate, l1_moe_w_up, l1_moe_w_down, l1_ln2_g, l1_ln2_b):
    even_params = (l0_mod_w, l0_mod_b, l0_w_in, l0_mla_q_norm, l0_mla_wq_up, l0_mla_kv_norm, l0_mla_wkv_up,
                   l0_rwkv_conv, l0_rwkv_w0_f, l0_rwkv_w2_f, l0_rwkv_w0_b, l0_rwkv_w2_b, l0_rwkv_a0_f,
                   l0_rwkv_a2_f, l0_rwkv_a0_b, l0_rwkv_a2_b, l0_rwkv_g2, l0_rwkv_k_k, l0_rwkv_k_a, l0_rwkv_r_k,
                   l0_rwkv_lnx_g, l0_rwkv_lnx_b, l0_w_out, l0_ln1_g, l0_ln1_b, l0_ffn_w_gate, l0_ffn_w_up,
                   l0_ffn_w_down, l0_ln2_g, l0_ln2_b)
    odd_params = (l1_mod_w, l1_mod_b, l1_w_in, l1_ret_decay_f, l1_ret_decay_b, l1_w_out, l1_ln1_g, l1_ln1_b,
                  l1_router, l1_moe_w_gate, l1_moe_w_up, l1_moe_w_down, l1_ln2_g, l1_ln2_b)
    sc = _silu(c)
    scc = _silu(c_ctx)
    xc = ctx
    for layer in range(DEPTH):
        if layer % 2 == 0:
            x, xc = _even_layer(x, xc, sc, scc, *even_params)
        else:
            x = _odd_layer(x, xc, sc, scc, *odd_params)
    return x
```

```cpp
#include <hip/hip_runtime.h>
#include <cstdio>
#include <cstdint>

#define LAS __attribute__((address_space(3)))
#define GAS __attribute__((address_space(1)))
typedef unsigned short bf16_t;
typedef short bf16x8 __attribute__((ext_vector_type(8)));
typedef float f32x4 __attribute__((ext_vector_type(4)));
typedef float f32x2 __attribute__((ext_vector_type(2)));
typedef unsigned u32x4 __attribute__((ext_vector_type(4)));
typedef unsigned u32x2 __attribute__((ext_vector_type(2)));

constexpr int DM = 1024, NB = 2, SEQ = 8192, NLAT = NB * SEQ, CTX = 256, NCTX = NB * CTX, MR = NLAT + NCTX;
constexpr int SKEYS = CTX + SEQ;
constexpr int E_IN = 2336, E_INP = 2560, FF = 2816, ODD_IN = 8192, RET_VD = 2048, DFE = 3584, NEXP = 8;
constexpr float ALPHA = 1.4142135623730951f;
constexpr float LN_EPS = 1e-5f;

constexpr size_t MiB = 1048576;
constexpr size_t WS_CTL = 0, CTL_BYTES = 65536;
constexpr size_t WS_SMALL = 1 * MiB;
constexpr size_t SM_MOD = 0;
constexpr size_t SM_ROPE0 = 262144;
constexpr size_t SM_ROPE1 = 262144 + 65536;
constexpr size_t SM_BIAS4 = 200704;
constexpr size_t SM_TOKE = 393216;
constexpr size_t SM_TOKG = 524288;
constexpr size_t SM_TOKP = 655360;
constexpr size_t SM_SLOT = 786432;
constexpr size_t SM_TOKS = 1179648;
constexpr size_t SM_END = 2 * MiB;
constexpr size_t WS_W0IN = 3 * MiB;
constexpr size_t WS_WMLAQ = 8 * MiB;
constexpr size_t WS_WKV = 8 * MiB + 768 * 256 * 2;
constexpr size_t WS_WMLAV = 8 * MiB + 1280 * 384 * 2;
constexpr size_t WS_WLORA = 9 * MiB + MiB / 2;
constexpr size_t WS_W0OUT = 11 * MiB + MiB / 2;
constexpr size_t WS_W0GU = 13 * MiB + MiB / 2;
constexpr size_t WS_W0DN = 24 * MiB + MiB / 2;
constexpr size_t WS_W1IN = 30 * MiB;
constexpr size_t WS_W1OUT = 46 * MiB;
constexpr size_t WS_R0 = 50 * MiB;
constexpr size_t WS_R1 = 218 * MiB;
constexpr size_t WS_END = 536 * MiB;
constexpr size_t WS_XMOD = 50 * MiB;
constexpr size_t WS_MIX0 = 267 * MiB + MiB / 2;
constexpr size_t WS_PRE = 383 * MiB;
constexpr size_t WS_X1 = 449 * MiB;
constexpr size_t WS_Z0 = 83 * MiB;
constexpr size_t WS_AMLA = 165 * MiB + MiB / 2;
constexpr size_t WS_ALORA = 178 * MiB;
constexpr size_t WS_RKV = 218 * MiB;
constexpr size_t WS_LDF = 267 * MiB + MiB / 2;
constexpr size_t WS_LDB = 300 * MiB + MiB / 2;
constexpr size_t WS_LRF = 333 * MiB + MiB / 2;
constexpr size_t WS_LRB = 350 * MiB;
constexpr size_t WS_GG = 366 * MiB + MiB / 2;
constexpr size_t WS_QB = 50 * MiB;
constexpr size_t WS_KB = 190 * MiB + MiB / 2;
constexpr size_t WS_VT = 74 * MiB + 3 * MiB / 4;
constexpr size_t WS_QC = 91 * MiB + MiB / 4;
constexpr size_t WS_Y0 = 124 * MiB + MiB / 4;
constexpr size_t WS_YS = 300 * MiB + MiB / 2;
constexpr size_t WS_MT = 383 * MiB;
constexpr size_t WS_NT = 449 * MiB;
constexpr size_t WS_HFF = 83 * MiB;
constexpr size_t WS_PART8 = 515 * MiB;
constexpr size_t WS_PART11 = 176 * MiB;
constexpr size_t WS_XC2 = 531 * MiB + MiB / 2;
constexpr size_t WS_XMOD1 = 480 * MiB;
constexpr size_t WS_K1 = 83 * MiB;
constexpr size_t WS_Q1 = 115 * MiB;
constexpr size_t WS_VT1 = 147 * MiB;
constexpr size_t WS_KDT = 218 * MiB;
constexpr size_t WS_PFB = 284 * MiB;
constexpr size_t WS_ST = 348 * MiB;
constexpr size_t WS_OF = 218 * MiB;
constexpr size_t WS_OB = 50 * MiB;
constexpr size_t WS_GNP = 522 * MiB;
constexpr size_t WS_GNS = 514 * MiB;
constexpr size_t WS_XMOD1B = 284 * MiB;
constexpr size_t WS_MIX1 = 348 * MiB;
constexpr size_t WS_PRE1 = 412 * MiB;
constexpr int RCH = 33;
constexpr size_t WS_MOEGU = 50 * MiB;
constexpr size_t WS_MOEDN = 162 * MiB;
constexpr size_t WS_HMID = 218 * MiB;
constexpr size_t WS_HMOE = 456 * MiB;
constexpr size_t WS_YB = 456 * MiB;
constexpr size_t WS_YB2 = 50 * MiB;
constexpr int MOE_MAXBLK = 136;

constexpr int CW_BAR = 4096;
constexpr int CW_MOECNT = 8192;

constexpr int RING_BYTES = 131072, LDSCTL_OFF = RING_BYTES, MISC_OFF = LDSCTL_OFF + 320, LDS_BYTES = 147456;

#define RLX_AGENT __ATOMIC_RELAXED, __HIP_MEMORY_SCOPE_AGENT
__device__ __forceinline__ unsigned f2bf(float f) { unsigned u = __builtin_bit_cast(unsigned, f); return (u + 0x7fffu + ((u >> 16) & 1u)) >> 16; }
__device__ __forceinline__ unsigned pk2(float lo, float hi) { return f2bf(lo) | (f2bf(hi) << 16); }
__device__ __forceinline__ float bf2f(unsigned short b) { return __builtin_bit_cast(float, ((unsigned)b) << 16); }
__device__ __forceinline__ float bflo(unsigned u) { return __builtin_bit_cast(float, u << 16); }
__device__ __forceinline__ float bfhi(unsigned u) { return __builtin_bit_cast(float, u & 0xffff0000u); }
typedef __bf16 bf16x2_t __attribute__((ext_vector_type(2)));
__device__ __forceinline__ unsigned cvt_pk_bf16(float lo, float hi) { const f32x2 v = {lo, hi}; const bf16x2_t b = __builtin_convertvector(v, bf16x2_t); return __builtin_bit_cast(unsigned, b); }
__device__ __forceinline__ float wave_sum(float v) {
#pragma unroll
    for (int o = 1; o < 64; o <<= 1) v += __shfl_xor(v, o);
    return v;
}
__device__ __forceinline__ float silu_f(float t) { return t * __builtin_amdgcn_rcpf(1.f + __builtin_amdgcn_exp2f(-1.4426950408889634f * t)); }
__device__ __forceinline__ float sigmoid_f(float t) { return __builtin_amdgcn_rcpf(1.f + __builtin_amdgcn_exp2f(-1.4426950408889634f * t)); }
__device__ __forceinline__ int row_class(int m) { return m < SEQ ? 0 : (m < NLAT ? 1 : 2); }

#define XB_TMO      128
#define XB_XCNT(j)  (256  + 64 * (j))
#define XB_XSUB(j)  (1280 + 64 * (j))
#define XB_XGEN(j)  (2304 + 64 * (j))
#define XB_TOP      3328
#define XB_TOPGEN   3392
#define XCD_BAR_WORDS 3456
#define XB_SPIN_CAP (1u << 18)
__device__ __forceinline__ unsigned xb_ld(unsigned* p)              { return __hip_atomic_load(p, __ATOMIC_RELAXED, __HIP_MEMORY_SCOPE_AGENT); }
__device__ __forceinline__ unsigned xb_add(unsigned* p, unsigned v) { return __hip_atomic_fetch_add(p, v, __ATOMIC_RELAXED, __HIP_MEMORY_SCOPE_AGENT); }
__device__ __forceinline__ unsigned xb_xcc_id() { return (unsigned)__builtin_amdgcn_s_getreg((3 << 11) | 20) & 0xFu; }
#define XB_SPIN(cond, bar) do { unsigned _sp = 0; while (cond) { __builtin_amdgcn_s_sleep(1); \
    if ((++_sp & 255u) == 0u) { if (xb_ld(&(bar)[XB_TMO])) break; if (_sp > XB_SPIN_CAP) { atomicAdd(&(bar)[XB_TMO], 1u); break; } } } } while (0)
struct XcdBarrier { unsigned* bar; unsigned x; volatile LAS unsigned* st; };
__device__ __forceinline__ XcdBarrier xcd_barrier_post(unsigned* bar, volatile LAS unsigned* st) {
    XcdBarrier b; b.bar = bar; b.x = xb_xcc_id(); b.st = st;
    if (threadIdx.x == 0) (void)xb_add(&bar[XB_XCNT(b.x)], 1u);
    return b;
}
__device__ __forceinline__ void xcd_barrier_complete(unsigned* bar, unsigned x, unsigned& nloc, unsigned& nx) {
    const unsigned G = gridDim.x * gridDim.y * gridDim.z;
    unsigned sum, cnt, mine, sp = 0u;
    for (;;) {
        sum = 0u; cnt = 0u; mine = 0u;
#pragma unroll
        for (unsigned j = 0; j < 16; ++j) { const unsigned c = xb_ld(&bar[XB_XCNT(j)]); sum += c; cnt += (c > 0u) ? 1u : 0u; mine = (j == x) ? c : mine; }
        if (sum == G) break;
        __builtin_amdgcn_s_sleep(1);
        if ((++sp & 255u) == 0u) { if (xb_ld(&bar[XB_TMO])) break; if (sp > XB_SPIN_CAP) { atomicAdd(&bar[XB_TMO], 1u); break; } }
    }
    nloc = mine > 0u ? mine : 1u; nx = cnt > 0u ? cnt : 1u;
}
__device__ __forceinline__ void xcd_barrier(const XcdBarrier& b) {
    asm volatile("s_waitcnt vmcnt(0)" ::: "memory");
    __syncthreads();
    if (threadIdx.x == 0) {
        unsigned* bar = b.bar;
        __builtin_amdgcn_s_waitcnt(0);
        unsigned nloc = b.st[0], nx = b.st[1];
        if (nloc == 0u) { xcd_barrier_complete(bar, b.x, nloc, nx); b.st[0] = nloc; b.st[1] = nx; }
        const unsigned old = xb_add(&bar[XB_XSUB(b.x)], 1u);
        const unsigned gen = old / nloc;
        if (old + 1u == (gen + 1u) * nloc) {
            __builtin_amdgcn_fence(__ATOMIC_RELEASE, "agent");
            asm volatile("s_waitcnt vmcnt(0)" ::: "memory");
            const unsigned og = xb_add(&bar[XB_TOP], 1u);
            const unsigned tg = og / nx;
            if (og + 1u == (tg + 1u) * nx) xb_add(&bar[XB_TOPGEN], 1u);
            else XB_SPIN(xb_ld(&bar[XB_TOPGEN]) == tg, bar);
            __builtin_amdgcn_fence(__ATOMIC_ACQUIRE, "agent");
            xb_add(&bar[XB_XGEN(b.x)], 1u);
            asm volatile("s_waitcnt vmcnt(0)" ::: "memory");
        } else {
            XB_SPIN(xb_ld(&bar[XB_XGEN(b.x)]) == gen, bar);
            __builtin_amdgcn_fence(__ATOMIC_ACQUIRE, "agent");
            asm volatile("s_waitcnt vmcnt(0)" ::: "memory");
        }
    }
    __syncthreads();
}

namespace pg8 {
constexpr int BM = 256, BK = 64, HALF = 128, HTB = HALF * BK * 2, STAGE_BYTES = 8 * HTB, NXCD = 8, WGM = 8;
__host__ __device__ __forceinline__ int lds_byte(int r, int c) { const int st = (r >> 4) * 2 + (c >> 5), rr = r & 15, cc = c & 31, ob = rr * 64 + cc * 2; return st * 1024 + (ob ^ (((ob >> 9) & 1) << 5)); }
__host__ __device__ __forceinline__ void stage_rc(int b, int& R, int& C) { const int st = b / 1024, sb = b % 1024, swz = sb ^ (((sb >> 9) & 1) << 5); R = (st >> 1) * 16 + swz / 64; C = (st & 1) * 32 + (swz % 64) / 2; }
__host__ __device__ __forceinline__ int perm32(int rho) { const int n = rho >> 4, i = rho & 15; return 8 * (i >> 2) + 4 * n + (i & 3); }

struct Unit { const char* A; const char* B; int nt, flags, pm, pn, aux; const int* gidx; };


__device__ __forceinline__ const char* rfl_ptr(const char* p) { const unsigned long long v = (unsigned long long)p; const unsigned lo = __builtin_amdgcn_readfirstlane((unsigned)v), hi = __builtin_amdgcn_readfirstlane((unsigned)(v >> 32)); return (const char*)(((unsigned long long)hi << 32) | lo); }
__device__ __forceinline__ void uniformize(Unit& u) { u.A = rfl_ptr(u.A); u.B = rfl_ptr(u.B); u.nt = __builtin_amdgcn_readfirstlane(u.nt); u.flags = __builtin_amdgcn_readfirstlane(u.flags);
    u.pm = __builtin_amdgcn_readfirstlane(u.pm); u.pn = __builtin_amdgcn_readfirstlane(u.pn); u.aux = __builtin_amdgcn_readfirstlane(u.aux); u.gidx = (const int*)rfl_ptr((const char*)u.gidx); }
struct DenseOrder {
    const bf16_t* A; const bf16_t* Bt; int lda, ldb, K, nM, nN, nwg, G, c, reps = 1;
    __device__ void init(const bf16_t* A_, int lda_, const bf16_t* Bt_, int ldb_, int M, int N, int K_, int G_, int c_) { A = A_; Bt = Bt_; lda = lda_; ldb = ldb_; K = K_; nM = M / BM; nN = N / BM; nwg = nM * nN; G = G_; c = c_; }
    __device__ bool next(int i, Unit& u) const {
        const long L = (long)i * G + c; if (L >= (long)nwg * reps) return false;
        return next_l((int)(L % nwg), u);
    }
    __device__ bool next_l(int wgid, Unit& u) const { { const int q = nwg / NXCD, r = nwg % NXCD, xcd = wgid % NXCD, off = wgid / NXCD; wgid = (xcd < r ? xcd * (q + 1) : r * (q + 1) + (xcd - r) * q) + off; }
        const int nig = WGM * nN, gid = wgid / nig, fm = gid * WGM, gsz = (nM - fm) < WGM ? (nM - fm) : WGM;
        u.pm = fm + ((wgid % nig) % gsz); u.pn = (wgid % nig) / gsz;
        u.A = (const char*)(A + (size_t)u.pm * BM * lda); u.B = (const char*)(Bt + (size_t)u.pn * BM * ldb); u.nt = K / BK; u.flags = 3; u.aux = 0; u.gidx = nullptr;
        return true;
    }
};


struct CtxSliceOrder {
    const bf16_t* A; const bf16_t* Bt; int lda, ldb, nN, ks, G, c, reps;
    __device__ bool next(int i, Unit& u) const { int L = i * G + c; const int n = 2 * nN * ks; if (L >= n * reps) return false; L %= n;
        const int tile = L / ks, sl = L % ks, pmc = tile / nN, pn = tile % nN;
        u.pm = pmc; u.pn = pn; u.A = (const char*)(A + (size_t)pmc * BM * lda + sl * 256); u.B = (const char*)(Bt + (size_t)pn * BM * ldb + sl * 256); u.nt = 4; u.flags = 3; u.aux = sl; u.gidx = nullptr; return true; }
};

struct BlockOrder {
    const bf16_t* A; const bf16_t* Bt; int lda, ldb, K, nM, nNb, nblk, acol, G, c, reps;
    __device__ bool next(int i, Unit& u) const { int L = i * G + c; const int per = nM * nNb, n = per * nblk; if (L >= n * reps) return false; L %= n;
        const int b = L / per, r = L % per, pm = r % nM, pn = r / nM;
        u.pm = pm; u.pn = b * nNb + pn; u.A = (const char*)(A + (size_t)pm * BM * lda + b * acol); u.B = (const char*)(Bt + (size_t)u.pn * BM * ldb); u.nt = K / BK; u.flags = 3; u.aux = 0; u.gidx = nullptr; return true; }
};

struct KnopeOrder { BlockOrder S;
    __device__ bool next(int i, Unit& u) const { if (!S.next(i, u)) return false; u.B = (const char*)(S.Bt + (size_t)(u.pn + 3) * BM * S.ldb); u.pn += 3; return true; } };

struct MoeOrder {
    const char* A; const char* W; const int* slot_tok; size_t wstride; int lda, ldb, K, npn, B0, G, c, reps = 1, ksplit = 1; bool gather;
    int eb[NEXP], en[NEXP], us[NEXP + 1];
    __device__ void init(const unsigned* cnt, int B0_, int B1_) {
        int bs = 0, u = 0; B0 = B0_;
#pragma unroll
        for (int e = 0; e < NEXP; ++e) { const int n = (int)__hip_atomic_load(cnt + 64 * e, __ATOMIC_RELAXED, __HIP_MEMORY_SCOPE_AGENT), nb = (n + 255) >> 8;
            const int lo = bs > B0_ ? bs : B0_, hi = (bs + nb) < B1_ ? (bs + nb) : B1_; eb[e] = lo; en[e] = hi > lo ? hi - lo : 0; us[e] = u; u += en[e] * npn * ksplit; bs += nb; }
        us[NEXP] = u;
    }
    __device__ bool next(int i, Unit& u) const {
        int L = i * G + c; if (L >= us[NEXP] * reps) return false; L %= us[NEXP];
        int e = 0, base = 0, nb = 1, fb = 0;
#pragma unroll
        for (int j = 0; j < NEXP; ++j) if (L >= us[j] && en[j] > 0) { e = j; base = us[j]; nb = en[j]; fb = eb[j]; }
        const int l0 = L - base, kh = l0 % ksplit, l = l0 / ksplit, pn = l / nb, blk = fb + l % nb, kq = K / ksplit;
        u.A = (gather ? A : A + (size_t)(blk - B0) * BM * lda * 2) + (size_t)kh * kq * 2; u.B = W + (size_t)e * wstride + (size_t)pn * BM * ldb * 2 + (size_t)kh * kq * 2; u.nt = kq / BK; u.flags = 3;
        u.pm = gather ? (blk - B0) : blk; u.pn = pn; u.aux = kh; u.gidx = slot_tok + blk * BM;
        return true;
    }
};

template <class Epi, class Sched, bool ALIGN_EPI, bool GATHER>
__device__ __forceinline__ void gemm_phase(LAS unsigned char* lds, const int lda, const int ldb, const Sched& S, const Epi& E) {
    const int tid = threadIdx.x, wid = __builtin_amdgcn_readfirstlane(tid >> 6), lane = tid & 63, wr = wid >> 2, wc = wid & 3, fr = lane & 15, fq = lane >> 4;
    unsigned voffA[2], voffB[2]; int gR[2], gC[2];
#pragma unroll
    for (int i = 0; i < 2; ++i) { int R, C; stage_rc(tid * 16 + i * 8192, R, C); const int Rb = Epi::PERM ? ((R & ~31) + perm32(R & 31)) : R;
        voffA[i] = (unsigned)(R * lda + C) * 2u; voffB[i] = (unsigned)(Rb * ldb + C) * 2u; gR[i] = R; gC[i] = C; }
    const size_t kstep = (size_t)(BK * 2);
    const size_t hstepA = GATHER ? 0 : (size_t)HALF * lda * 2, hstepB = (size_t)HALF * ldb * 2;
    const unsigned ldsw = (unsigned)wid * 1024u;
    const int aoff = lds_byte(wr * 64 + fr, fq * 8), boff = lds_byte(wc * 32 + fr, fq * 8);
#define PG8_SA(b, h) (((b) * 2 + (h)) * HTB)
#define PG8_SB(b, h) ((4 + (b) * 2 + (h)) * HTB)
#define PG8_STG(bufoff, gbase, v0, v1) do { \
        __builtin_amdgcn_global_load_lds((const unsigned*)((const char*)(gbase) + (v0)), (LAS unsigned*)(lds + (bufoff) + ldsw), 16, 0, 0); \
        __builtin_amdgcn_global_load_lds((const unsigned*)((const char*)(gbase) + (v1)), (LAS unsigned*)(lds + (bufoff) + ldsw + 8192), 16, 0, 0); } while (0)
#define PG8_STAGE_B(bufoff, gbase) PG8_STG(bufoff, gbase, voffB[0], voffB[1])
#define PG8_LDA(dst, b, h) do { _Pragma("unroll") for (int m = 0; m < 4; ++m) _Pragma("unroll") for (int k = 0; k < 2; ++k) dst[m][k] = *(const LAS bf16x8*)(lds + PG8_SA(b, h) + aoff + m * 2048 + k * 1024); } while (0)
#define PG8_LDB(dst, b, h) do { _Pragma("unroll") for (int n = 0; n < 2; ++n) _Pragma("unroll") for (int k = 0; k < 2; ++k) dst[n][k] = *(const LAS bf16x8*)(lds + PG8_SB(b, h) + boff + n * 2048 + k * 1024); } while (0)
#define PG8_MMA(ai, bj, At, Bt) do { __builtin_amdgcn_s_setprio(1); _Pragma("unroll") for (int m = 0; m < 4; ++m) _Pragma("unroll") for (int n = 0; n < 2; ++n) _Pragma("unroll") for (int k = 0; k < 2; ++k) \
        acc[ai][bj][m][n] = __builtin_amdgcn_mfma_f32_16x16x32_bf16(Bt[n][k], At[m][k], acc[ai][bj][m][n], 0, 0, 0); __builtin_amdgcn_s_setprio(0); } while (0)
#define PG8_WAIT_V(n) asm volatile("s_waitcnt vmcnt(" #n ")" ::: "memory")
#define PG8_WAIT_L(n) asm volatile("s_waitcnt lgkmcnt(" #n ")" ::: "memory")
#define PG8_BAR __builtin_amdgcn_s_barrier()
#define PG8_SCHED __builtin_amdgcn_sched_barrier(0)
    Unit cur, nxt; int ui = 0;
    if (!S.next(0, cur)) return;
    uniformize(cur);
    f32x4 acc[2][2][4][2];
#pragma unroll
    for (int a = 0; a < 2; ++a)
#pragma unroll
        for (int b = 0; b < 2; ++b)
#pragma unroll
            for (int m = 0; m < 4; ++m)
#pragma unroll
                for (int n = 0; n < 2; ++n) acc[a][b][m][n] = (f32x4){0.f, 0.f, 0.f, 0.f};
    bf16x8 At[4][2], B0[2][2], B1[2][2];
    unsigned cvA[4], nvA[4];
    if constexpr (GATHER) {
#pragma unroll
        for (int i = 0; i < 2; ++i) { cvA[i] = (unsigned)((size_t)cur.gidx[gR[i]] * lda + gC[i]) * 2u; cvA[2 + i] = (unsigned)((size_t)cur.gidx[HALF + gR[i]] * lda + gC[i]) * 2u; }
    } else { cvA[0] = voffA[0]; cvA[1] = voffA[1]; cvA[2] = voffA[0]; cvA[3] = voffA[1]; }
#pragma unroll
    for (int i = 0; i < 4; ++i) nvA[i] = cvA[i];
    const char* cA = cur.A; const char* cB = cur.B;
    PG8_STAGE_B(PG8_SB(0, 0), cB); PG8_STAGE_B(PG8_SB(0, 1), cB + hstepB); PG8_STG(PG8_SA(0, 0), cA, cvA[0], cvA[1]); PG8_STG(PG8_SA(0, 1), cA + hstepA, cvA[2], cvA[3]);
    if (wr == 1) PG8_BAR;
    PG8_WAIT_V(2); PG8_BAR;
    PG8_STAGE_B(PG8_SB(1, 0), cB + kstep); PG8_STG(PG8_SA(1, 0), cA + kstep, cvA[0], cvA[1]); PG8_STAGE_B(PG8_SB(1, 1), cB + hstepB + kstep);
    PG8_WAIT_V(6); PG8_BAR;
    for (;;) {
        const bool has_next = S.next(ui + 1, nxt);
        if (has_next) uniformize(nxt);
        const char* nA = has_next ? nxt.A : cA; const char* nB = has_next ? nxt.B : cB;
        if constexpr (GATHER) {
            if (has_next) {
#pragma unroll
                for (int i = 0; i < 2; ++i) { nvA[i] = (unsigned)((size_t)nxt.gidx[gR[i]] * lda + gC[i]) * 2u; nvA[2 + i] = (unsigned)((size_t)nxt.gidx[HALF + gR[i]] * lda + gC[i]) * 2u; }
            }
        }
        const int nt = cur.nt;
        for (int t = 0; t < nt; t += 2) {
            const bool last = (t == nt - 2);
            const char* a1 = cA + (size_t)(t + 1) * kstep;
            const char* a2 = last ? nA : cA + (size_t)(t + 2) * kstep; const char* b2 = last ? nB : cB + (size_t)(t + 2) * kstep;
            const char* a3 = a2 + kstep; const char* b3 = b2 + kstep;
            unsigned w0, w1, w2, w3;
            if constexpr (GATHER) { w0 = last ? nvA[0] : cvA[0]; w1 = last ? nvA[1] : cvA[1]; w2 = last ? nvA[2] : cvA[2]; w3 = last ? nvA[3] : cvA[3]; }
            else { w0 = cvA[0]; w1 = cvA[1]; w2 = cvA[2]; w3 = cvA[3]; }
            PG8_LDB(B0, 0, 0); PG8_LDB(B1, 0, 1); PG8_SCHED; PG8_LDA(At, 0, 0); PG8_STG(PG8_SA(1, 1), a1 + hstepA, cvA[2], cvA[3]);
            PG8_WAIT_V(8); PG8_WAIT_L(0); PG8_BAR; PG8_MMA(0, 0, At, B0); PG8_MMA(0, 1, At, B1); PG8_BAR; PG8_SCHED;
            PG8_LDA(At, 0, 1); PG8_STAGE_B(PG8_SB(0, 0), b2); PG8_STAGE_B(PG8_SB(0, 1), b2 + hstepB); PG8_STG(PG8_SA(0, 0), a2, w0, w1);
            PG8_WAIT_V(8); PG8_WAIT_L(0); PG8_BAR; PG8_MMA(1, 0, At, B0); PG8_MMA(1, 1, At, B1); PG8_BAR; PG8_SCHED;
            PG8_LDB(B0, 1, 0); PG8_LDB(B1, 1, 1); PG8_SCHED; PG8_LDA(At, 1, 0); PG8_STG(PG8_SA(0, 1), a2 + hstepA, w2, w3);
            PG8_WAIT_V(8); PG8_WAIT_L(0); PG8_BAR; PG8_MMA(0, 0, At, B0); PG8_MMA(0, 1, At, B1); PG8_BAR; PG8_SCHED;
            PG8_LDA(At, 1, 1); PG8_STAGE_B(PG8_SB(1, 0), b3); PG8_STAGE_B(PG8_SB(1, 1), b3 + hstepB); PG8_STG(PG8_SA(1, 0), a3, w0, w1);
            PG8_WAIT_V(8); PG8_WAIT_L(0); PG8_BAR; PG8_MMA(1, 0, At, B0); PG8_MMA(1, 1, At, B1); PG8_BAR; PG8_SCHED;
        }
        if constexpr (ALIGN_EPI) { if (wr == 0) PG8_BAR; }
        if (cur.flags & 2) E(acc, cur, wr, wc, fr, fq);
        if (!has_next) break;
        if (nxt.flags & 1) {
#pragma unroll
            for (int a = 0; a < 2; ++a)
#pragma unroll
                for (int b = 0; b < 2; ++b)
#pragma unroll
                    for (int m = 0; m < 4; ++m)
#pragma unroll
                        for (int n = 0; n < 2; ++n) acc[a][b][m][n] = (f32x4){0.f, 0.f, 0.f, 0.f};
        }
        cur = nxt; cA = nA; cB = nB; ++ui;
#pragma unroll
        for (int i = 0; i < 4; ++i) cvA[i] = nvA[i];
        if constexpr (ALIGN_EPI) { if (wr == 1) PG8_BAR; }
    }
    PG8_WAIT_V(0);
    if constexpr (!ALIGN_EPI) { if (wr == 0) PG8_BAR; }
    PG8_BAR;
#undef PG8_SA
#undef PG8_SB
#undef PG8_STG
#undef PG8_STAGE_B
#undef PG8_LDA
#undef PG8_LDB
#undef PG8_MMA
#undef PG8_WAIT_V
#undef PG8_WAIT_L
#undef PG8_BAR
#undef PG8_SCHED
}

typedef f32x4 Acc[2][2][4][2];

struct EpiResGate {
    static constexpr bool PERM = false;
    float* out; const float* res; const float* gate3;
    int ld; int row_cls_base;
    __device__ __forceinline__ void operator()(const Acc& acc, const Unit& u, int wr, int wc, int fr, int fq) const {
        const int row0 = u.pm * BM + wr * 64 + fr, col0 = u.pn * BM + wc * 32 + 4 * fq;
        const float* g = gate3 + (size_t)row_class(u.pm * BM + row_cls_base) * 6144;
        f32x4 gv[2][2];
#pragma unroll
        for (int bj = 0; bj < 2; ++bj)
#pragma unroll
            for (int n = 0; n < 2; ++n) gv[bj][n] = *(const f32x4*)(g + col0 + bj * HALF + n * 16);
#pragma unroll
        for (int ai = 0; ai < 2; ++ai)
#pragma unroll
            for (int m = 0; m < 4; ++m) { const size_t ro = (size_t)(row0 + ai * HALF + m * 16) * ld + col0;
#pragma unroll
                for (int bj = 0; bj < 2; ++bj)
#pragma unroll
                    for (int n = 0; n < 2; ++n) { const f32x4 r = *(const f32x4*)(res + ro + bj * HALF + n * 16);
                        *(f32x4*)(out + ro + bj * HALF + n * 16) = r * ALPHA + gv[bj][n] * acc[ai][bj][m][n]; } }
    }
};
struct EpiCtxPart {
    static constexpr bool PERM = false;
    float* part; const float* gate;
    __device__ __forceinline__ void operator()(const Acc& acc, const Unit& u, int wr, int wc, int fr, int fq) const {
        const int row0 = u.pm * BM + wr * 64 + fr, col0 = u.pn * BM + wc * 32 + 4 * fq;
        float* ob = part + ((size_t)u.aux * NCTX + row0) * 1024 + col0;
        f32x4 gv[2][2];
#pragma unroll
        for (int bj = 0; bj < 2; ++bj)
#pragma unroll
            for (int n = 0; n < 2; ++n) gv[bj][n] = *(const f32x4*)(gate + col0 + bj * HALF + n * 16);
#pragma unroll
        for (int ai = 0; ai < 2; ++ai)
#pragma unroll
            for (int m = 0; m < 4; ++m)
#pragma unroll
                for (int bj = 0; bj < 2; ++bj)
#pragma unroll
                    for (int n = 0; n < 2; ++n) *(f32x4*)(ob + (size_t)(ai * HALF + m * 16) * 1024 + bj * HALF + n * 16) = gv[bj][n] * acc[ai][bj][m][n];
    }
};
struct EpiSwiGLU {
    static constexpr bool PERM = true;
    bf16_t* H; int ldh;
    __device__ __forceinline__ void operator()(const Acc& acc, const Unit& u, int wr, int wc, int fr, int fq) const {
        const int row0 = u.pm * BM + wr * 64 + fr, col0 = u.pn * HALF + wc * 32 + 8 * fq;
#pragma unroll
        for (int ai = 0; ai < 2; ++ai)
#pragma unroll
            for (int m = 0; m < 4; ++m) { bf16_t* rowp = H + (size_t)(row0 + ai * HALF + m * 16) * ldh + col0;
                float v[8];
#pragma unroll
                for (int n = 0; n < 2; ++n)
#pragma unroll
                    for (int j = 0; j < 4; ++j) { const float g = acc[ai][0][m][n][j], up = acc[ai][1][m][n][j]; v[4 * n + j] = silu_f(g) * up; }
                u32x4 w; w.x = cvt_pk_bf16(v[0], v[1]); w.y = cvt_pk_bf16(v[2], v[3]); w.z = cvt_pk_bf16(v[4], v[5]); w.w = cvt_pk_bf16(v[6], v[7]);
                *(u32x4*)rowp = w; }
    }
};

struct EpiBf16 {
    static constexpr bool PERM = true;
    bf16_t* O; int ldc;
    __device__ __forceinline__ void operator()(const Acc& acc, const Unit& u, int wr, int wc, int fr, int fq) const {
        const int row0 = u.pm * BM + wr * 64 + fr, col0 = u.pn * BM + wc * 32 + 8 * fq;
#pragma unroll
        for (int ai = 0; ai < 2; ++ai)
#pragma unroll
            for (int m = 0; m < 4; ++m) { bf16_t* rowp = O + (size_t)(row0 + ai * HALF + m * 16) * ldc + col0;
#pragma unroll
                for (int bj = 0; bj < 2; ++bj) { const f32x4 v0 = acc[ai][bj][m][0], v1 = acc[ai][bj][m][1];
                    u32x4 w; w.x = cvt_pk_bf16(v0[0], v0[1]); w.y = cvt_pk_bf16(v0[2], v0[3]); w.z = cvt_pk_bf16(v1[0], v1[1]); w.w = cvt_pk_bf16(v1[2], v1[3]);
                    *(u32x4*)(rowp + bj * HALF) = w; } }
    }
};
struct EpiBf16Sel {
    static constexpr bool PERM = true;
    bf16_t* O; int ldc; long stride;
    __device__ __forceinline__ void operator()(const Acc& acc, const Unit& u, int wr, int wc, int fr, int fq) const {
        const int row0 = u.pm * BM + wr * 64 + fr, col0 = u.pn * BM + wc * 32 + 8 * fq; bf16_t* Ob = O + (long)u.aux * stride;
#pragma unroll
        for (int ai = 0; ai < 2; ++ai)
#pragma unroll
            for (int m = 0; m < 4; ++m) { bf16_t* rowp = Ob + (size_t)(row0 + ai * HALF + m * 16) * ldc + col0;
#pragma unroll
                for (int bj = 0; bj < 2; ++bj) { const f32x4 v0 = acc[ai][bj][m][0], v1 = acc[ai][bj][m][1];
                    u32x4 w; w.x = cvt_pk_bf16(v0[0], v0[1]); w.y = cvt_pk_bf16(v0[2], v0[3]); w.z = cvt_pk_bf16(v1[0], v1[1]); w.w = cvt_pk_bf16(v1[2], v1[3]);
                    *(u32x4*)(rowp + bj * HALF) = w; } }
    }
};
struct EpiLora {
    static constexpr bool PERM = true;
    float* ld; bf16_t* lr; const float* bias4;
    __device__ __forceinline__ void operator()(const Acc& acc, const Unit& u, int wr, int wc, int fr_in, int fq_in) const {
        int fr = fr_in, fq = fq_in; asm volatile("" : "+v"(fr), "+v"(fq));
        const int blk = u.pn >> 1, row0 = u.pm * BM + wr * 64 + fr, colb = (u.pn & 1) * BM + wc * 32 + 8 * fq;
        const float* bias = bias4 + (blk < 4 ? blk : 0) * 512;
        f32x4 bv[2][2];
#pragma unroll
        for (int bj = 0; bj < 2; ++bj)
#pragma unroll
            for (int n = 0; n < 2; ++n) bv[bj][n] = blk < 4 ? *(const f32x4*)(bias + colb + bj * HALF + 4 * n) : (f32x4){0.f, 0.f, 0.f, 0.f};
#pragma unroll
        for (int ai = 0; ai < 2; ++ai)
#pragma unroll
            for (int m = 0; m < 4; ++m) { const size_t ro = (size_t)(row0 + ai * HALF + m * 16) * 512 + colb;
#pragma unroll
                for (int bj = 0; bj < 2; ++bj) { f32x4 v0 = acc[ai][bj][m][0] + bv[bj][0], v1 = acc[ai][bj][m][1] + bv[bj][1];
                    if (blk < 4) {
#pragma unroll
                        for (int j = 0; j < 4; ++j) { v0[j] = sigmoid_f(v0[j]); v1[j] = sigmoid_f(v1[j]); } }
                    if (blk < 2) { float* o = ld + (size_t)blk * MR * 512 + ro + bj * HALF; *(f32x4*)o = v0 * -0.6065306597126334f; *(f32x4*)(o + 4) = v1 * -0.6065306597126334f; }
                    else { bf16_t* o = lr + (size_t)(blk - 2) * MR * 512 + ro + bj * HALF;
                        u32x4 w; w.x = cvt_pk_bf16(v0[0], v0[1]); w.y = cvt_pk_bf16(v0[2], v0[3]); w.z = cvt_pk_bf16(v1[0], v1[1]); w.w = cvt_pk_bf16(v1[2], v1[3]); *(u32x4*)o = w; } } }
    }
};
struct EpiMlaQK {
    static constexpr bool PERM = false;
    bf16_t* Q; bf16_t* KB; const f32x2* rope; float qscale;
    __device__ __forceinline__ void operator()(const Acc& acc, const Unit& u, int wr, int wc, int fr_in, int fq_in) const {
        int fr = fr_in, fq = fq_in; asm volatile("" : "+v"(fr), "+v"(fq));
        const int row0 = u.pm * BM + wr * 64 + fr;
#pragma unroll
        for (int bj = 0; bj < 2; ++bj) {
            const int cg = u.pn * BM + bj * HALF + wc * 32;
            if (cg < 768) {
                const bool is_rope = ((cg >> 5) % 3) == 2;
#pragma unroll
                for (int ai = 0; ai < 2; ++ai)
#pragma unroll
                    for (int m = 0; m < 4; ++m) { const int row = row0 + ai * HALF + m * 16;
                        f32x4 v0 = acc[ai][bj][m][0] * qscale, v1 = acc[ai][bj][m][1] * qscale;
                        if (is_rope && row < NLAT) { const int t = row & (SEQ - 1), prow = t >> 6, pcol = t & 63;
#pragma unroll
                            for (int j = 0; j < 4; ++j) { const int p = 4 * fq + j, f = p >> 3, i = p & 7; const f32x2 cs = rope[(f ? pcol : prow) * 8 + i];
                                const float t1 = v0[j], t2 = v1[j]; v0[j] = t1 * cs.x - t2 * cs.y; v1[j] = t1 * cs.y + t2 * cs.x; } }
                        bf16_t* o = Q + (size_t)row * 768 + cg + 4 * fq;
                        u32x2 w0; w0.x = cvt_pk_bf16(v0[0], v0[1]); w0.y = cvt_pk_bf16(v0[2], v0[3]); *(u32x2*)o = w0;
                        u32x2 w1; w1.x = cvt_pk_bf16(v1[0], v1[1]); w1.y = cvt_pk_bf16(v1[2], v1[3]); *(u32x2*)(o + 16) = w1; }
            } else {
                const int c = cg - 768, head = c >> 6, d0 = (c & 63) + 4 * fq;
#pragma unroll
                for (int ai = 0; ai < 2; ++ai)
#pragma unroll
                    for (int m = 0; m < 4; ++m) { const int row = row0 + ai * HALF + m * 16;
                        const int b = row < NLAT ? (row >> 13) : ((row - NLAT) >> 8), sk = row < NLAT ? CTX + (row & (SEQ - 1)) : ((row - NLAT) & (CTX - 1));
                        bf16_t* o = KB + ((size_t)(b * SKEYS + sk) * 8 + head) * 96 + d0;
                        const f32x4 v0 = acc[ai][bj][m][0], v1 = acc[ai][bj][m][1];
                        u32x2 w0; w0.x = cvt_pk_bf16(v0[0], v0[1]); w0.y = cvt_pk_bf16(v0[2], v0[3]); *(u32x2*)o = w0;
                        u32x2 w1; w1.x = cvt_pk_bf16(v1[0], v1[1]); w1.y = cvt_pk_bf16(v1[2], v1[3]); *(u32x2*)(o + 16) = w1; }
            }
        }
    }
};
struct EpiVT {
    static constexpr bool PERM = true;
    bf16_t* VT;
    __device__ __forceinline__ void operator()(const Acc& acc, const Unit& u, int wr, int wc, int fr, int fq) const {
        const int m0 = u.pn * BM;
        const int b = m0 < NLAT ? (m0 >> 13) : ((m0 - NLAT) >> 8), s0 = m0 < NLAT ? CTX + (m0 & (SEQ - 1)) : 0;
        const int row0 = u.pm * BM + wr * 64 + fr, col0 = wc * 32 + 8 * fq;
#pragma unroll
        for (int ai = 0; ai < 2; ++ai)
#pragma unroll
            for (int m = 0; m < 4; ++m) { bf16_t* rowp = VT + ((size_t)b * 512 + row0 + ai * HALF + m * 16) * SKEYS + s0 + col0;
#pragma unroll
                for (int bj = 0; bj < 2; ++bj) { const f32x4 v0 = acc[ai][bj][m][0], v1 = acc[ai][bj][m][1];
                    u32x4 w; w.x = cvt_pk_bf16(v0[0], v0[1]); w.y = cvt_pk_bf16(v0[2], v0[3]); w.z = cvt_pk_bf16(v1[0], v1[1]); w.w = cvt_pk_bf16(v1[2], v1[3]);
                    *(u32x4*)(rowp + bj * HALF) = w; } }
    }
};

struct ScoreOrder {
    const bf16_t* Q; const bf16_t* Kk; int G, c, reps;
    __device__ bool next(int i, Unit& u) const { int L = i * G + c; if (L >= 256 * reps) return false; L &= 255; const int bh = L >> 5, ch = L & 31, b = bh >> 2, h = bh & 3;
        const size_t off = ((size_t)(b * SEQ + ch * 256) * 1024 + h * 256); u.A = (const char*)(Q + off); u.B = (const char*)(Kk + off); u.nt = 4; u.flags = 3; u.pm = L; u.pn = 0; u.aux = h; u.gidx = nullptr; return true; }
};
struct StateOrder {
    const bf16_t* VT; const bf16_t* KDT; int G, c, reps;
    __device__ bool next(int i, Unit& u) const { int L = i * G + c; if (L >= 2 * 8 * RCH * 2 * reps) return false; L %= 2 * 8 * RCH * 2; const int half = L & 1, r = L >> 1, dir = r / (8 * RCH), bhs = r % (8 * RCH);
        u.A = (const char*)(VT + ((size_t)bhs * 512 + half * 256) * 256); u.B = (const char*)(KDT + ((size_t)dir * 8 * RCH + bhs) * 65536); u.nt = 4; u.flags = 3; u.pm = (dir * 8 * RCH + bhs) * 2 + half; u.pn = 0; u.aux = 0; u.gidx = nullptr; return true; }
};
struct OutOrder {
    const bf16_t* P; const bf16_t* Q; const bf16_t* VT; const bf16_t* ST; int G, c, reps;
    __device__ bool next(int i, Unit& u) const { int tile = (i >> 1) * G + c; const int seg = i & 1; if (tile >= 1024 * reps) return false; tile &= 1023;
        const int half = tile & 1, ch = (tile >> 1) & 31, bh = (tile >> 6) & 7, dir = tile >> 9, b = bh >> 2, h = bh & 3;
        const size_t aoff = (size_t)(b * SEQ + ch * 256) * 1024 + h * 256;
        if (seg == 0) { u.A = (const char*)(P + (size_t)dir * NLAT * 1024 + aoff); u.B = (const char*)(VT + ((size_t)(bh * RCH + ch + 1) * 512 + half * 256) * 256); u.flags = 1; }
        else { const int slot = dir ? ch + 1 : ch; u.A = (const char*)(Q + aoff); u.B = (const char*)(ST + (((size_t)dir * 8 * RCH + bh * RCH + slot) * 512 + half * 256) * 256); u.flags = 2; }
        u.nt = 4; u.pm = tile; u.pn = 0; u.aux = 0; u.gidx = nullptr; return true; }
};
__device__ __forceinline__ float lg2gamma(const float* dec, int h) { return __log2f(1.f - __builtin_amdgcn_exp2f(-dec[h])); }

struct EpiQK1 {
    static constexpr bool PERM = false;
    bf16_t* Q; bf16_t* Kk; const f32x2* rope;
    __device__ __forceinline__ void operator()(const Acc& acc, const Unit& u, int wr, int wc, int fr_in, int fq_in) const {
        int fr = fr_in, fq = fq_in; asm volatile("" : "+v"(fr), "+v"(fq));
        const int row0 = u.pm * BM + wr * 64 + fr;
#pragma unroll
        for (int bj = 0; bj < 2; ++bj) { const int cg = u.pn * BM + bj * HALF + wc * 32, isk = cg >> 10, cq = cg & 1023, f = (cq >> 7) & 1, i0 = ((cq & 127) >> 5) * 16 + 4 * fq;
            bf16_t* dst = (isk ? Kk : Q) + cq + 4 * fq; const float sc = isk ? 0.0625f : 1.f;
#pragma unroll
            for (int ai = 0; ai < 2; ++ai)
#pragma unroll
                for (int m = 0; m < 4; ++m) { const int row = row0 + ai * HALF + m * 16, t = row & (SEQ - 1), pos = f ? (t & 63) : (t >> 6);
                    f32x4 v0 = acc[ai][bj][m][0], v1 = acc[ai][bj][m][1];
#pragma unroll
                    for (int j = 0; j < 4; ++j) { const f32x2 cs = rope[pos * 64 + i0 + j]; const float t1 = v0[j], t2 = v1[j]; v0[j] = (t1 * cs.x - t2 * cs.y) * sc; v1[j] = (t1 * cs.y + t2 * cs.x) * sc; }
                    bf16_t* o = dst + (size_t)row * 1024;
                    u32x2 w0; w0.x = cvt_pk_bf16(v0[0], v0[1]); w0.y = cvt_pk_bf16(v0[2], v0[3]); *(u32x2*)o = w0;
                    u32x2 w1; w1.x = cvt_pk_bf16(v1[0], v1[1]); w1.y = cvt_pk_bf16(v1[2], v1[3]); *(u32x2*)(o + 16) = w1; __builtin_amdgcn_sched_barrier(0); } }
    }
};
struct EpiKVT {
    static constexpr bool PERM = true;
    bf16_t* KDT; bf16_t* VT; const f32x2* rope; const float* decf; const float* decb;
    __device__ __forceinline__ void operator()(const Acc& acc, const Unit& u, int wr, int wc, int fr_in, int fq_in) const {
        int fr = fr_in, fq = fq_in; asm volatile("" : "+v"(fr), "+v"(fq));
        const int m0 = u.pn * BM; const bool lat = m0 < NLAT;
        const int b = lat ? (m0 >> 13) : ((m0 - NLAT) >> 8), slot = lat ? 1 + ((m0 & (SEQ - 1)) >> 8) : 0, t0 = m0 & (SEQ - 1);
        const int rbase = u.pm * BM + wr * 64;
#pragma unroll
        for (int ai = 0; ai < 2; ++ai) { const int rg = rbase + ai * HALF;
            if (rg < 1024) {
                const int h = rg >> 8, lgsel = h; const float lgf = lg2gamma(decf, lgsel), lgb = lg2gamma(decb, lgsel);
#pragma unroll
                for (int mp = 0; mp < 2; ++mp) { const int dk = (rg & 255) + 32 * mp + fr, f = (dk >> 7) & 1, fi = ((dk & 127) >> 5) * 16 + fr;
                    bf16_t* o1 = KDT + (((size_t)(b * 4 + h) * RCH + slot) * 256 + dk) * 256; bf16_t* o2 = o1 + 16 * 256;
#pragma unroll
                    for (int bj = 0; bj < 2; ++bj)
#pragma unroll
                        for (int n = 0; n < 2; ++n) { const int jt0 = bj * HALF + wc * 32 + 8 * fq + 4 * n; float a1[4], a2[4], df[4], db[4];
#pragma unroll
                            for (int j = 0; j < 4; ++j) { float t1 = acc[ai][bj][2 * mp][n][j], t2 = acc[ai][bj][2 * mp + 1][n][j]; const int jt = jt0 + j;
                                if (lat) { const int t = t0 + jt; const f32x2 cs = rope[(f ? (t & 63) : (t >> 6)) * 64 + fi]; const float x1 = t1 * cs.x - t2 * cs.y, x2 = t1 * cs.y + t2 * cs.x; t1 = x1; t2 = x2; }
                                a1[j] = t1 * 0.0625f; a2[j] = t2 * 0.0625f; df[j] = __builtin_amdgcn_exp2f((float)(255 - jt) * lgf); db[j] = __builtin_amdgcn_exp2f((float)jt * lgb); }
                            u32x2 w;
                            w.x = cvt_pk_bf16(a1[0] * df[0], a1[1] * df[1]); w.y = cvt_pk_bf16(a1[2] * df[2], a1[3] * df[3]); *(u32x2*)(o1 + jt0) = w;
                            w.x = cvt_pk_bf16(a2[0] * df[0], a2[1] * df[1]); w.y = cvt_pk_bf16(a2[2] * df[2], a2[3] * df[3]); *(u32x2*)(o2 + jt0) = w;
                            w.x = cvt_pk_bf16(a1[0] * db[0], a1[1] * db[1]); w.y = cvt_pk_bf16(a1[2] * db[2], a1[3] * db[3]); *(u32x2*)(o1 + (size_t)8 * RCH * 65536 + jt0) = w;
                            w.x = cvt_pk_bf16(a2[0] * db[0], a2[1] * db[1]); w.y = cvt_pk_bf16(a2[2] * db[2], a2[3] * db[3]); *(u32x2*)(o2 + (size_t)8 * RCH * 65536 + jt0) = w; __builtin_amdgcn_sched_barrier(0); } }
            } else {
                const int e0 = rg - 1024, h = e0 >> 9;
#pragma unroll
                for (int m = 0; m < 4; ++m) { const int dv = (e0 & 511) + 16 * m + fr; bf16_t* o = VT + (((size_t)(b * 4 + h) * RCH + slot) * 512 + dv) * 256 + wc * 32 + 8 * fq;
#pragma unroll
                    for (int bj = 0; bj < 2; ++bj) { const f32x4 v0 = acc[ai][bj][m][0], v1 = acc[ai][bj][m][1];
                        u32x4 w; w.x = cvt_pk_bf16(v0[0], v0[1]); w.y = cvt_pk_bf16(v0[2], v0[3]); w.z = cvt_pk_bf16(v1[0], v1[1]); w.w = cvt_pk_bf16(v1[2], v1[3]);
                        *(u32x4*)(o + bj * HALF) = w; } }
            }
        }
    }
};
struct EpiScore {
    static constexpr bool PERM = true;
    bf16_t* P; const float* decf; const float* decb;
    __device__ __forceinline__ void operator()(const Acc& acc, const Unit& u, int wr, int wc, int fr_in, int fq_in) const {
        int fr = fr_in, fq = fq_in; asm volatile("" : "+v"(fr), "+v"(fq));
        const int L = u.pm, bh = L >> 5, ch = L & 31, b = bh >> 2, h = bh & 3; const float lgf = lg2gamma(decf, h), lgb = lg2gamma(decb, h);
        bf16_t* base = P + ((size_t)(b * SEQ + ch * 256) * 1024 + h * 256);
        const int jb = wc * 32 + 8 * fq;
#pragma unroll
        for (int ai = 0; ai < 2; ++ai)
#pragma unroll
            for (int m = 0; m < 4; ++m) { const int i = ai * HALF + wr * 64 + 16 * m + fr; bf16_t* rp = base + (size_t)i * 1024 + jb; bf16_t* rpb = rp + (size_t)NLAT * 1024;
#pragma unroll
                for (int bj = 0; bj < 2; ++bj)
#pragma unroll
                    for (int n = 0; n < 2; ++n) { float pf[4], pb[4];
#pragma unroll
                        for (int j = 0; j < 4; ++j) { const int jj = jb + bj * HALF + 4 * n + j; const float a = acc[ai][bj][m][n][j];
                            pf[j] = jj <= i ? a * __builtin_amdgcn_exp2f(-(float)(jj + 1) * lgf) : 0.f; pb[j] = jj >= i ? a * __builtin_amdgcn_exp2f(-(float)(256 - jj) * lgb) : 0.f; }
                        u32x2 w; w.x = cvt_pk_bf16(pf[0], pf[1]); w.y = cvt_pk_bf16(pf[2], pf[3]); *(u32x2*)(rp + bj * HALF + 4 * n) = w;
                        w.x = cvt_pk_bf16(pb[0], pb[1]); w.y = cvt_pk_bf16(pb[2], pb[3]); *(u32x2*)(rpb + bj * HALF + 4 * n) = w; }
                __builtin_amdgcn_sched_barrier(0); }
    }
};
struct EpiRetOut {
    static constexpr bool PERM = true;
    bf16_t* OF; bf16_t* OB; const float* decf; const float* decb; float* gns;
    __device__ __forceinline__ void operator()(const Acc& acc, const Unit& u, int wr, int wc, int fr_in, int fq_in) const {
        int fr = fr_in, fq = fq_in; asm volatile("" : "+v"(fr), "+v"(fq));
        const int tile = u.pm, half = tile & 1, ch = (tile >> 1) & 31, bh = (tile >> 6) & 7, dir = tile >> 9, b = bh >> 2, h = bh & 3;
        const float lg = dir ? lg2gamma(decb, h) : lg2gamma(decf, h);
        bf16_t* base = (dir ? OB : OF) + ((size_t)(b * SEQ + ch * 256) * 2048 + h * 512 + half * 256 + wc * 32 + 8 * fq);
        float* gb = gns + (((size_t)(b * SEQ + ch * 256) * 8 + h * 2 + dir) * 8 + half * 4 + wc) * 2;
#pragma unroll
        for (int ai = 0; ai < 2; ++ai)
#pragma unroll
            for (int m = 0; m < 4; ++m) { const int i = ai * HALF + wr * 64 + 16 * m + fr; const float rs = __builtin_amdgcn_exp2f((float)(dir ? 256 - i : i + 1) * lg); float s1 = 0.f, s2 = 0.f;
#pragma unroll
                for (int bj = 0; bj < 2; ++bj) { const f32x4 v0 = acc[ai][bj][m][0] * rs, v1 = acc[ai][bj][m][1] * rs;
                    s1 += (v0[0] + v0[1]) + (v0[2] + v0[3]) + (v1[0] + v1[1]) + (v1[2] + v1[3]);
                    s2 += (v0[0] * v0[0] + v0[1] * v0[1]) + (v0[2] * v0[2] + v0[3] * v0[3]) + (v1[0] * v1[0] + v1[1] * v1[1]) + (v1[2] * v1[2] + v1[3] * v1[3]);
                    u32x4 w; w.x = cvt_pk_bf16(v0[0], v0[1]); w.y = cvt_pk_bf16(v0[2], v0[3]); w.z = cvt_pk_bf16(v1[0], v1[1]); w.w = cvt_pk_bf16(v1[2], v1[3]);
                    *(u32x4*)(base + (size_t)i * 2048 + bj * HALF) = w; }
                s1 += __shfl_xor(s1, 16); s1 += __shfl_xor(s1, 32); s2 += __shfl_xor(s2, 16); s2 += __shfl_xor(s2, 32);
                if (fq == 0) *(f32x2*)(gb + (size_t)i * 128) = (f32x2){s1, s2}; }
    }
};
struct EpiGate1 {
    static constexpr bool PERM = false;
    bf16_t* MIX; const bf16_t* OF; const bf16_t* OB; const f32x2* st;
    __device__ __forceinline__ void operator()(const Acc& acc, const Unit& u, int wr, int wc, int fr_in, int fq_in) const {
        int fr = fr_in, fq = fq_in; asm volatile("" : "+v"(fr), "+v"(fq));
        const int row0 = u.pm * BM + wr * 64 + fr;
#pragma unroll
        for (int bj = 0; bj < 2; ++bj) { const int cgi = (u.pn * BM + bj * HALF + wc * 32) >> 5, j0 = cgi * 16 + 4 * fq, h = j0 >> 9;
#pragma unroll
            for (int ai = 0; ai < 2; ++ai)
#pragma unroll
                for (int m = 0; m < 4; ++m) { const int row = row0 + ai * HALF + m * 16; const f32x2 sf = st[(size_t)row * 8 + h * 2], sb = st[(size_t)row * 8 + h * 2 + 1];
                    const u32x2 of = *(const u32x2*)(OF + (size_t)row * 2048 + j0), ob = *(const u32x2*)(OB + (size_t)row * 2048 + j0);
                    const float fo[4] = {bflo(of.x), bfhi(of.x), bflo(of.y), bfhi(of.y)}, bo[4] = {bflo(ob.x), bfhi(ob.x), bflo(ob.y), bfhi(ob.y)}; float r[4];
#pragma unroll
                    for (int j = 0; j < 4; ++j) r[j] = silu_f(acc[ai][bj][m][0][j]) * (fo[j] - sf.x) * sf.y + silu_f(acc[ai][bj][m][1][j]) * (bo[j] - sb.x) * sb.y;
                    u32x2 w; w.x = cvt_pk_bf16(r[0], r[1]); w.y = cvt_pk_bf16(r[2], r[3]); *(u32x2*)(MIX + (size_t)row * 2048 + j0) = w; } }
    }
};
}


namespace attn {
typedef float f32x16 __attribute__((ext_vector_type(16)));
constexpr int KROW = 208, VROW = 144, KBYTES = 64 * KROW, VBYTES = 64 * VROW, BUF = KBYTES + VBYTES;
__device__ __forceinline__ void unit(LAS unsigned char* lds, const bf16_t* QB, const bf16_t* KB, const bf16_t* VT, bf16_t* MIX, int b, int h, int qrow0, int nkeys, int tid) {
    const int wave = __builtin_amdgcn_readfirstlane(tid >> 6), lane = tid & 63, r32 = lane & 31, hh = lane >> 5;
    bf16x8 qf[6];
    { const bf16_t* qp = QB + (size_t)(qrow0 + 32 * wave + r32) * 768 + h * 96 + 8 * hh;
#pragma unroll
      for (int s6 = 0; s6 < 6; ++s6) qf[s6] = *(const bf16x8*)(qp + 16 * s6); }
    f32x16 o0, o1;
#pragma unroll
    for (int i = 0; i < 16; ++i) { o0[i] = 0.f; o1[i] = 0.f; }
    float mrun = -1e30f, lrun = 0.f;
    const bf16_t* kbase = KB + ((size_t)b * SKEYS * 8 + h) * 96;
    const bf16_t* vbase = VT + ((size_t)(b * 8 + h) * 64) * SKEYS;
    const int kc0 = tid, kc1 = 512 + tid;
    const int kk0 = kc0 / 12, kp0 = kc0 % 12, kk1 = kc1 / 12, kp1 = kc1 % 12, vd = tid >> 3, vp = tid & 7;
    u32x4 ra0, ra1, rav, rb0, rb1, rbv;
    const int ntile = nkeys / 64;
#define ATT_LOAD(t, r0, r1, rv_) do { const int s0 = (t) * 64; r0 = *(const u32x4*)(kbase + (size_t)(s0 + kk0) * 768 + kp0 * 8); \
        if (tid < 256) r1 = *(const u32x4*)(kbase + (size_t)(s0 + kk1) * 768 + kp1 * 8); rv_ = *(const u32x4*)(vbase + (size_t)vd * SKEYS + s0 + vp * 8); } while (0)
#define ATT_STORE(buf, r0, r1, rv_) do { LAS unsigned char* kb_ = lds + (buf) * BUF; *(LAS u32x4*)(kb_ + kk0 * KROW + kp0 * 16) = r0; \
        if (tid < 256) *(LAS u32x4*)(kb_ + kk1 * KROW + kp1 * 16) = r1; *(LAS u32x4*)(kb_ + KBYTES + vd * VROW + vp * 16) = rv_; } while (0)
    const int krow = ((r32 & 0x13) | ((r32 & 4) << 1) | ((r32 & 8) >> 1));
#define ATT_COMPUTE(t) do { \
        LAS unsigned char* kb = lds + ((t) & 1) * BUF; LAS unsigned char* vb = kb + KBYTES; \
        f32x16 s0, s1; \
        _Pragma("unroll") for (int i = 0; i < 16; ++i) { s0[i] = 0.f; s1[i] = 0.f; } \
        _Pragma("unroll") for (int s6 = 0; s6 < 6; ++s6) { \
            const bf16x8 a0 = *(const LAS bf16x8*)(kb + krow * KROW + (16 * s6 + 8 * hh) * 2); \
            const bf16x8 a1 = *(const LAS bf16x8*)(kb + (32 + krow) * KROW + (16 * s6 + 8 * hh) * 2); \
            s0 = __builtin_amdgcn_mfma_f32_32x32x16_bf16(a0, qf[s6], s0, 0, 0, 0); \
            s1 = __builtin_amdgcn_mfma_f32_32x32x16_bf16(a1, qf[s6], s1, 0, 0, 0); } \
        float mx = s0[0]; \
        _Pragma("unroll") for (int i = 1; i < 16; ++i) mx = fmaxf(mx, s0[i]); \
        _Pragma("unroll") for (int i = 0; i < 16; ++i) mx = fmaxf(mx, s1[i]); \
        mx = fmaxf(mx, __shfl_xor(mx, 32)); \
        if (__any(mx > mrun)) { const float mnew = fmaxf(mrun, mx), alpha = __builtin_amdgcn_exp2f(mrun - mnew); \
            _Pragma("unroll") for (int i = 0; i < 16; ++i) { o0[i] *= alpha; o1[i] *= alpha; } lrun *= alpha; mrun = mnew; } \
        float ps = 0.f; \
        _Pragma("unroll") for (int i = 0; i < 16; ++i) { s0[i] = __builtin_amdgcn_exp2f(s0[i] - mrun); s1[i] = __builtin_amdgcn_exp2f(s1[i] - mrun); ps += s0[i] + s1[i]; } \
        lrun += ps; \
        bf16x8 pf[4]; \
        _Pragma("unroll") for (int g = 0; g < 2; ++g) { u32x4 w0, w1; \
            w0.x = cvt_pk_bf16(s0[8 * g + 0], s0[8 * g + 1]); w0.y = cvt_pk_bf16(s0[8 * g + 2], s0[8 * g + 3]); w0.z = cvt_pk_bf16(s0[8 * g + 4], s0[8 * g + 5]); w0.w = cvt_pk_bf16(s0[8 * g + 6], s0[8 * g + 7]); \
            w1.x = cvt_pk_bf16(s1[8 * g + 0], s1[8 * g + 1]); w1.y = cvt_pk_bf16(s1[8 * g + 2], s1[8 * g + 3]); w1.z = cvt_pk_bf16(s1[8 * g + 4], s1[8 * g + 5]); w1.w = cvt_pk_bf16(s1[8 * g + 6], s1[8 * g + 7]); \
            pf[g] = __builtin_bit_cast(bf16x8, w0); pf[2 + g] = __builtin_bit_cast(bf16x8, w1); } \
        _Pragma("unroll") for (int ks = 0; ks < 4; ++ks) { \
            const bf16x8 v0 = *(const LAS bf16x8*)(vb + r32 * VROW + (16 * ks + 8 * hh) * 2); \
            const bf16x8 v1 = *(const LAS bf16x8*)(vb + (32 + r32) * VROW + (16 * ks + 8 * hh) * 2); \
            o0 = __builtin_amdgcn_mfma_f32_32x32x16_bf16(v0, pf[ks], o0, 0, 0, 0); \
            o1 = __builtin_amdgcn_mfma_f32_32x32x16_bf16(v1, pf[ks], o1, 0, 0, 0); } } while (0)
    ATT_LOAD(0, ra0, ra1, rav); ATT_STORE(0, ra0, ra1, rav);
    ATT_LOAD(1, rb0, rb1, rbv);
    __syncthreads();
    for (int t = 0; t < ntile; t += 2) {
        if (t + 2 < ntile) ATT_LOAD(t + 2, ra0, ra1, rav);
        ATT_COMPUTE(t);
        ATT_STORE(1, rb0, rb1, rbv);
        __syncthreads();
        if (t + 3 < ntile) ATT_LOAD(t + 3, rb0, rb1, rbv);
        ATT_COMPUTE(t + 1);
        if (t + 2 < ntile) ATT_STORE(0, ra0, ra1, rav);
        __syncthreads();
    }
#undef ATT_COMPUTE
#undef ATT_LOAD
#undef ATT_STORE
    const float linv = 1.f / (lrun + __shfl_xor(lrun, 32));
    bf16_t* op = MIX + (size_t)(qrow0 + 32 * wave + r32) * 1024 + h * 64 + 4 * hh;
#pragma unroll
    for (int g = 0; g < 4; ++g) {
        u32x2 w0; w0.x = cvt_pk_bf16(o0[4 * g] * linv, o0[4 * g + 1] * linv); w0.y = cvt_pk_bf16(o0[4 * g + 2] * linv, o0[4 * g + 3] * linv); *(u32x2*)(op + 8 * g) = w0;
        u32x2 w1; w1.x = cvt_pk_bf16(o1[4 * g] * linv, o1[4 * g + 1] * linv); w1.y = cvt_pk_bf16(o1[4 * g + 2] * linv, o1[4 * g + 3] * linv); *(u32x2*)(op + 32 + 8 * g) = w1;
    }
}
}


namespace rwkv {
constexpr int C = 32, NCH = SKEYS / C, NCS = 2 * NB * 8 * NCH;
constexpr int TC = 144, CT = 80;
constexpr int O_A = 0, O_B = 4608, O_K = 9216, O_R = 13824, O_BH = 18432, O_KH = 23552, O_VT = 28672, O_WT = 33792, O_UT = 38912, O_GT = 44032,
              O_AAB = 49152, O_AAK = 53248, O_ARB = 55808, O_ARK = 58368, O_TOT = 60928, O_WSUM = 61184, ITEM_BYTES = 62464;
__device__ __forceinline__ int token_row(int dir, int b, int p) {
    if (p < CTX) return NLAT + b * CTX + (dir ? CTX - 1 - p : p);
    const int t = p - CTX; return b * SEQ + (dir ? SEQ - 1 - t : t);
}
__device__ __forceinline__ f32x4 mfma16(bf16x8 a, bf16x8 b, f32x4 c) { return __builtin_amdgcn_mfma_f32_16x16x32_bf16(a, b, c, 0, 0, 0); }
__device__ __forceinline__ bf16x8 ldfrag(const LAS unsigned char* img, int stride, int row, int kbyte) { return *(const LAS bf16x8*)(img + row * stride + kbyte); }

__device__ __forceinline__ void prep_item(LAS unsigned char* L, int cs, bool valid, int tid4, int solve_base, const bf16_t* RKV, const float* LD, const bf16_t* LR, const float* k_k, const float* k_a,
                                          bf16_t* MT, bf16_t* NT, bf16_t* QC, float* Y0) {
    const int w = tid4 >> 6, lane = tid4 & 63, l15 = lane & 15, q4 = lane >> 4;
    const int chunk = cs % NCH, sq = cs / NCH, h = sq & 7, b = (sq >> 3) & 1, dir = sq >> 4;
    { const int t = tid4 >> 3, c0 = (tid4 & 7) * 8; const int m = token_row(dir, b, chunk * C + t);
      const u32x4 xr = *(const u32x4*)(RKV + (size_t)m * 1536 + h * 64 + c0), xk = *(const u32x4*)(RKV + (size_t)m * 1536 + 512 + h * 64 + c0), xv = *(const u32x4*)(RKV + (size_t)m * 1536 + 1024 + h * 64 + c0);
      const u32x4 xl = *(const u32x4*)(LR + (size_t)dir * MR * 512 + (size_t)m * 512 + h * 64 + c0);
      const float* ldp = LD + (size_t)dir * MR * 512 + (size_t)m * 512 + h * 64 + c0; const f32x4 l0 = *(const f32x4*)ldp, l1 = *(const f32x4*)(ldp + 4);
      const f32x4 kk0 = *(const f32x4*)(k_k + h * 64 + c0), kk1 = *(const f32x4*)(k_k + h * 64 + c0 + 4), ka0 = *(const f32x4*)(k_a + h * 64 + c0), ka1 = *(const f32x4*)(k_a + h * 64 + c0 + 4);
      float r[8] = {bflo(xr.x), bfhi(xr.x), bflo(xr.y), bfhi(xr.y), bflo(xr.z), bfhi(xr.z), bflo(xr.w), bfhi(xr.w)};
      float k[8] = {bflo(xk.x), bfhi(xk.x), bflo(xk.y), bfhi(xk.y), bflo(xk.z), bfhi(xk.z), bflo(xk.w), bfhi(xk.w)};
      float v[8] = {bflo(xv.x), bfhi(xv.x), bflo(xv.y), bfhi(xv.y), bflo(xv.z), bfhi(xv.z), bflo(xv.w), bfhi(xv.w)};
      float lr[8] = {bflo(xl.x), bfhi(xl.x), bflo(xl.y), bfhi(xl.y), bflo(xl.z), bfhi(xl.z), bflo(xl.w), bfhi(xl.w)};
      float ld[8] = {l0.x, l0.y, l0.z, l0.w, l1.x, l1.y, l1.z, l1.w};
      const float kkv[8] = {kk0.x, kk0.y, kk0.z, kk0.w, kk1.x, kk1.y, kk1.z, kk1.w}, kav[8] = {ka0.x, ka0.y, ka0.z, ka0.w, ka1.x, ka1.y, ka1.z, ka1.w};
      float cum[8];
#pragma unroll
      for (int j = 0; j < 8; ++j) { float x = ld[j];
#pragma unroll
          for (int d = 8; d < 64; d <<= 1) { const float y = __shfl_up(x, d); if (lane >= d) x += y; }
          cum[j] = x; }
      LAS float* wsum = (LAS float*)(L + O_WSUM);
      if (lane >= 56) {
#pragma unroll
          for (int j = 0; j < 8; ++j) wsum[w * 64 + c0 + j] = cum[j]; }
      __syncthreads();
      float tot[8];
#pragma unroll
      for (int j = 0; j < 8; ++j) { float pre = 0.f, all = 0.f;
#pragma unroll
          for (int ww = 0; ww < 4; ++ww) { const float x = wsum[ww * 64 + c0 + j]; all += x; pre += (ww < w) ? x : 0.f; }
          cum[j] += pre; tot[j] = all; }
      if (t == 0) {
#pragma unroll
          for (int j = 0; j < 8; ++j) ((LAS float*)(L + O_TOT))[c0 + j] = tot[j]; }
      float x2 = 0.f; float xs[8];
#pragma unroll
      for (int j = 0; j < 8; ++j) { xs[j] = k[j] * kkv[j]; x2 += xs[j] * xs[j]; }
      x2 += __shfl_xor(x2, 1); x2 += __shfl_xor(x2, 2); x2 += __shfl_xor(x2, 4);
      const float inv = 1.f / fmaxf(sqrtf(x2), 1e-12f);
      float ia[8], ib[8], ik[8], ir[8], hb[8], hk[8];
#pragma unroll
      for (int j = 0; j < 8; ++j) { const float kkn = xs[j] * inv, bb = kkn * lr[j], kd = k[j] * (1.f + (lr[j] - 1.f) * kav[j]);
          const float ec = __expf(cum[j]), ece = __expf(cum[j] - ld[j]), em = __expf(-cum[j]), eh = __expf(tot[j] - cum[j]);
          ia[j] = -kkn * ece; ib[j] = bb * em; ik[j] = kd * em; ir[j] = r[j] * ec; hb[j] = bb * eh; hk[j] = kd * eh; }
      u32x4 wv;
      wv.x = cvt_pk_bf16(ia[0], ia[1]); wv.y = cvt_pk_bf16(ia[2], ia[3]); wv.z = cvt_pk_bf16(ia[4], ia[5]); wv.w = cvt_pk_bf16(ia[6], ia[7]); *(LAS u32x4*)(L + O_A + t * TC + c0 * 2) = wv;
      wv.x = cvt_pk_bf16(ib[0], ib[1]); wv.y = cvt_pk_bf16(ib[2], ib[3]); wv.z = cvt_pk_bf16(ib[4], ib[5]); wv.w = cvt_pk_bf16(ib[6], ib[7]); *(LAS u32x4*)(L + O_B + t * TC + c0 * 2) = wv;
      wv.x = cvt_pk_bf16(ik[0], ik[1]); wv.y = cvt_pk_bf16(ik[2], ik[3]); wv.z = cvt_pk_bf16(ik[4], ik[5]); wv.w = cvt_pk_bf16(ik[6], ik[7]); *(LAS u32x4*)(L + O_K + t * TC + c0 * 2) = wv;
      wv.x = cvt_pk_bf16(ir[0], ir[1]); wv.y = cvt_pk_bf16(ir[2], ir[3]); wv.z = cvt_pk_bf16(ir[4], ir[5]); wv.w = cvt_pk_bf16(ir[6], ir[7]); *(LAS u32x4*)(L + O_R + t * TC + c0 * 2) = wv;
#pragma unroll
      for (int j = 0; j < 8; ++j) { *(LAS unsigned short*)(L + O_BH + (c0 + j) * CT + t * 2) = (unsigned short)f2bf(hb[j]); *(LAS unsigned short*)(L + O_KH + (c0 + j) * CT + t * 2) = (unsigned short)f2bf(hk[j]);
          *(LAS unsigned short*)(L + O_VT + (c0 + j) * CT + t * 2) = (unsigned short)f2bf(v[j]); }
    }
    __syncthreads();
    { const int offI = (w == 0 || w == 2) ? O_B : O_K, offT = (w < 2) ? O_A : O_R; const bool strict = w < 2;
#pragma unroll
      for (int mi = 0; mi < 2; ++mi)
#pragma unroll
          for (int nt = 0; nt < 2; ++nt) { f32x4 d = {0.f, 0.f, 0.f, 0.f};
#pragma unroll
              for (int ks = 0; ks < 2; ++ks) d = mfma16(ldfrag(L + offI, TC, 16 * mi + l15, (32 * ks + 8 * q4) * 2), ldfrag(L + offT, TC, 16 * nt + l15, (32 * ks + 8 * q4) * 2), d);
              const int t = 16 * nt + l15, i0 = 16 * mi + 4 * q4;
#pragma unroll
              for (int j = 0; j < 4; ++j) { const int i = i0 + j; if (strict ? !(i < t) : !(i <= t)) d[j] = 0.f; }
              if (w == 0) *(LAS f32x4*)(L + O_AAB + t * 128 + i0 * 4) = d;
              else { u32x2 o; o.x = cvt_pk_bf16(d[0], d[1]); o.y = cvt_pk_bf16(d[2], d[3]); *(LAS u32x2*)(L + (w == 1 ? O_AAK : w == 2 ? O_ARB : O_ARK) + t * CT + i0 * 2) = o; } }
    }
    __syncthreads();
    {
#pragma unroll
      for (int mt = 0; mt < 2; ++mt) { f32x4 d = {0.f, 0.f, 0.f, 0.f};
          d = mfma16(ldfrag(L + O_AAK, CT, 16 * mt + l15, 16 * q4), ldfrag(L + O_VT, CT, 16 * w + l15, 16 * q4), d);
          u32x2 o; o.x = cvt_pk_bf16(d[0], d[1]); o.y = cvt_pk_bf16(d[2], d[3]); *(LAS u32x2*)(L + O_GT + (16 * w + l15) * CT + (16 * mt + 4 * q4) * 2) = o; }
    }
    __syncthreads();
    const int sw = w - solve_base;
    if (sw == 0 || sw == 1) {
        float x[32];
        if (sw == 0) {
#pragma unroll
            for (int t = 0; t < 32; ++t) x[t] = bf2f(*(const LAS unsigned short*)(L + O_A + t * TC + lane * 2));
        } else {
#pragma unroll
            for (int g = 0; g < 4; ++g) { const u32x4 y = *(const LAS u32x4*)(L + O_GT + lane * CT + g * 16);
                x[8 * g + 0] = bflo(y.x); x[8 * g + 1] = bfhi(y.x); x[8 * g + 2] = bflo(y.y); x[8 * g + 3] = bfhi(y.y); x[8 * g + 4] = bflo(y.z); x[8 * g + 5] = bfhi(y.z); x[8 * g + 6] = bflo(y.w); x[8 * g + 7] = bfhi(y.w); }
        }
#pragma unroll
        for (int t = 1; t < 32; ++t) { float acc = x[t];
#pragma unroll
            for (int i4 = 0; i4 < (t + 3) / 4; ++i4) { const f32x4 a = *(const LAS f32x4*)(L + O_AAB + t * 128 + i4 * 16);
                acc += a.x * x[4 * i4]; if (4 * i4 + 1 < t) acc += a.y * x[4 * i4 + 1]; if (4 * i4 + 2 < t) acc += a.z * x[4 * i4 + 2]; if (4 * i4 + 3 < t) acc += a.w * x[4 * i4 + 3]; }
            x[t] = acc; }
        LAS unsigned char* dst = L + (sw == 0 ? O_WT : O_UT) + lane * CT;
#pragma unroll
        for (int g = 0; g < 4; ++g) { u32x4 o; o.x = cvt_pk_bf16(x[8 * g], x[8 * g + 1]); o.y = cvt_pk_bf16(x[8 * g + 2], x[8 * g + 3]); o.z = cvt_pk_bf16(x[8 * g + 4], x[8 * g + 5]); o.w = cvt_pk_bf16(x[8 * g + 6], x[8 * g + 7]);
            *(LAS u32x4*)(dst + g * 16) = o; }
    }
    __syncthreads();
    if (valid) {
        const int kb = w >> 1, hf = w & 1;
#pragma unroll
        for (int nt = 0; nt < 2; ++nt) { f32x4 d = {0.f, 0.f, 0.f, 0.f};
            d = mfma16(ldfrag(L + O_WT, CT, 16 * w + l15, 16 * q4), ldfrag(L + O_ARB, CT, 16 * nt + l15, 16 * q4), d);
            const int t = 16 * nt + l15; const u32x2 rr = *(const LAS u32x2*)(L + O_R + t * TC + (16 * w + 4 * q4) * 2);
            u32x2 o; o.x = cvt_pk_bf16(d[0] + bflo(rr.x), d[1] + bfhi(rr.x)); o.y = cvt_pk_bf16(d[2] + bflo(rr.y), d[3] + bfhi(rr.y));
            *(u32x2*)(QC + (size_t)cs * 2048 + t * 64 + 32 * kb + 8 * q4 + 4 * hf) = o; }
#pragma unroll
        for (int mt = 0; mt < 2; ++mt) { f32x4 d = {0.f, 0.f, 0.f, 0.f};
            d = mfma16(ldfrag(L + O_ARK, CT, 16 * mt + l15, 16 * q4), ldfrag(L + O_VT, CT, 16 * w + l15, 16 * q4), d);
            d = mfma16(ldfrag(L + O_ARB, CT, 16 * mt + l15, 16 * q4), ldfrag(L + O_UT, CT, 16 * w + l15, 16 * q4), d);
            *(f32x4*)(Y0 + (size_t)cs * 2048 + ((w * 2 + mt) * 64 + lane) * 4) = d; }
#pragma unroll
        for (int m1 = 0; m1 < 4; ++m1) { f32x4 d = {0.f, 0.f, 0.f, 0.f};
            d = mfma16(ldfrag(L + O_WT, CT, 16 * m1 + l15, 16 * q4), ldfrag(L + O_BH, CT, 16 * w + l15, 16 * q4), d);
            const int c2 = 16 * w + l15, c1 = 16 * m1 + 4 * q4;
#pragma unroll
            for (int j = 0; j < 4; ++j) if (c1 + j == c2) d[j] += __expf(((const LAS float*)(L + O_TOT))[c2]);
            u32x2 o; o.x = cvt_pk_bf16(d[0], d[1]); o.y = cvt_pk_bf16(d[2], d[3]);
            *(u32x2*)(MT + (size_t)cs * 4096 + c2 * 64 + 32 * (m1 >> 1) + 8 * q4 + 4 * (m1 & 1)) = o; }
#pragma unroll
        for (int mc = 0; mc < 4; ++mc) { f32x4 d = {0.f, 0.f, 0.f, 0.f};
            d = mfma16(ldfrag(L + O_BH, CT, 16 * mc + l15, 16 * q4), ldfrag(L + O_UT, CT, 16 * w + l15, 16 * q4), d);
            d = mfma16(ldfrag(L + O_KH, CT, 16 * mc + l15, 16 * q4), ldfrag(L + O_VT, CT, 16 * w + l15, 16 * q4), d);
            u32x2 o; o.x = cvt_pk_bf16(d[0], d[1]); o.y = cvt_pk_bf16(d[2], d[3]);
            *(u32x2*)(NT + (size_t)cs * 4096 + ((w * 4 + mc) * 64 + lane) * 4) = o; }
    }
    __syncthreads();
}

constexpr int RING = 8;
struct StateData { bf16x8 mf[4][2]; u32x2 nt[4]; };
struct OutData { bf16x8 qf[2][2]; f32x4 y0[2]; };
__device__ __forceinline__ void state_load(StateData& d, size_t cs, int slab, int lane, const bf16_t* MT, const bf16_t* NT) {
    const int l15 = lane & 15, q4 = lane >> 4;
#pragma unroll
    for (int mt = 0; mt < 4; ++mt)
#pragma unroll
        for (int kb = 0; kb < 2; ++kb) d.mf[mt][kb] = *(const bf16x8*)(MT + cs * 4096 + (16 * mt + l15) * 64 + 32 * kb + 8 * q4);
#pragma unroll
    for (int mc = 0; mc < 4; ++mc) d.nt[mc] = *(const u32x2*)(NT + cs * 4096 + ((slab * 4 + mc) * 64 + lane) * 4);
}
__device__ __forceinline__ void state_step(const StateData& d, bf16x8 (&sb)[2], int ch, int lane, LAS unsigned char* ring, volatile LAS int* prog, volatile LAS int* ydone) {
    { int guard = 0; while (ch >= *ydone + RING && guard < (1 << 22)) { __builtin_amdgcn_s_sleep(1); ++guard; } }
    LAS bf16x8* slot = (LAS bf16x8*)(ring + (ch & (RING - 1)) * 2048) + lane * 2;
    slot[0] = sb[0]; slot[1] = sb[1];
    __builtin_amdgcn_fence(__ATOMIC_RELEASE, "workgroup");
    if (lane == 0) *prog = ch + 1;
    f32x4 an[4];
#pragma unroll
    for (int mc = 0; mc < 4; ++mc) an[mc] = (f32x4){bflo(d.nt[mc].x), bfhi(d.nt[mc].x), bflo(d.nt[mc].y), bfhi(d.nt[mc].y)};
#pragma unroll
    for (int kb = 0; kb < 2; ++kb)
#pragma unroll
        for (int mt = 0; mt < 4; ++mt) an[mt] = mfma16(d.mf[mt][kb], sb[kb], an[mt]);
#pragma unroll
    for (int kb = 0; kb < 2; ++kb) { u32x4 o; o.x = cvt_pk_bf16(an[2 * kb][0], an[2 * kb][1]); o.y = cvt_pk_bf16(an[2 * kb][2], an[2 * kb][3]); o.z = cvt_pk_bf16(an[2 * kb + 1][0], an[2 * kb + 1][1]); o.w = cvt_pk_bf16(an[2 * kb + 1][2], an[2 * kb + 1][3]);
        sb[kb] = __builtin_bit_cast(bf16x8, o); }
}
__device__ __forceinline__ void state_wave(int sq, int slab, int lane, const bf16_t* MT, const bf16_t* NT, LAS unsigned char* ring, volatile LAS int* prog, volatile LAS int* ydone) {
    bf16x8 sb[2]; { const u32x4 z = {0u, 0u, 0u, 0u}; sb[0] = __builtin_bit_cast(bf16x8, z); sb[1] = sb[0]; }
    const size_t cs0 = (size_t)sq * NCH;
    StateData d0, d1, d2, d3;
    state_load(d0, cs0, slab, lane, MT, NT); state_load(d1, cs0 + 1, slab, lane, MT, NT); state_load(d2, cs0 + 2, slab, lane, MT, NT); state_load(d3, cs0 + 3, slab, lane, MT, NT);
    for (int ch = 0; ch < NCH; ch += 4) {
        const size_t nb = cs0 + (ch + 4 < NCH ? ch + 4 : ch);
        state_step(d0, sb, ch, lane, ring, prog, ydone);     state_load(d0, nb, slab, lane, MT, NT);
        state_step(d1, sb, ch + 1, lane, ring, prog, ydone); state_load(d1, nb + 1, slab, lane, MT, NT);
        state_step(d2, sb, ch + 2, lane, ring, prog, ydone); state_load(d2, nb + 2, slab, lane, MT, NT);
        state_step(d3, sb, ch + 3, lane, ring, prog, ydone); state_load(d3, nb + 3, slab, lane, MT, NT);
    }
}
__device__ __forceinline__ void out_load(OutData& d, size_t cs, int slab, int lane, const bf16_t* QC, const float* Y) {
    const int l15 = lane & 15, q4 = lane >> 4;
#pragma unroll
    for (int mt = 0; mt < 2; ++mt)
#pragma unroll
        for (int kb = 0; kb < 2; ++kb) d.qf[mt][kb] = *(const bf16x8*)(QC + cs * 2048 + (16 * mt + l15) * 64 + 32 * kb + 8 * q4);
#pragma unroll
    for (int mt = 0; mt < 2; ++mt) d.y0[mt] = *(const f32x4*)(Y + cs * 2048 + ((slab * 2 + mt) * 64 + lane) * 4);
}
__device__ __forceinline__ void out_step(const OutData& d, size_t cs, int ch, int slab, int lane, bf16_t* YS, const LAS unsigned char* ring, volatile LAS int* prog, volatile LAS int* ydone) {
    { int guard = 0; while (*prog <= ch && guard < (1 << 22)) { __builtin_amdgcn_s_sleep(1); ++guard; } }
    __builtin_amdgcn_fence(__ATOMIC_ACQUIRE, "workgroup");
    const LAS bf16x8* slot = (const LAS bf16x8*)(ring + (ch & (RING - 1)) * 2048) + lane * 2;
    const bf16x8 s0 = slot[0], s1 = slot[1];
    f32x4 ay[2] = {d.y0[0], d.y0[1]};
#pragma unroll
    for (int mt = 0; mt < 2; ++mt) { ay[mt] = mfma16(d.qf[mt][0], s0, ay[mt]); ay[mt] = mfma16(d.qf[mt][1], s1, ay[mt]); }
    __builtin_amdgcn_fence(__ATOMIC_RELEASE, "workgroup");
    if (lane == 0) *ydone = ch + 1;
#pragma unroll
    for (int mt = 0; mt < 2; ++mt) { u32x2 o; o.x = cvt_pk_bf16(ay[mt][0], ay[mt][1]); o.y = cvt_pk_bf16(ay[mt][2], ay[mt][3]); *(u32x2*)(YS + cs * 2048 + ((slab * 2 + mt) * 64 + lane) * 4) = o; }
}
__device__ __forceinline__ void out_wave(int sq, int slab, int lane, const bf16_t* QC, const float* Y, bf16_t* YS, const LAS unsigned char* ring, volatile LAS int* prog, volatile LAS int* ydone) {
    const size_t cs0 = (size_t)sq * NCH;
    OutData d0, d1, d2;
    out_load(d0, cs0, slab, lane, QC, Y); out_load(d1, cs0 + 1, slab, lane, QC, Y); out_load(d2, cs0 + 2, slab, lane, QC, Y);
    for (int ch = 0; ch < NCH; ch += 3) {
        const size_t nb = cs0 + (ch + 3 < NCH ? ch + 3 : ch);
        out_step(d0, cs0 + ch, ch, slab, lane, YS, ring, prog, ydone);         out_load(d0, nb, slab, lane, QC, Y);
        out_step(d1, cs0 + ch + 1, ch + 1, slab, lane, YS, ring, prog, ydone); out_load(d1, nb + 1, slab, lane, QC, Y);
        out_step(d2, cs0 + ch + 2, ch + 2, slab, lane, YS, ring, prog, ydone); out_load(d2, nb + 2, slab, lane, QC, Y);
    }
}
}

constexpr int NWAVES = 8;
struct Frame {
    LAS unsigned char* lds; volatile LAS unsigned* MISC; unsigned* ctl;
    int tid, lane, wave, vcu, G;
    float* out; unsigned char* ws;
};
enum { I_X = 0, I_C, I_CTX, I_CCTX,
       I0_MODW, I0_MODB, I0_WIN, I0_QNORM, I0_WQUP, I0_KVNORM, I0_WKVUP, I0_CONV, I0_W0F, I0_W2F, I0_W0B, I0_W2B, I0_A0F, I0_A2F, I0_A0B, I0_A2B, I0_G2,
       I0_KK, I0_KA, I0_RK, I0_LNXG, I0_LNXB, I0_WOUT, I0_LN1G, I0_LN1B, I0_FFG, I0_FFU, I0_FFD, I0_LN2G, I0_LN2B,
       I1_MODW, I1_MODB, I1_WIN, I1_DECF, I1_DECB, I1_WOUT, I1_LN1G, I1_LN1B, I1_ROUTER, I1_MOEG, I1_MOEU, I1_MOED, I1_LN2G, I1_LN2B, N_IN };

template <class RowMap>
__device__ __forceinline__ void transpose_item(const float* W, int ldw, int k0, int n0, bf16_t* WT, int ldt, int kofs, const RowMap& rm, LAS float* scr, int lane) {
#pragma unroll 8
    for (int i = 0; i < 32; ++i) { const int kk = 2 * i + (lane >> 5); scr[kk * 33 + (lane & 31)] = W[(size_t)(k0 + kk) * ldw + n0 + (lane & 31)]; }
    asm volatile("s_waitcnt lgkmcnt(0)" ::: "memory");
    const int c = lane & 7;
#pragma unroll
    for (int j = 0; j < 4; ++j) { const int n = (lane >> 3) + 8 * j; const LAS float* s = scr + (8 * c) * 33 + n;
        u32x4 o; o.x = pk2(s[0 * 33], s[1 * 33]); o.y = pk2(s[2 * 33], s[3 * 33]); o.z = pk2(s[4 * 33], s[5 * 33]); o.w = pk2(s[6 * 33], s[7 * 33]);
        *(u32x4*)(WT + (size_t)rm(n0 + n) * ldt + kofs + k0 + 8 * c) = o; }
    asm volatile("s_waitcnt lgkmcnt(0)" ::: "memory");
}
struct RmPlain { int off; __device__ int operator()(int n) const { return off + n; } };
struct RmGU { int off; __device__ int operator()(int n) const { return off + (n >> 7) * 256 + (n & 127); } };

struct RmRope1 { int off; __device__ int operator()(int n) const { const int hf = n & ~127, u = n & 127, i = u & 63; return off + hf + (i >> 4) * 32 + (u >= 64 ? 16 : 0) + (i & 15); } };
struct RmGate1 { __device__ int operator()(int n) const { const int j = n & 2047, isb = n >> 11; return 4096 + (j >> 4) * 32 + isb * 16 + (j & 15); } };
struct RmMlaQ { __device__ int operator()(int n) const { const int h = n / 96, u = n % 96; if (u < 64) return h * 96 + u; const int up = u - 64, f = up >> 4, w = up & 15, i = w & 7, sec = w >> 3; return h * 96 + 64 + sec * 16 + f * 8 + i; } };
struct RmKV2 { __device__ int operator()(int n) const { const int h = n >> 7, d = n & 127; return d < 64 ? h * 64 + d : 512 + h * 64 + (d - 64); } };
struct RmMlaKV { __device__ int operator()(int n) const { const int h = n >> 7, d = n & 127; return d < 64 ? 768 + h * 64 + d : 1280 + h * 64 + (d - 64); } };
__device__ __forceinline__ void sincos_tab(double a, float& sn, float& cs) {
    const double k = rint(a * 0.63661977236758134308);
    const double r = (a - k * 1.57079632679489655800) - k * 6.123233995736766e-17;
    const int q = ((int)k) & 3; const double r2 = r * r;
    const double sv = r * (1.0 - r2 / 6.0 * (1.0 - r2 / 20.0 * (1.0 - r2 / 42.0 * (1.0 - r2 / 72.0 * (1.0 - r2 / 110.0 * (1.0 - r2 / 156.0))))));
    const double cv = 1.0 - r2 / 2.0 * (1.0 - r2 / 12.0 * (1.0 - r2 / 30.0 * (1.0 - r2 / 56.0 * (1.0 - r2 / 90.0 * (1.0 - r2 / 132.0)))));
    const double ss = (q == 0) ? sv : (q == 1) ? cv : (q == 2) ? -sv : -cv;
    const double cc = (q == 0) ? cv : (q == 1) ? -sv : (q == 2) ? -cv : sv;
    sn = (float)ss; cs = (float)cc;
}
__device__ __forceinline__ void rope_tables(Frame& F) {
    f32x2* t0 = (f32x2*)(F.ws + WS_SMALL + SM_ROPE0); f32x2* t1 = (f32x2*)(F.ws + WS_SMALL + SM_ROPE1);
    const int gt = (F.vcu * NWAVES + F.wave) * 64 + F.lane, NGT = F.G * NWAVES * 64;
    for (int i = gt; i < 128 * 8 + 128 * 64; i += NGT) {
        const bool first = i < 1024; const int j = first ? i : i - 1024, nf = first ? 8 : 64, pos = j / nf, fi = j % nf;
        const float invf = (float)exp2(-(double)fi / (double)nf * 13.287712379549449);
        const float ang = (float)pos * invf; float sn, cs; sincos_tab((double)ang, sn, cs);
        (first ? t0 : t1)[j] = (f32x2){cs, sn};
    }
}
template <class RowMap>
__device__ __forceinline__ void convert_matrix(Frame& F, int& cursor, const float* W, int K, int N, int ldw, bf16_t* WT, int ldt, int kofs, const RowMap& rm, int gw = -1, int NGW = 0) {
    LAS float* scr = (LAS float*)(F.lds + F.wave * 16384);
    if (gw < 0) { gw = F.vcu * NWAVES + F.wave; NGW = F.G * NWAVES; }
    const int nblk = N / 32, nit = (K / 64) * nblk;
    int first = (gw - cursor % NGW + NGW) % NGW;
    for (int it = first; it < nit; it += NGW) transpose_item(W, ldw, 64 * (it / nblk), 32 * (it % nblk), WT, ldt, kofs, rm, scr, F.lane);
    cursor += nit;
}
__device__ __forceinline__ void zero_rect(Frame& F, bf16_t* base, int ld, int r0, int nr, int c0, int nc) {
    const int per_row = nc / 8, total = nr * per_row, gt = (F.vcu * NWAVES + F.wave) * 64 + F.lane, NGT = F.G * NWAVES * 64;
    for (int i = gt; i < total; i += NGT) { const int r = i / per_row, c = (i % per_row) * 8; *(u32x4*)(base + (size_t)(r0 + r) * ld + c0 + c) = (u32x4){0u, 0u, 0u, 0u}; }
}

__device__ __forceinline__ void mod_vectors(Frame& F, const float* modw0, const float* modb0, const float* modw1, const float* modb1, const float* cvec, const float* cctx) {
    if (blockIdx.x >= 96) return;
    const int layer = blockIdx.x / 48, cb = blockIdx.x % 48;
    const float* W = layer ? modw1 : modw0; const float* bias = layer ? modb1 : modb0;
    LAS float* sc = (LAS float*)F.lds;
    LAS float* red = sc + 3 * 1024;
    for (int i = F.tid; i < 3 * 1024; i += 512) { const int cls = i / 1024, k = i % 1024; const float v = cls < 2 ? cvec[cls * 1024 + k] : cctx[k]; sc[i] = silu_f(v); }
    __syncthreads();
    const int col = cb * 128 + 2 * F.lane;
    float a[3][2] = {{0.f, 0.f}, {0.f, 0.f}, {0.f, 0.f}};
    for (int k = F.wave * 128; k < F.wave * 128 + 128; ++k) {
        const f32x2 w = *(const f32x2*)(W + (size_t)k * 6144 + col);
#pragma unroll
        for (int c = 0; c < 3; ++c) { const float s = sc[c * 1024 + k]; a[c][0] += s * w.x; a[c][1] += s * w.y; }
    }
#pragma unroll
    for (int c = 0; c < 3; ++c) { red[(F.wave * 3 + c) * 128 + 2 * F.lane] = a[c][0]; red[(F.wave * 3 + c) * 128 + 2 * F.lane + 1] = a[c][1]; }
    __syncthreads();
    float* mod = (float*)(F.ws + WS_SMALL + SM_MOD) + (size_t)layer * 3 * 6144;
    if (F.tid < 384) { const int c = F.tid / 128, j = F.tid % 128; float s = bias[cb * 128 + j];
#pragma unroll
        for (int w = 0; w < 8; ++w) s += red[(w * 3 + c) * 128 + j];
        mod[c * 6144 + cb * 128 + j] = s; }
    __syncthreads();
}

struct Row4 { f32x4 v[4]; };
__device__ __forceinline__ Row4 row_load(const float* p, int lane) { Row4 r; const f32x4* q = (const f32x4*)p + lane;
#pragma unroll
    for (int j = 0; j < 4; ++j) r.v[j] = q[64 * j]; return r; }
__device__ __forceinline__ void row_store(float* p, int lane, const Row4& r) { f32x4* q = (f32x4*)p + lane;
#pragma unroll
    for (int j = 0; j < 4; ++j) q[64 * j] = r.v[j]; }
__device__ __forceinline__ void row_store_bf16(bf16_t* p, int lane, const Row4& r) { u32x2* q = (u32x2*)p + lane;
#pragma unroll
    for (int j = 0; j < 4; ++j) { u32x2 w; w.x = pk2(r.v[j].x, r.v[j].y); w.y = pk2(r.v[j].z, r.v[j].w); q[64 * j] = w; } }
__device__ __forceinline__ Row4 row_ln(const Row4& a, const float* g, const float* b, int lane) {
    float s = 0.f;
#pragma unroll
    for (int j = 0; j < 4; ++j) s += (a.v[j].x + a.v[j].y) + (a.v[j].z + a.v[j].w);
    const float mean = wave_sum(s) * (1.f / DM); float s2 = 0.f; Row4 d;
#pragma unroll
    for (int j = 0; j < 4; ++j) { d.v[j] = a.v[j] - mean; s2 += (d.v[j].x * d.v[j].x + d.v[j].y * d.v[j].y) + (d.v[j].z * d.v[j].z + d.v[j].w * d.v[j].w); }
    const float rstd = 1.f / sqrtf(wave_sum(s2) * (1.f / DM) + LN_EPS);
    const Row4 gg = row_load(g, lane), bb = row_load(b, lane); Row4 o;
#pragma unroll
    for (int j = 0; j < 4; ++j) o.v[j] = d.v[j] * rstd * gg.v[j] + bb.v[j];
    return o;
}
__device__ __forceinline__ void ctx_fix(Row4& p, const float* part, int nsl, int lane) {
#pragma unroll
    for (int j = 0; j < 4; ++j) p.v[j] = p.v[j] * ALPHA;
    for (int sl = 0; sl < nsl; ++sl) { const Row4 q = row_load(part + (size_t)sl * NCTX * 1024, lane);
#pragma unroll
        for (int j = 0; j < 4; ++j) p.v[j] = p.v[j] + q.v[j]; }
}
__device__ __forceinline__ Row4 row_mod(const Row4& a, const float* shift, const float* scale, int lane) {
    const Row4 sh = row_load(shift, lane), sc = row_load(scale, lane); Row4 o;
#pragma unroll
    for (int j = 0; j < 4; ++j) o.v[j] = a.v[j] * (sc.v[j] + 1.f) + sh.v[j];
    return o;
}

struct Args { const float* in[N_IN]; float* out; unsigned char* ws; int ph_lo, ph_hi; };
constexpr int N_PHASES = 32;

__global__ void __launch_bounds__(NWAVES * 64, 2) mk_fwd(Args args) {
    extern __shared__ __attribute__((aligned(16))) unsigned char lds_raw[];
    Frame F;
    F.lds = (LAS unsigned char*)lds_raw; F.MISC = (volatile LAS unsigned*)(F.lds + MISC_OFF);
    F.tid = threadIdx.x; F.lane = F.tid & 63; F.wave = __builtin_amdgcn_readfirstlane(F.tid >> 6);
    F.G = gridDim.x; { const int bx = blockIdx.x; F.vcu = (F.G % 8 == 0) ? (bx % 8) * (F.G / 8) + bx / 8 : bx; }
    F.out = args.out; F.ws = args.ws; F.ctl = (unsigned*)(args.ws + WS_CTL);
    for (int u = F.tid; u < (LDS_BYTES - LDSCTL_OFF) / 4; u += NWAVES * 64) ((LAS unsigned*)(F.lds + LDSCTL_OFF))[u] = 0u;
    __syncthreads();
    XcdBarrier bar = xcd_barrier_post(F.ctl + CW_BAR, F.MISC + 8);
    const int lo = args.ph_lo, hi = args.ph_hi;
#ifndef ONLY_PH
#define ONLY_PH -1
#endif
#define IN(k) ((ONLY_PH < 0 || ONLY_PH == (k)) && lo <= (k) && (k) < hi)
#define INP(i) (args.in[i])
#ifndef DBL_PH
#define DBL_PH -1
#endif
#define REPS(k) (((k) == DBL_PH) ? 2 : 1)
#define SEAM(k) do { if (IN(k) && IN((k) + 1)) xcd_barrier(bar); } while (0)
    unsigned char* ws = args.ws;
    const float* mod0 = (const float*)(ws + WS_SMALL + SM_MOD);
    const float* mod1 = mod0 + 3 * 6144;
    const int gw = F.vcu * NWAVES + F.wave, NGW = F.G * NWAVES;

    if (IN(0)) {
        for (int r_ = 0; r_ < REPS(0); ++r_) mod_vectors(F, INP(I0_MODW), INP(I0_MODB), INP(I1_MODW), INP(I1_MODB), INP(I_C), INP(I_CCTX));
        int cur = 0;
        if (DBL_PH == 29) for (int r_ = 0; r_ < 2; ++r_) { convert_matrix(F, cur, INP(I1_WIN), 1024, 1024, ODD_IN, (bf16_t*)(ws + WS_W1IN), 1024, 0, RmRope1{0}); convert_matrix(F, cur, INP(I1_WIN) + 4096, 1024, 4096, ODD_IN, (bf16_t*)(ws + WS_W1IN), 1024, 0, RmGate1{}); convert_matrix(F, cur, INP(I0_FFD), FF, 1024, 1024, (bf16_t*)(ws + WS_W0DN), FF, 0, RmPlain{0}); }
        rope_tables(F);
        if (blockIdx.x == 100) { float* b4 = (float*)(ws + WS_SMALL + SM_BIAS4); b4[F.tid] = INP(I0_W0F)[F.tid]; b4[512 + F.tid] = INP(I0_W0B)[F.tid]; b4[1024 + F.tid] = INP(I0_A0F)[F.tid]; b4[1536 + F.tid] = INP(I0_A0B)[F.tid]; }
        convert_matrix(F, cur, INP(I0_WIN), 1024, E_IN, E_IN, (bf16_t*)(ws + WS_W0IN), 1024, 0, RmPlain{0});
        zero_rect(F, (bf16_t*)(ws + WS_W0IN), 1024, E_IN, E_INP - E_IN, 0, 1024);
        convert_matrix(F, cur, INP(I0_WQUP), 256, 768, 768, (bf16_t*)(ws + WS_WMLAQ), 256, 0, RmMlaQ{});
        convert_matrix(F, cur, INP(I0_WKVUP), 128, 1024, 1024, (bf16_t*)(ws + WS_WKV), 128, 0, RmKV2{});
        { bf16_t* WL = (bf16_t*)(ws + WS_WLORA);
          convert_matrix(F, cur, INP(I0_W2F), 64, 512, 512, WL, 128, 0, RmPlain{0});
          convert_matrix(F, cur, INP(I0_W2B), 64, 512, 512, WL, 128, 0, RmPlain{512});
          convert_matrix(F, cur, INP(I0_A2F), 64, 512, 512, WL, 128, 0, RmPlain{1024});
          convert_matrix(F, cur, INP(I0_A2B), 64, 512, 512, WL, 128, 0, RmPlain{1536});
          convert_matrix(F, cur, INP(I0_G2), 128, 512, 512, WL, 128, 0, RmPlain{2048});
          zero_rect(F, WL, 128, 0, 2048, 64, 64); }
    }
    SEAM(0);


    if (IN(1)) {
        for (int m_ = gw; m_ < MR * REPS(1); m_ += NGW) { const int m = m_ % MR;
            const Row4 xr = row_load(m < NLAT ? INP(I_X) + (size_t)m * 1024 : INP(I_CTX) + (size_t)(m - NLAT) * 1024, F.lane);
            const float* md = mod0 + (size_t)row_class(m) * 6144;
            row_store_bf16((bf16_t*)(ws + WS_XMOD) + (size_t)m * 1024, F.lane, row_mod(xr, md, md + 1024, F.lane));
        }
    }
    SEAM(1);

    if (IN(2)) {
        pg8::DenseOrder S; S.init((const bf16_t*)(ws + WS_XMOD), 1024, (const bf16_t*)(ws + WS_W0IN), 1024, MR, E_INP, 1024, F.G, (int)blockIdx.x); S.reps = REPS(2);
        pg8::EpiBf16 E{(bf16_t*)(ws + WS_Z0), E_INP};
        pg8::gemm_phase<pg8::EpiBf16, pg8::DenseOrder, true, false>(F.lds, 1024, 1024, S, E);
    }
    SEAM(2);

    if (IN(3)) {
        LAS unsigned short* wscr = (LAS unsigned short*)(F.lds + F.wave * 128);
        const f32x2* rope0 = (const f32x2*)(ws + WS_SMALL + SM_ROPE0);
        bf16_t* AM = (bf16_t*)(ws + WS_AMLA); bf16_t* AL = (bf16_t*)(ws + WS_ALORA); bf16_t* RKV = (bf16_t*)(ws + WS_RKV); bf16_t* KBp = (bf16_t*)(ws + WS_KB);
        const float* convw = INP(I0_CONV);
        for (int m_ = gw; m_ < MR * REPS(3); m_ += NGW) { const int m = m_ % MR;
            const bf16_t* Z = (const bf16_t*)(ws + WS_Z0) + (size_t)m * E_INP;
            const bool lat = m < NLAT;
            const int b = lat ? (m >> 13) : ((m - NLAT) >> 8), tpos = lat ? (m & (SEQ - 1)) : ((m - NLAT) & (CTX - 1)), slen = lat ? SEQ : CTX;
            { const u32x2 w = *(const u32x2*)(Z + 4 * F.lane); const float v0 = bflo(w.x), v1 = bfhi(w.x), v2 = bflo(w.y), v3 = bfhi(w.y);
              const float r = rsqrtf(wave_sum(v0 * v0 + v1 * v1 + v2 * v2 + v3 * v3) * (1.f / 256.f) + 1e-6f);
              const f32x4 g = *(const f32x4*)(INP(I0_QNORM) + 4 * F.lane);
              u32x2 o; o.x = pk2(v0 * r * g.x, v1 * r * g.y); o.y = pk2(v2 * r * g.z, v3 * r * g.w); *(u32x2*)(AM + (size_t)m * 384 + 4 * F.lane) = o; }
            { const unsigned w = *(const unsigned*)(Z + 256 + 2 * F.lane); const float v0 = bflo(w), v1 = bfhi(w);
              const float r = rsqrtf(wave_sum(v0 * v0 + v1 * v1) * (1.f / 128.f) + 1e-6f);
              const f32x2 g = *(const f32x2*)(INP(I0_KVNORM) + 2 * F.lane);
              *(unsigned*)(AM + (size_t)m * 384 + 256 + 2 * F.lane) = pk2(v0 * r * g.x, v1 * r * g.y); }
            { if (F.lane < 16) { const int f = F.lane >> 3, i = F.lane & 7; const float t1 = bf2f(Z[384 + f * 16 + i]), t2 = bf2f(Z[384 + f * 16 + i + 8]);
                  float o1 = t1, o2 = t2;
                  if (lat) { const f32x2 cs = rope0[(f ? (tpos & 63) : (tpos >> 6)) * 8 + i]; o1 = t1 * cs.x - t2 * cs.y; o2 = t1 * cs.y + t2 * cs.x; }
                  wscr[F.lane] = (unsigned short)f2bf(o1); wscr[16 + F.lane] = (unsigned short)f2bf(o2); }
              asm volatile("s_waitcnt lgkmcnt(0)" ::: "memory");
              if (F.lane < 32) { const u32x4 c = *(const LAS u32x4*)((const LAS unsigned char*)wscr + (F.lane & 3) * 16);
                  const int sk = lat ? CTX + tpos : tpos;
                  *(u32x4*)(KBp + ((size_t)(b * SKEYS + sk) * 8 + (F.lane >> 2)) * 96 + 64 + (F.lane & 3) * 8) = c; }
              asm volatile("s_waitcnt lgkmcnt(0)" ::: "memory"); }
            { const bf16_t* R0 = Z + 416; const bool hp = tpos > 0, hn = tpos < slen - 1;
#pragma unroll
              for (int g = 0; g < 3; ++g) { const int c = 8 * (F.lane + 64 * g);
                  const u32x4 xc = *(const u32x4*)(R0 + c);
                  const u32x4 xp = hp ? *(const u32x4*)(R0 - E_INP + c) : (u32x4){0u, 0u, 0u, 0u};
                  const u32x4 xn = hn ? *(const u32x4*)(R0 + E_INP + c) : (u32x4){0u, 0u, 0u, 0u};
                  float o[8];
#pragma unroll
                  for (int q = 0; q < 2; ++q) { const f32x4 w0 = *(const f32x4*)(convw + c + 4 * q), w1 = *(const f32x4*)(convw + 1536 + c + 4 * q), w2 = *(const f32x4*)(convw + 3072 + c + 4 * q);
                      const unsigned p0 = q ? xp.z : xp.x, p1 = q ? xp.w : xp.y, c0 = q ? xc.z : xc.x, c1 = q ? xc.w : xc.y, n0 = q ? xn.z : xn.x, n1 = q ? xn.w : xn.y;
                      o[4 * q + 0] = bflo(p0) * w0.x + bflo(c0) * w1.x + bflo(n0) * w2.x; o[4 * q + 1] = bfhi(p0) * w0.y + bfhi(c0) * w1.y + bfhi(n0) * w2.y;
                      o[4 * q + 2] = bflo(p1) * w0.z + bflo(c1) * w1.z + bflo(n1) * w2.z; o[4 * q + 3] = bfhi(p1) * w0.w + bfhi(c1) * w1.w + bfhi(n1) * w2.w; }
                  u32x4 w; w.x = pk2(o[0], o[1]); w.y = pk2(o[2], o[3]); w.z = pk2(o[4], o[5]); w.w = pk2(o[6], o[7]);
                  *(u32x4*)(RKV + (size_t)m * 1536 + c) = w; } }
            { if (F.lane < 48) { const u32x4 x = *(const u32x4*)(Z + 1952 + 8 * F.lane); float v[8] = {bflo(x.x), bfhi(x.x), bflo(x.y), bfhi(x.y), bflo(x.z), bfhi(x.z), bflo(x.w), bfhi(x.w)};
#pragma unroll
                  for (int j = 0; j < 8; ++j) { if (F.lane < 16) { const float e = __expf(2.f * v[j]); v[j] = 1.f - 2.f / (e + 1.f); } else if (F.lane >= 32) v[j] = sigmoid_f(v[j]); }
                  u32x4 w; w.x = pk2(v[0], v[1]); w.y = pk2(v[2], v[3]); w.z = pk2(v[4], v[5]); w.w = pk2(v[6], v[7]);
                  *(u32x4*)(AL + (size_t)m * 384 + 8 * F.lane) = w; } }
        }
    }
    SEAM(3);

    if (IN(4)) {
        { pg8::BlockOrder S{(const bf16_t*)(ws + WS_ALORA), (const bf16_t*)(ws + WS_WLORA), 384, 128, 128, MR / 256, 2, 5, 64, F.G, (int)blockIdx.x, REPS(4)};
          pg8::EpiLora E{(float*)(ws + WS_LDF), (bf16_t*)(ws + WS_LRF), (const float*)(ws + WS_SMALL + SM_BIAS4)};
          pg8::gemm_phase<pg8::EpiLora, pg8::BlockOrder, true, false>(F.lds, 384, 128, S, E); }
        { pg8::EpiMlaQK E{(bf16_t*)(ws + WS_QB), (bf16_t*)(ws + WS_KB), (const f32x2*)(ws + WS_SMALL + SM_ROPE0), 0.10206207261596577f * 1.4426950408889634f};
          { pg8::DenseOrder S; S.init((const bf16_t*)(ws + WS_AMLA), 384, (const bf16_t*)(ws + WS_WMLAQ), 256, MR, 768, 256, F.G, (int)blockIdx.x); S.reps = REPS(4);
            pg8::gemm_phase<pg8::EpiMlaQK, pg8::DenseOrder, true, false>(F.lds, 384, 256, S, E); }
          { pg8::BlockOrder S{(const bf16_t*)(ws + WS_AMLA) + 256 - 3 * 0, (const bf16_t*)(ws + WS_WKV) - (size_t)3 * 256 * 128, 384, 128, 128, MR / 256, 2, 1, 0, F.G, (int)blockIdx.x, REPS(4)}; S.nblk = 1;
            pg8::gemm_phase<pg8::EpiMlaQK, pg8::KnopeOrder, true, false>(F.lds, 384, 128, pg8::KnopeOrder{S}, E); } }
        { pg8::DenseOrder S; S.init((const bf16_t*)(ws + WS_WKV) + (size_t)512 * 128, 128, (const bf16_t*)(ws + WS_AMLA) + 256, 384, 512, MR, 128, F.G, (int)blockIdx.x); S.reps = REPS(4);
          pg8::EpiVT E{(bf16_t*)(ws + WS_VT)};
          pg8::gemm_phase<pg8::EpiVT, pg8::DenseOrder, true, false>(F.lds, 128, 384, S, E); }
    }
    SEAM(4);


    if (IN(5)) {
        const int grp = F.tid >> 8, tid4 = F.tid & 255;
        for (int it0 = F.vcu * 2 + grp; it0 < ((rwkv::NCS * REPS(5) + 2 * F.G - 1) / (2 * F.G)) * 2 * F.G; it0 += 2 * F.G) {
            const bool valid = it0 < rwkv::NCS * REPS(5); const int it = it0 % rwkv::NCS; const int cs = valid ? it : rwkv::NCS - 1;
            rwkv::prep_item(F.lds + grp * rwkv::ITEM_BYTES, cs, valid, tid4, 2 * grp, (const bf16_t*)(ws + WS_RKV), (const float*)(ws + WS_LDF), (const bf16_t*)(ws + WS_LRF), INP(I0_KK), INP(I0_KA),
                            (bf16_t*)(ws + WS_MT), (bf16_t*)(ws + WS_NT), (bf16_t*)(ws + WS_QC), (float*)(ws + WS_Y0));
        }
    }
    SEAM(5);

    if (IN(6)) {
        const bf16_t* QBp = (const bf16_t*)(ws + WS_QB); const bf16_t* KBp = (const bf16_t*)(ws + WS_KB); const bf16_t* VTp = (const bf16_t*)(ws + WS_VT); bf16_t* MIX = (bf16_t*)(ws + WS_MIX0);
        for (int uu = F.vcu; uu < (512 + 32) * REPS(6); uu += F.G) { const int u = uu % 544; if (u >= 512 && !(u & 1)) continue;
            if (u < 512) { const int bh = u >> 5, qb = u & 31, b = bh >> 3, h = bh & 7; attn::unit(F.lds, QBp, KBp, VTp, MIX, b, h, b * SEQ + qb * 256, SKEYS, F.tid); }
            else { const int bh = (u - 512) >> 1, b = bh >> 3, h = bh & 7; attn::unit(F.lds, QBp, KBp, VTp, MIX, b, h, NLAT + b * CTX, CTX, F.tid); }
        }
        __syncthreads();
        { volatile LAS int* prog = (volatile LAS int*)(F.lds + 0);
          if (F.tid == 0) { *prog = 0; *(prog + 16) = 0; }
          __syncthreads();
          if ((F.vcu & 1) == 0) { const int k = F.vcu >> 1; volatile LAS int* ydone = prog + 16; LAS unsigned char* ring = F.lds + 1024;
              if (F.wave == 0) rwkv::state_wave(k >> 2, k & 3, F.lane, (const bf16_t*)(ws + WS_MT), (const bf16_t*)(ws + WS_NT), ring, prog, ydone);
              else if (F.wave == 1) rwkv::out_wave(k >> 2, k & 3, F.lane, (const bf16_t*)(ws + WS_QC), (const float*)(ws + WS_Y0), (bf16_t*)(ws + WS_YS), ring, prog, ydone);
          }
          if (F.vcu & 1) {
              const int gwo = (F.vcu >> 1) * NWAVES + F.wave, NGWo = (F.G >> 1) * NWAVES; int cur = 0;
              convert_matrix(F, cur, INP(I0_WOUT), 1024, 1024, 1024, (bf16_t*)(ws + WS_W0OUT), 1024, 0, RmPlain{0}, gwo, NGWo);
              convert_matrix(F, cur, INP(I0_FFG), 1024, FF, FF, (bf16_t*)(ws + WS_W0GU), 1024, 0, RmGU{0}, gwo, NGWo);
              convert_matrix(F, cur, INP(I0_FFU), 1024, FF, FF, (bf16_t*)(ws + WS_W0GU), 1024, 0, RmGU{128}, gwo, NGWo);
              convert_matrix(F, cur, INP(I0_FFD), FF, 1024, 1024, (bf16_t*)(ws + WS_W0DN), FF, 0, RmPlain{0}, gwo, NGWo);
              convert_matrix(F, cur, INP(I1_WOUT), RET_VD, 1024, 1024, (bf16_t*)(ws + WS_W1OUT), RET_VD, 0, RmPlain{0}, gwo, NGWo);
              convert_matrix(F, cur, INP(I1_WIN), 1024, 1024, ODD_IN, (bf16_t*)(ws + WS_W1IN), 1024, 0, RmRope1{0}, gwo, NGWo);
              convert_matrix(F, cur, INP(I1_WIN) + 1024, 1024, 1024, ODD_IN, (bf16_t*)(ws + WS_W1IN), 1024, 0, RmRope1{1024}, gwo, NGWo);
              convert_matrix(F, cur, INP(I1_WIN) + 2048, 1024, 2048, ODD_IN, (bf16_t*)(ws + WS_W1IN), 1024, 0, RmPlain{2048}, gwo, NGWo);
              convert_matrix(F, cur, INP(I1_WIN) + 4096, 1024, 4096, ODD_IN, (bf16_t*)(ws + WS_W1IN), 1024, 0, RmGate1{}, gwo, NGWo); } }
    }
    SEAM(6);

    if (IN(7)) {
        const bf16_t* Y = (const bf16_t*)(ws + WS_YS); const bf16_t* RKV = (const bf16_t*)(ws + WS_RKV); const bf16_t* LRF = (const bf16_t*)(ws + WS_LRF); const bf16_t* GG = (const bf16_t*)(ws + WS_GG);
        const float* k_a = INP(I0_KA); const float* r_k = INP(I0_RK); const float* lnx_g = INP(I0_LNXG); const float* lnx_b = INP(I0_LNXB);
        for (int m_ = gw; m_ < MR * REPS(7); m_ += NGW) { const int m = m_ % MR;
            const bool lat = m < NLAT; const int b = lat ? (m >> 13) : ((m - NLAT) >> 8), tp = lat ? (m & (SEQ - 1)) : ((m - NLAT) & (CTX - 1));
            const int pf = lat ? CTX + tp : tp, pb = lat ? CTX + (SEQ - 1 - tp) : (CTX - 1 - tp);
            const int tf = pf & 31, tb = pb & 31, lo_ = ((F.lane >> 4) * 2) * 256 + (F.lane & 15) * 4;
            const size_t yfo = ((size_t)((0 * 2 + b) * 8) * rwkv::NCH + (pf >> 5)) * 2048 + lo_ + (tf >> 4) * 256 + ((tf & 15) >> 2) * 64 + (tf & 3);
            const size_t ybo = ((size_t)((1 * 2 + b) * 8) * rwkv::NCH + (pb >> 5)) * 2048 + lo_ + (tb >> 4) * 256 + ((tb & 15) >> 2) * 64 + (tb & 3);
            unsigned short ry[8][8];
#pragma unroll
            for (int h = 0; h < 8; ++h) { const int ch = h * 64 + F.lane;
                ry[h][0] = Y[yfo + (size_t)h * rwkv::NCH * 2048]; ry[h][1] = Y[ybo + (size_t)h * rwkv::NCH * 2048];
                ry[h][2] = RKV[(size_t)m * 1536 + ch]; ry[h][3] = RKV[(size_t)m * 1536 + 512 + ch]; ry[h][4] = RKV[(size_t)m * 1536 + 1024 + ch];
                ry[h][5] = LRF[(size_t)m * 512 + ch]; ry[h][6] = LRF[(size_t)MR * 512 + (size_t)m * 512 + ch]; ry[h][7] = GG[(size_t)m * 512 + ch]; }
            float res[8];
#pragma unroll
            for (int h = 0; h < 8; ++h) { const int ch = h * 64 + F.lane;
                const float ys = bf2f(ry[h][0]) + bf2f(ry[h][1]), mean = wave_sum(ys) * (1.f / 64.f), dv = ys - mean, var = wave_sum(dv * dv) * (1.f / 64.f);
                const float yn = dv * rsqrtf(var + 64e-5f) * lnx_g[ch] + lnx_b[ch];
                const float r = bf2f(ry[h][2]), k = bf2f(ry[h][3]), v = bf2f(ry[h][4]), lf = bf2f(ry[h][5]), lb = bf2f(ry[h][6]);
                const float ksum = k * (2.f + (lf + lb - 2.f) * k_a[ch]);
                const float bonus = wave_sum(r * ksum * r_k[ch]) * v;
                res[h] = (yn + bonus) * bf2f(ry[h][7]); }
#pragma unroll
            for (int h = 0; h < 8; ++h) ((bf16_t*)(ws + WS_MIX0))[(size_t)m * 1024 + 512 + h * 64 + F.lane] = (bf16_t)f2bf(res[h]);
        }
    }
    SEAM(7);

    if (IN(8)) {
        { pg8::DenseOrder S; S.init((const bf16_t*)(ws + WS_MIX0), 1024, (const bf16_t*)(ws + WS_W0OUT), 1024, NLAT, 1024, 1024, F.G, (int)blockIdx.x); S.reps = REPS(8);
          pg8::EpiResGate E{(float*)(ws + WS_PRE), INP(I_X), mod0 + 2 * 1024, 1024, 0};
          pg8::gemm_phase<pg8::EpiResGate, pg8::DenseOrder, true, false>(F.lds, 1024, 1024, S, E); }
        { pg8::CtxSliceOrder S{(const bf16_t*)(ws + WS_MIX0) + (size_t)NLAT * 1024, (const bf16_t*)(ws + WS_W0OUT), 1024, 1024, 4, 4, F.G, (int)blockIdx.x, REPS(8)};
          pg8::EpiCtxPart E{(float*)(ws + WS_PART8), mod0 + 2 * 6144 + 2 * 1024};
          pg8::gemm_phase<pg8::EpiCtxPart, pg8::CtxSliceOrder, true, false>(F.lds, 1024, 1024, S, E); }
    }
    SEAM(8);

    if (IN(9)) {
        for (int m_ = gw; m_ < MR * REPS(9); m_ += NGW) { const int m = m_ % MR;
            const bool isctx = m >= NLAT;
            Row4 p = row_load(isctx ? INP(I_CTX) + (size_t)(m - NLAT) * 1024 : (const float*)(ws + WS_PRE) + (size_t)m * 1024, F.lane);
            if (isctx) ctx_fix(p, (const float*)(ws + WS_PART8) + (size_t)(m - NLAT) * 1024, 4, F.lane);
            const Row4 x1 = row_ln(p, INP(I0_LN1G), INP(I0_LN1B), F.lane);
            row_store((float*)(ws + WS_X1) + (size_t)m * 1024, F.lane, x1);
            const float* md = mod0 + (size_t)row_class(m) * 6144;
            row_store_bf16((bf16_t*)(ws + WS_XMOD) + (size_t)m * 1024, F.lane, row_mod(x1, md + 3 * 1024, md + 4 * 1024, F.lane));
        }
    }
    SEAM(9);

    if (IN(10)) {
        pg8::DenseOrder S; S.init((const bf16_t*)(ws + WS_XMOD), 1024, (const bf16_t*)(ws + WS_W0GU), 1024, MR, 2 * FF, 1024, F.G, (int)blockIdx.x); S.reps = REPS(10);
        pg8::EpiSwiGLU E{(bf16_t*)(ws + WS_HFF), FF};
        pg8::gemm_phase<pg8::EpiSwiGLU, pg8::DenseOrder, true, false>(F.lds, 1024, 1024, S, E);
    }
    SEAM(10);

    if (IN(11)) {
        { pg8::DenseOrder S; S.init((const bf16_t*)(ws + WS_HFF), FF, (const bf16_t*)(ws + WS_W0DN), FF, NLAT, 1024, FF, F.G, (int)blockIdx.x); S.reps = REPS(11);
          pg8::EpiResGate E{(float*)(ws + WS_PRE), (const float*)(ws + WS_X1), mod0 + 5 * 1024, 1024, 0};
          pg8::gemm_phase<pg8::EpiResGate, pg8::DenseOrder, true, false>(F.lds, FF, FF, S, E); }
        { pg8::CtxSliceOrder S{(const bf16_t*)(ws + WS_HFF) + (size_t)NLAT * FF, (const bf16_t*)(ws + WS_W0DN), FF, FF, 4, 11, F.G, (int)blockIdx.x, REPS(11)};
          pg8::EpiCtxPart E{(float*)(ws + WS_PART11), mod0 + 2 * 6144 + 5 * 1024};
          pg8::gemm_phase<pg8::EpiCtxPart, pg8::CtxSliceOrder, true, false>(F.lds, FF, FF, S, E); }
    }
    SEAM(11);

    if (IN(12)) {
        for (int m_ = gw; m_ < MR * REPS(12); m_ += NGW) { const int m = m_ % MR;
            const bool isctx = m >= NLAT;
            Row4 p = row_load((const float*)(ws + (isctx ? WS_X1 : WS_PRE)) + (size_t)m * 1024, F.lane);
            if (isctx) ctx_fix(p, (const float*)(ws + WS_PART11) + (size_t)(m - NLAT) * 1024, 11, F.lane);
            const Row4 x2 = row_ln(p, INP(I0_LN2G), INP(I0_LN2B), F.lane);
            float* dst = m < NLAT ? F.out + (size_t)m * 1024 : (float*)(ws + WS_XC2) + (size_t)(m - NLAT) * 1024;
            row_store(dst, F.lane, x2);
            const float* md = mod1 + (size_t)row_class(m) * 6144;
            row_store_bf16((bf16_t*)(ws + WS_XMOD1) + (size_t)m * 1024, F.lane, row_mod(x2, md, md + 1024, F.lane));
        }
    }
    SEAM(12);


    if (IN(13)) {
        { pg8::DenseOrder S; S.init((const bf16_t*)(ws + WS_XMOD1), 1024, (const bf16_t*)(ws + WS_W1IN), 1024, NLAT, 2048, 1024, F.G, (int)blockIdx.x); S.reps = REPS(13);
          pg8::EpiQK1 E{(bf16_t*)(ws + WS_Q1), (bf16_t*)(ws + WS_K1), (const f32x2*)(ws + WS_SMALL + SM_ROPE1)};
          pg8::gemm_phase<pg8::EpiQK1, pg8::DenseOrder, true, false>(F.lds, 1024, 1024, S, E); }
        { pg8::DenseOrder S; S.init((const bf16_t*)(ws + WS_W1IN) + (size_t)1024 * 1024, 1024, (const bf16_t*)(ws + WS_XMOD1), 1024, 3072, MR, 1024, F.G, (int)blockIdx.x); S.reps = REPS(13);
          pg8::EpiKVT E{(bf16_t*)(ws + WS_KDT), (bf16_t*)(ws + WS_VT1), (const f32x2*)(ws + WS_SMALL + SM_ROPE1), INP(I1_DECF), INP(I1_DECB)};
          pg8::gemm_phase<pg8::EpiKVT, pg8::DenseOrder, true, false>(F.lds, 1024, 1024, S, E); }
    }
    SEAM(13);

    if (IN(14)) {
#ifndef SKIP_SCORE
        { pg8::ScoreOrder S{(const bf16_t*)(ws + WS_Q1), (const bf16_t*)(ws + WS_K1), F.G, (int)blockIdx.x, REPS(14)};
          pg8::EpiScore E{(bf16_t*)(ws + WS_PFB), INP(I1_DECF), INP(I1_DECB)};
          pg8::gemm_phase<pg8::EpiScore, pg8::ScoreOrder, true, false>(F.lds, 1024, 1024, S, E); }
#endif
#ifndef SKIP_STATE
        { pg8::StateOrder S{(const bf16_t*)(ws + WS_VT1), (const bf16_t*)(ws + WS_KDT), F.G, (int)blockIdx.x, REPS(14)};
          pg8::EpiBf16 E{(bf16_t*)(ws + WS_ST), 256};
          pg8::gemm_phase<pg8::EpiBf16, pg8::StateOrder, true, false>(F.lds, 256, 256, S, E); }
#endif
    }
    SEAM(14);

    if (IN(15)) {
        const int gt = gw * 64 + F.lane, NGT = NGW * 64; bf16_t* ST = (bf16_t*)(ws + WS_ST);
        for (int it = gt; it < 2 * 8 * 16384; it += NGT) { const int e8 = it & 16383, bh = (it >> 14) & 7, dir = it >> 17, h = bh & 3;
            const float g256 = exp2f(256.f * pg8::lg2gamma(dir ? INP(I1_DECB) : INP(I1_DECF), h));
            bf16_t* p = ST + ((size_t)dir * 8 * RCH + bh * RCH) * 131072 + (size_t)e8 * 8;
            float run[8]; { const u32x4 x = *(const u32x4*)p; run[0] = bflo(x.x); run[1] = bfhi(x.x); run[2] = bflo(x.y); run[3] = bfhi(x.y); run[4] = bflo(x.z); run[5] = bfhi(x.z); run[6] = bflo(x.w); run[7] = bfhi(x.w); }
#pragma unroll 1
            for (int g8 = 0; g8 < 4; ++g8) {
                u32x4 x[8];
#pragma unroll
                for (int q = 0; q < 8; ++q) { const int sl = dir ? RCH - 1 - (8 * g8 + q) : 1 + 8 * g8 + q; x[q] = *(const u32x4*)(p + (size_t)sl * 131072); }
#pragma unroll
                for (int q = 0; q < 8; ++q) { const int sl = dir ? RCH - 1 - (8 * g8 + q) : 1 + 8 * g8 + q;
                    const float kv[8] = {bflo(x[q].x), bfhi(x[q].x), bflo(x[q].y), bfhi(x[q].y), bflo(x[q].z), bfhi(x[q].z), bflo(x[q].w), bfhi(x[q].w)};
                    if (dir) { u32x4 w; w.x = pk2(run[0], run[1]); w.y = pk2(run[2], run[3]); w.z = pk2(run[4], run[5]); w.w = pk2(run[6], run[7]); *(u32x4*)(p + (size_t)sl * 131072) = w; }
#pragma unroll
                    for (int j = 0; j < 8; ++j) run[j] = run[j] * g256 + kv[j];
                    if (!dir) { u32x4 w; w.x = pk2(run[0], run[1]); w.y = pk2(run[2], run[3]); w.z = pk2(run[4], run[5]); w.w = pk2(run[6], run[7]); *(u32x4*)(p + (size_t)sl * 131072) = w; } } }
        }
    }
    SEAM(15);

    if (IN(16)) {
        pg8::OutOrder S{(const bf16_t*)(ws + WS_PFB), (const bf16_t*)(ws + WS_Q1), (const bf16_t*)(ws + WS_VT1), (const bf16_t*)(ws + WS_ST), F.G, (int)blockIdx.x, REPS(16)};
        pg8::EpiRetOut E{(bf16_t*)(ws + WS_OF), (bf16_t*)(ws + WS_OB), INP(I1_DECF), INP(I1_DECB), (float*)(ws + WS_GNP)};
        pg8::gemm_phase<pg8::EpiRetOut, pg8::OutOrder, true, false>(F.lds, 1024, 256, S, E);
    }
    SEAM(16);

    if (IN(17)) {
        const int gt = gw * 64 + F.lane, NGT = NGW * 64; const f32x4* gp = (const f32x4*)(ws + WS_GNP); f32x2* st = (f32x2*)(ws + WS_GNS);
        for (int i = gt; i < NLAT * 8; i += NGT) { float s1 = 0.f, s2 = 0.f;
#pragma unroll
            for (int q = 0; q < 4; ++q) { const f32x4 v = gp[(size_t)i * 4 + q]; s1 += v.x + v.z; s2 += v.y + v.w; }
            const float mean = s1 * (1.f / 512.f); st[i] = (f32x2){mean, rsqrtf(fmaxf(s2 * (1.f / 512.f) - mean * mean, 0.f) + 1e-6f)}; }
    }
    SEAM(17);

    if (IN(18)) {
        pg8::DenseOrder S; S.init((const bf16_t*)(ws + WS_XMOD1), 1024, (const bf16_t*)(ws + WS_W1IN) + (size_t)4096 * 1024, 1024, NLAT, 4096, 1024, F.G, (int)blockIdx.x); S.reps = REPS(18);
        pg8::EpiGate1 E{(bf16_t*)(ws + WS_MIX1), (const bf16_t*)(ws + WS_OF), (const bf16_t*)(ws + WS_OB), (const f32x2*)(ws + WS_GNS)};
        pg8::gemm_phase<pg8::EpiGate1, pg8::DenseOrder, true, false>(F.lds, 1024, 1024, S, E);
    }
    SEAM(18);

    if (IN(19)) {
        pg8::DenseOrder S; S.init((const bf16_t*)(ws + WS_MIX1), RET_VD, (const bf16_t*)(ws + WS_W1OUT), RET_VD, NLAT, 1024, RET_VD, F.G, (int)blockIdx.x); S.reps = REPS(19);
        pg8::EpiResGate E{F.out, F.out, mod1 + 2 * 1024, 1024, 0};
        pg8::gemm_phase<pg8::EpiResGate, pg8::DenseOrder, true, false>(F.lds, RET_VD, RET_VD, S, E);
    }
    SEAM(19);

    if (IN(20)) {
        const float* router = INP(I1_ROUTER);
        int* tok_e = (int*)(ws + WS_SMALL + SM_TOKE); float* tok_g = (float*)(ws + WS_SMALL + SM_TOKG); int* tok_p = (int*)(ws + WS_SMALL + SM_TOKP);
        LAS unsigned* lcnt = (LAS unsigned*)(F.lds + 64); LAS unsigned* lbase = lcnt + 8;
        if (F.tid < 8) lcnt[F.tid] = 0u;
        __syncthreads();
        for (int m = gw; m < NLAT; m += NGW) {
            const Row4 p = row_load(F.out + (size_t)m * 1024, F.lane);
            const Row4 x3 = row_ln(p, INP(I1_LN1G), INP(I1_LN1B), F.lane);
            row_store(F.out + (size_t)m * 1024, F.lane, x3);
            const float* md = mod1 + (size_t)row_class(m) * 6144;
            const Row4 h = row_mod(x3, md + 3 * 1024, md + 4 * 1024, F.lane);
            row_store_bf16((bf16_t*)(ws + WS_HMOE) + (size_t)m * 1024, F.lane, h);
            float lg[8] = {0.f, 0.f, 0.f, 0.f, 0.f, 0.f, 0.f, 0.f};
#pragma unroll
            for (int j = 0; j < 4; ++j)
#pragma unroll
                for (int q = 0; q < 4; ++q) { const int k = 4 * F.lane + 256 * j + q; const f32x4 r0 = *(const f32x4*)(router + (size_t)k * 8), r1 = *(const f32x4*)(router + (size_t)k * 8 + 4); const float hv = h.v[j][q];
                    lg[0] += hv * r0.x; lg[1] += hv * r0.y; lg[2] += hv * r0.z; lg[3] += hv * r0.w; lg[4] += hv * r1.x; lg[5] += hv * r1.y; lg[6] += hv * r1.z; lg[7] += hv * r1.w; }
#pragma unroll
            for (int e = 0; e < 8; ++e) lg[e] = wave_sum(lg[e]);
            int e0 = 0; float v0 = lg[0];
#pragma unroll
            for (int e = 1; e < 8; ++e) if (lg[e] > v0) { v0 = lg[e]; e0 = e; }
            int e1 = -1; float v1 = -3.0e38f;
#pragma unroll
            for (int e = 0; e < 8; ++e) if (e != e0 && lg[e] > v1) { v1 = lg[e]; e1 = e; }
            const float g0 = 1.f / (1.f + __expf(v1 - v0));
            if (F.lane == 0) {
                const int p0 = (int)__hip_atomic_fetch_add(lcnt + e0, 1u, __ATOMIC_RELAXED, __HIP_MEMORY_SCOPE_WORKGROUP), p1 = (int)__hip_atomic_fetch_add(lcnt + e1, 1u, __ATOMIC_RELAXED, __HIP_MEMORY_SCOPE_WORKGROUP);
                tok_e[2 * m] = e0; tok_e[2 * m + 1] = e1; tok_g[2 * m] = g0; tok_g[2 * m + 1] = 1.f - g0; tok_p[2 * m] = p0; tok_p[2 * m + 1] = p1; }
        }
        __syncthreads();
        if (F.tid < 8) lbase[F.tid] = atomicAdd(F.ctl + CW_MOECNT + 64 * F.tid, lcnt[F.tid]);
        __syncthreads();
        for (int m = gw; m < NLAT; m += NGW) { if (F.lane < 2) { const int i = 2 * m + F.lane; tok_p[i] += (int)lbase[tok_e[i]]; } }
        __syncthreads();
        int cur = 0;
        for (int e_ = 0; e_ < 8 * REPS(20); ++e_) { const int e = e_ & 7;
            convert_matrix(F, cur, INP(I1_MOEG) + (size_t)e * 1024 * DFE, 1024, DFE, DFE, (bf16_t*)(ws + WS_MOEGU) + (size_t)e * 2 * DFE * 1024, 1024, 0, RmGU{0});
            convert_matrix(F, cur, INP(I1_MOEU) + (size_t)e * 1024 * DFE, 1024, DFE, DFE, (bf16_t*)(ws + WS_MOEGU) + (size_t)e * 2 * DFE * 1024, 1024, 0, RmGU{128});
            convert_matrix(F, cur, INP(I1_MOED) + (size_t)e * DFE * 1024, DFE, 1024, 1024, (bf16_t*)(ws + WS_MOEDN) + (size_t)e * 1024 * DFE, DFE, 0, RmPlain{0});
        }
    }
    SEAM(20);

    if (IN(21)) {
        int* tok_e = (int*)(ws + WS_SMALL + SM_TOKE); int* tok_p = (int*)(ws + WS_SMALL + SM_TOKP); int* slot_tok = (int*)(ws + WS_SMALL + SM_SLOT);
        int pst[8], cn[8]; { int bs = 0;
#pragma unroll
            for (int e = 0; e < 8; ++e) { cn[e] = (int)__hip_atomic_load(F.ctl + CW_MOECNT + 64 * e, RLX_AGENT); pst[e] = bs; bs += ((cn[e] + 255) >> 8) << 8; } }
        const int gt = gw * 64 + F.lane, NGT = NGW * 64;
        for (int i = gt; i < 2 * NLAT; i += NGT) { const int e = tok_e[i]; int ps = 0;
#pragma unroll
            for (int j = 0; j < 8; ++j) ps = (e == j) ? pst[j] : ps;
            const int slot = ps + tok_p[i]; ((int*)(ws + WS_SMALL + SM_TOKS))[i] = slot; slot_tok[slot] = i >> 1; }
        if (gt < 8 * 256) { const int e = gt >> 8, j = gt & 255; int ps = 0, c = 0;
#pragma unroll
            for (int q = 0; q < 8; ++q) { ps = (e == q) ? pst[q] : ps; c = (e == q) ? cn[q] : c; }
            if (c + j < (((c + 255) >> 8) << 8)) slot_tok[ps + c + j] = 0; }
    }
    SEAM(21);

#define MOE_HALF_PHASES(PHGU, PHDN, B0_, B1_) \
    if (IN(PHGU)) { pg8::MoeOrder S; S.A = (const char*)(ws + WS_HMOE); S.W = (const char*)(ws + WS_MOEGU); S.slot_tok = (const int*)(ws + WS_SMALL + SM_SLOT); S.wstride = (size_t)2 * DFE * 1024 * 2; \
        S.lda = 1024; S.ldb = 1024; S.K = 1024; S.npn = 2 * DFE / 256; S.G = F.G; S.c = (int)blockIdx.x; S.gather = true; S.reps = REPS(PHGU); S.init(F.ctl + CW_MOECNT, B0_, B1_); \
        pg8::EpiSwiGLU E{(bf16_t*)(ws + WS_HMID), DFE}; \
        pg8::gemm_phase<pg8::EpiSwiGLU, pg8::MoeOrder, true, true>(F.lds, 1024, 1024, S, E); } \
    SEAM(PHGU); \
    if (IN(PHDN)) { pg8::MoeOrder S; S.A = (const char*)(ws + WS_HMID); S.W = (const char*)(ws + WS_MOEDN); S.slot_tok = (const int*)(ws + WS_SMALL + SM_SLOT); S.wstride = (size_t)1024 * DFE * 2; \
        S.lda = DFE; S.ldb = DFE; S.K = DFE; S.npn = 4; S.G = F.G; S.c = (int)blockIdx.x; S.gather = false; S.reps = REPS(PHDN); S.ksplit = 2; S.init(F.ctl + CW_MOECNT, B0_, B1_); \
        pg8::EpiBf16Sel E{(bf16_t*)(ws + WS_YB), 1024, ((long)WS_YB2 - (long)WS_YB) / 2}; \
        pg8::gemm_phase<pg8::EpiBf16Sel, pg8::MoeOrder, true, false>(F.lds, DFE, DFE, S, E); } \
    SEAM(PHDN);
    MOE_HALF_PHASES(22, 23, 0, MOE_MAXBLK)
#undef MOE_HALF_PHASES

    if (IN(26)) {
        const float* tok_g = (const float*)(ws + WS_SMALL + SM_TOKG); const int* tok_s = (const int*)(ws + WS_SMALL + SM_TOKS); const bf16_t* YB = (const bf16_t*)(ws + WS_YB);
        for (int m = gw; m < NLAT; m += NGW) {
            const Row4 x3 = row_load(F.out + (size_t)m * 1024, F.lane);
            const float g0 = tok_g[2 * m], g1 = tok_g[2 * m + 1]; const int s0 = tok_s[2 * m], s1 = tok_s[2 * m + 1];
            const Row4 gate = row_load(mod1 + (size_t)row_class(m) * 6144 + 5 * 1024, F.lane);
            const u32x2* y0 = (const u32x2*)(YB + (size_t)s0 * 1024) + F.lane; const u32x2* y1 = (const u32x2*)(YB + (size_t)s1 * 1024) + F.lane;
            const u32x2* z0 = (const u32x2*)((const bf16_t*)(ws + WS_YB2) + (size_t)s0 * 1024) + F.lane; const u32x2* z1 = (const u32x2*)((const bf16_t*)(ws + WS_YB2) + (size_t)s1 * 1024) + F.lane;
            Row4 q;
#pragma unroll
            for (int j = 0; j < 4; ++j) { const u32x2 a = y0[64 * j], b = y1[64 * j], a2 = z0[64 * j], b2 = z1[64 * j];
                const f32x4 y = ((f32x4){bflo(a.x), bfhi(a.x), bflo(a.y), bfhi(a.y)} + (f32x4){bflo(a2.x), bfhi(a2.x), bflo(a2.y), bfhi(a2.y)}) * g0
                              + ((f32x4){bflo(b.x), bfhi(b.x), bflo(b.y), bfhi(b.y)} + (f32x4){bflo(b2.x), bfhi(b2.x), bflo(b2.y), bfhi(b2.y)}) * g1;
                q.v[j] = x3.v[j] * ALPHA + gate.v[j] * y; }
            row_store(F.out + (size_t)m * 1024, F.lane, row_ln(q, INP(I1_LN2G), INP(I1_LN2B), F.lane));
        }
    }
    if (DBL_PH == 28) { for (int i_ = 0; i_ < 20; ++i_) xcd_barrier(bar); }
#undef IN
#undef INP
#undef SEAM
}

extern "C" void kernel_launch(void* const* d_in, const int* in_sizes, int n_in, void* d_out, int out_size, void* d_ws, size_t ws_size, hipStream_t stream) {
    static int grid = 0;
    if (grid == 0) {
        if (n_in != N_IN || out_size != NLAT * DM || ws_size < WS_END) { fprintf(stderr, "kernel_launch: unexpected shapes: n_in %d out %d ws %zu (need %zu)\n", n_in, out_size, ws_size, (size_t)WS_END); }
        int dev = 0, cus = 0, per_cu = 0;
        hipGetDevice(&dev); hipDeviceGetAttribute(&cus, hipDeviceAttributeMultiprocessorCount, dev);
        hipFuncSetAttribute((const void*)mk_fwd, hipFuncAttributeMaxDynamicSharedMemorySize, LDS_BYTES);
        hipOccupancyMaxActiveBlocksPerMultiprocessor(&per_cu, (const void*)mk_fwd, NWAVES * 64, LDS_BYTES);
        (void)hipGetLastError();
        grid = cus > 0 ? cus : 256;
        if (per_cu < 1) fprintf(stderr, "kernel_launch: occupancy query reports %d\n", per_cu);
    }
    hipMemsetAsync((char*)d_ws + WS_CTL, 0, CTL_BYTES, stream);
    Args a{};
    for (int i = 0; i < N_IN; ++i) a.in[i] = (const float*)d_in[i];
    a.out = (float*)d_out; a.ws = (unsigned char*)d_ws; a.ph_lo = 0; a.ph_hi = N_PHASES;
    hipLaunchKernelGGL(mk_fwd, dim3(grid), dim3(NWAVES * 64), LDS_BYTES, stream, a);
}
```

```cpp
#include <hip/hip_runtime.h>
#include <cstdio>
#include <cstdint>

#define LAS __attribute__((address_space(3)))
#define GAS __attribute__((address_space(1)))
typedef unsigned short bf16_t;
typedef short bf16x8 __attribute__((ext_vector_type(8)));
typedef float f32x4 __attribute__((ext_vector_type(4)));
typedef float f32x2 __attribute__((ext_vector_type(2)));
typedef unsigned u32x4 __attribute__((ext_vector_type(4)));
typedef unsigned u32x2 __attribute__((ext_vector_type(2)));

constexpr int DM = 1024, NB = 2, SEQ = 8192, NLAT = NB * SEQ, CTX = 256, NCTX = NB * CTX, MR = NLAT + NCTX;
constexpr int SKEYS = CTX + SEQ;
constexpr int E_IN = 2336, E_INP = 2560, FF = 2816, ODD_IN = 8192, RET_VD = 2048, DFE = 3584, NEXP = 8;
constexpr float ALPHA = 1.4142135623730951f;
constexpr float LN_EPS = 1e-5f;

constexpr size_t MiB = 1048576;
constexpr size_t WS_CTL = 0, CTL_BYTES = 65536;
constexpr size_t WS_SMALL = 1 * MiB;
constexpr size_t SM_MOD = 0;
constexpr size_t SM_ROPE0 = 262144;
constexpr size_t SM_ROPE1 = 262144 + 65536;
constexpr size_t SM_BIAS4 = 200704;
constexpr size_t SM_TOKE = 393216;
constexpr size_t SM_TOKG = 524288;
constexpr size_t SM_TOKP = 655360;
constexpr size_t SM_SLOT = 786432;
constexpr size_t SM_TOKS = 1179648;
constexpr size_t SM_END = 2 * MiB;
constexpr size_t WS_W0IN = 3 * MiB;
constexpr size_t WS_WMLAQ = 8 * MiB;
constexpr size_t WS_WKV = 8 * MiB + 768 * 256 * 2;
constexpr size_t WS_WMLAV = 8 * MiB + 1280 * 384 * 2;
constexpr size_t WS_WLORA = 9 * MiB + MiB / 2;
constexpr size_t WS_W0OUT = 11 * MiB + MiB / 2;
constexpr size_t WS_W0GU = 13 * MiB + MiB / 2;
constexpr size_t WS_W0DN = 24 * MiB + MiB / 2;
constexpr size_t WS_W1IN = 30 * MiB;
constexpr size_t WS_W1OUT = 46 * MiB;
constexpr size_t WS_R0 = 50 * MiB;
constexpr size_t WS_R1 = 218 * MiB;
constexpr size_t WS_END = 536 * MiB;
constexpr size_t WS_XMOD = 50 * MiB;
constexpr size_t WS_MIX0 = 267 * MiB + MiB / 2;
constexpr size_t WS_PRE = 383 * MiB;
constexpr size_t WS_X1 = 449 * MiB;
constexpr size_t WS_Z0 = 83 * MiB;
constexpr size_t WS_AMLA = 165 * MiB + MiB / 2;
constexpr size_t WS_ALORA = 178 * MiB;
constexpr size_t WS_RKV = 218 * MiB;
constexpr size_t WS_LDF = 267 * MiB + MiB / 2;
constexpr size_t WS_LDB = 300 * MiB + MiB / 2;
constexpr size_t WS_LRF = 333 * MiB + MiB / 2;
constexpr size_t WS_LRB = 350 * MiB;
constexpr size_t WS_GG = 366 * MiB + MiB / 2;
constexpr size_t WS_QB = 50 * MiB;
constexpr size_t WS_KB = 190 * MiB + MiB / 2;
constexpr size_t WS_VT = 74 * MiB + 3 * MiB / 4;
constexpr size_t WS_QC = 91 * MiB + MiB / 4;
constexpr size_t WS_Y0 = 124 * MiB + MiB / 4;
constexpr size_t WS_YS = 300 * MiB + MiB / 2;
constexpr size_t WS_MT = 383 * MiB;
constexpr size_t WS_NT = 449 * MiB;
constexpr size_t WS_HFF = 83 * MiB;
constexpr size_t WS_PART8 = 515 * MiB;
constexpr size_t WS_PART11 = 176 * MiB;
constexpr size_t WS_XC2 = 531 * MiB + MiB / 2;
constexpr size_t WS_XMOD1 = 480 * MiB;
constexpr size_t WS_K1 = 83 * MiB;
constexpr size_t WS_Q1 = 115 * MiB;
constexpr size_t WS_VT1 = 147 * MiB;
constexpr size_t WS_KDT = 218 * MiB;
constexpr size_t WS_PFB = 284 * MiB;
constexpr size_t WS_ST = 348 * MiB;
constexpr size_t WS_OF = 218 * MiB;
constexpr size_t WS_OB = 50 * MiB;
constexpr size_t WS_GNP = 522 * MiB;
constexpr size_t WS_GNS = 514 * MiB;
constexpr size_t WS_XMOD1B = 284 * MiB;
constexpr size_t WS_MIX1 = 348 * MiB;
constexpr size_t WS_PRE1 = 412 * MiB;
constexpr int RCH = 33;
constexpr size_t WS_MOEGU = 50 * MiB;
constexpr size_t WS_MOEDN = 162 * MiB;
constexpr size_t WS_HMID = 218 * MiB;
constexpr size_t WS_HMOE = 456 * MiB;
constexpr size_t WS_YB = 456 * MiB;
constexpr size_t WS_YB2 = 50 * MiB;
constexpr int MOE_MAXBLK = 136;

constexpr int CW_BAR = 4096;
constexpr int CW_MOECNT = 8192;

constexpr int RING_BYTES = 131072, LDSCTL_OFF = RING_BYTES, MISC_OFF = LDSCTL_OFF + 320, LDS_BYTES = 147456;

#define RLX_AGENT __ATOMIC_RELAXED, __HIP_MEMORY_SCOPE_AGENT
__device__ __forceinline__ unsigned f2bf(float f) { unsigned u = __builtin_bit_cast(unsigned, f); return (u + 0x7fffu + ((u >> 16) & 1u)) >> 16; }
__device__ __forceinline__ unsigned pk2(float lo, float hi) { return f2bf(lo) | (f2bf(hi) << 16); }
__device__ __forceinline__ float bf2f(unsigned short b) { return __builtin_bit_cast(float, ((unsigned)b) << 16); }
__device__ __forceinline__ float bflo(unsigned u) { return __builtin_bit_cast(float, u << 16); }
__device__ __forceinline__ float bfhi(unsigned u) { return __builtin_bit_cast(float, u & 0xffff0000u); }
typedef __bf16 bf16x2_t __attribute__((ext_vector_type(2)));
__device__ __forceinline__ unsigned cvt_pk_bf16(float lo, float hi) { const f32x2 v = {lo, hi}; const bf16x2_t b = __builtin_convertvector(v, bf16x2_t); return __builtin_bit_cast(unsigned, b); }
__device__ __forceinline__ float wave_sum(float v) {
#pragma unroll
    for (int o = 1; o < 64; o <<= 1) v += __shfl_xor(v, o);
    return v;
}
__device__ __forceinline__ float silu_f(float t) { return t * __builtin_amdgcn_rcpf(1.f + __builtin_amdgcn_exp2f(-1.4426950408889634f * t)); }
__device__ __forceinline__ float sigmoid_f(float t) { return __builtin_amdgcn_rcpf(1.f + __builtin_amdgcn_exp2f(-1.4426950408889634f * t)); }
__device__ __forceinline__ int row_class(int m) { return m < SEQ ? 0 : (m < NLAT ? 1 : 2); }

#define XB_TMO      128
#define XB_XCNT(j)  (256  + 64 * (j))
#define XB_XSUB(j)  (1280 + 64 * (j))
#define XB_XGEN(j)  (2304 + 64 * (j))
#define XB_TOP      3328
#define XB_TOPGEN   3392
#define XCD_BAR_WORDS 3456
#define XB_SPIN_CAP (1u << 18)
__device__ __forceinline__ unsigned xb_ld(unsigned* p)              { return __hip_atomic_load(p, __ATOMIC_RELAXED, __HIP_MEMORY_SCOPE_AGENT); }
__device__ __forceinline__ unsigned xb_add(unsigned* p, unsigned v) { return __hip_atomic_fetch_add(p, v, __ATOMIC_RELAXED, __HIP_MEMORY_SCOPE_AGENT); }
__device__ __forceinline__ unsigned xb_xcc_id() { return (unsigned)__builtin_amdgcn_s_getreg((3 << 11) | 20) & 0xFu; }
#define XB_SPIN(cond, bar) do { unsigned _sp = 0; while (cond) { __builtin_amdgcn_s_sleep(1); \
    if ((++_sp & 255u) == 0u) { if (xb_ld(&(bar)[XB_TMO])) break; if (_sp > XB_SPIN_CAP) { atomicAdd(&(bar)[XB_TMO], 1u); break; } } } } while (0)
struct XcdBarrier { unsigned* bar; unsigned x; volatile LAS unsigned* st; };
__device__ __forceinline__ XcdBarrier xcd_barrier_post(unsigned* bar, volatile LAS unsigned* st) {
    XcdBarrier b; b.bar = bar; b.x = xb_xcc_id(); b.st = st;
    if (threadIdx.x == 0) (void)xb_add(&bar[XB_XCNT(b.x)], 1u);
    return b;
}
__device__ __forceinline__ void xcd_barrier_complete(unsigned* bar, unsigned x, unsigned& nloc, unsigned& nx) {
    const unsigned G = gridDim.x * gridDim.y * gridDim.z;
    unsigned sum, cnt, mine, sp = 0u;
    for (;;) {
        sum = 0u; cnt = 0u; mine = 0u;
#pragma unroll
        for (unsigned j = 0; j < 16; ++j) { const unsigned c = xb_ld(&bar[XB_XCNT(j)]); sum += c; cnt += (c > 0u) ? 1u : 0u; mine = (j == x) ? c : mine; }
        if (sum == G) break;
        __builtin_amdgcn_s_sleep(1);
        if ((++sp & 255u) == 0u) { if (xb_ld(&bar[XB_TMO])) break; if (sp > XB_SPIN_CAP) { atomicAdd(&bar[XB_TMO], 1u); break; } }
    }
    nloc = mine > 0u ? mine : 1u; nx = cnt > 0u ? cnt : 1u;
}
__device__ __forceinline__ void xcd_barrier(const XcdBarrier& b) {
    asm volatile("s_waitcnt vmcnt(0)" ::: "memory");
    __syncthreads();
    if (threadIdx.x == 0) {
        unsigned* bar = b.bar;
        __builtin_amdgcn_s_waitcnt(0);
        unsigned nloc = b.st[0], nx = b.st[1];
        if (nloc == 0u) { xcd_barrier_complete(bar, b.x, nloc, nx); b.st[0] = nloc; b.st[1] = nx; }
        const unsigned old = xb_add(&bar[XB_XSUB(b.x)], 1u);
        const unsigned gen = old / nloc;
        if (old + 1u == (gen + 1u) * nloc) {
            __builtin_amdgcn_fence(__ATOMIC_RELEASE, "agent");
            asm volatile("s_waitcnt vmcnt(0)" ::: "memory");
            const unsigned og = xb_add(&bar[XB_TOP], 1u);
            const unsigned tg = og / nx;
            if (og + 1u == (tg + 1u) * nx) xb_add(&bar[XB_TOPGEN], 1u);
            else XB_SPIN(xb_ld(&bar[XB_TOPGEN]) == tg, bar);
            __builtin_amdgcn_fence(__ATOMIC_ACQUIRE, "agent");
            xb_add(&bar[XB_XGEN(b.x)], 1u);
            asm volatile("s_waitcnt vmcnt(0)" ::: "memory");
        } else {
            XB_SPIN(xb_ld(&bar[XB_XGEN(b.x)]) == gen, bar);
            __builtin_amdgcn_fence(__ATOMIC_ACQUIRE, "agent");
            asm volatile("s_waitcnt vmcnt(0)" ::: "memory");
        }
    }
    __syncthreads();
}

namespace pg8 {
constexpr int BM = 256, BK = 64, HALF = 128, HTB = HALF * BK * 2, STAGE_BYTES = 8 * HTB, NXCD = 8, WGM = 8;
__host__ __device__ __forceinline__ int lds_byte(int r, int c) { const int st = (r >> 4) * 2 + (c >> 5), rr = r & 15, cc = c & 31, ob = rr * 64 + cc * 2; return st * 1024 + (ob ^ (((ob >> 9) & 1) << 5)); }
__host__ __device__ __forceinline__ void stage_rc(int b, int& R, int& C) { const int st = b / 1024, sb = b % 1024, swz = sb ^ (((sb >> 9) & 1) << 5); R = (st >> 1) * 16 + swz / 64; C = (st & 1) * 32 + (swz % 64) / 2; }
__host__ __device__ __forceinline__ int perm32(int rho) { const int n = rho >> 4, i = rho & 15; return 8 * (i >> 2) + 4 * n + (i & 3); }

struct Unit { const char* A; const char* B; int nt, flags, pm, pn, aux; const int* gidx; };


__device__ __forceinline__ const char* rfl_ptr(const char* p) { const unsigned long long v = (unsigned long long)p; const unsigned lo = __builtin_amdgcn_readfirstlane((unsigned)v), hi = __builtin_amdgcn_readfirstlane((unsigned)(v >> 32)); return (const char*)(((unsigned long long)hi << 32) | lo); }
__device__ __forceinline__ void uniformize(Unit& u) { u.A = rfl_ptr(u.A); u.B = rfl_ptr(u.B); u.nt = __builtin_amdgcn_readfirstlane(u.nt); u.flags = __builtin_amdgcn_readfirstlane(u.flags);
    u.pm = __builtin_amdgcn_readfirstlane(u.pm); u.pn = __builtin_amdgcn_readfirstlane(u.pn); u.aux = __builtin_amdgcn_readfirstlane(u.aux); u.gidx = (const int*)rfl_ptr((const char*)u.gidx); }
struct DenseOrder {
    const bf16_t* A; const bf16_t* Bt; int lda, ldb, K, nM, nN, nwg, G, c, reps = 1;
    __device__ void init(const bf16_t* A_, int lda_, const bf16_t* Bt_, int ldb_, int M, int N, int K_, int G_, int c_) { A = A_; Bt = Bt_; lda = lda_; ldb = ldb_; K = K_; nM = M / BM; nN = N / BM; nwg = nM * nN; G = G_; c = c_; }
    __device__ bool next(int i, Unit& u) const {
        const long L = (long)i * G + c; if (L >= (long)nwg * reps) return false;
        return next_l((int)(L % nwg), u);
    }
    __device__ bool next_l(int wgid, Unit& u) const { { const int q = nwg / NXCD, r = nwg % NXCD, xcd = wgid % NXCD, off = wgid / NXCD; wgid = (xcd < r ? xcd * (q + 1) : r * (q + 1) + (xcd - r) * q) + off; }
        const int nig = WGM * nN, gid = wgid / nig, fm = gid * WGM, gsz = (nM - fm) < WGM ? (nM - fm) : WGM;
        u.pm = fm + ((wgid % nig) % gsz); u.pn = (wgid % nig) / gsz;
        u.A = (const char*)(A + (size_t)u.pm * BM * lda); u.B = (const char*)(Bt + (size_t)u.pn * BM * ldb); u.nt = K / BK; u.flags = 3; u.aux = 0; u.gidx = nullptr;
        return true;
    }
};


struct CtxSliceOrder {
    const bf16_t* A; const bf16_t* Bt; int lda, ldb, nN, ks, G, c, reps;
    __device__ bool next(int i, Unit& u) const { int L = i * G + c; const int n = 2 * nN * ks; if (L >= n * reps) return false; L %= n;
        const int tile = L / ks, sl = L % ks, pmc = tile / nN, pn = tile % nN;
        u.pm = pmc; u.pn = pn; u.A = (const char*)(A + (size_t)pmc * BM * lda + sl * 256); u.B = (const char*)(Bt + (size_t)pn * BM * ldb + sl * 256); u.nt = 4; u.flags = 3; u.aux = sl; u.gidx = nullptr; return true; }
};

struct BlockOrder {
    const bf16_t* A; const bf16_t* Bt; int lda, ldb, K, nM, nNb, nblk, acol, G, c, reps;
    __device__ bool next(int i, Unit& u) const { int L = i * G + c; const int per = nM * nNb, n = per * nblk; if (L >= n * reps) return false; L %= n;
        const int b = L / per, r = L % per, pm = r % nM, pn = r / nM;
        u.pm = pm; u.pn = b * nNb + pn; u.A = (const char*)(A + (size_t)pm * BM * lda + b * acol); u.B = (const char*)(Bt + (size_t)u.pn * BM * ldb); u.nt = K / BK; u.flags = 3; u.aux = 0; u.gidx = nullptr; return true; }
};

struct KnopeOrder { BlockOrder S;
    __device__ bool next(int i, Unit& u) const { if (!S.next(i, u)) return false; u.B = (const char*)(S.Bt + (size_t)(u.pn + 3) * BM * S.ldb); u.pn += 3; return true; } };

struct MoeOrder {
    const char* A; const char* W; const int* slot_tok; size_t wstride; int lda, ldb, K, npn, B0, G, c, reps = 1, ksplit = 1; bool gather;
    int eb[NEXP], en[NEXP], us[NEXP + 1];
    __device__ void init(const unsigned* cnt, int B0_, int B1_) {
        int bs = 0, u = 0; B0 = B0_;
#pragma unroll
        for (int e = 0; e < NEXP; ++e) { const int n = (int)__hip_atomic_load(cnt + 64 * e, __ATOMIC_RELAXED, __HIP_MEMORY_SCOPE_AGENT), nb = (n + 255) >> 8;
            const int lo = bs > B0_ ? bs : B0_, hi = (bs + nb) < B1_ ? (bs + nb) : B1_; eb[e] = lo; en[e] = hi > lo ? hi - lo : 0; us[e] = u; u += en[e] * npn * ksplit; bs += nb; }
        us[NEXP] = u;
    }
    __device__ bool next(int i, Unit& u) const {
        int L = i * G + c; if (L >= us[NEXP] * reps) return false; L %= us[NEXP];
        int e = 0, base = 0, nb = 1, fb = 0;
#pragma unroll
        for (int j = 0; j < NEXP; ++j) if (L >= us[j] && en[j] > 0) { e = j; base = us[j]; nb = en[j]; fb = eb[j]; }
        const int l0 = L - base, kh = l0 % ksplit, l = l0 / ksplit, pn = l / nb, blk = fb + l % nb, kq = K / ksplit;
        u.A = (gather ? A : A + (size_t)(blk - B0) * BM * lda * 2) + (size_t)kh * kq * 2; u.B = W + (size_t)e * wstride + (size_t)pn * BM * ldb * 2 + (size_t)kh * kq * 2; u.nt = kq / BK; u.flags = 3;
        u.pm = gather ? (blk - B0) : blk; u.pn = pn; u.aux = kh; u.gidx = slot_tok + blk * BM;
        return true;
    }
};

template <class Epi, class Sched, bool ALIGN_EPI, bool GATHER>
__device__ __forceinline__ void gemm_phase(LAS unsigned char* lds, const int lda, const int ldb, const Sched& S, const Epi& E) {
    const int tid = threadIdx.x, wid = __builtin_amdgcn_readfirstlane(tid >> 6), lane = tid & 63, wr = wid >> 2, wc = wid & 3, fr = lane & 15, fq = lane >> 4;
    unsigned voffA[2], voffB[2]; int gR[2], gC[2];
#pragma unroll
    for (int i = 0; i < 2; ++i) { int R, C; stage_rc(tid * 16 + i * 8192, R, C); const int Rb = Epi::PERM ? ((R & ~31) + perm32(R & 31)) : R;
        voffA[i] = (unsigned)(R * lda + C) * 2u; voffB[i] = (unsigned)(Rb * ldb + C) * 2u; gR[i] = R; gC[i] = C; }
    const size_t kstep = (size_t)(BK * 2);
    const size_t hstepA = GATHER ? 0 : (size_t)HALF * lda * 2, hstepB = (size_t)HALF * ldb * 2;
    const unsigned ldsw = (unsigned)wid * 1024u;
    const int aoff = lds_byte(wr * 64 + fr, fq * 8), boff = lds_byte(wc * 32 + fr, fq * 8);
#define PG8_SA(b, h) (((b) * 2 + (h)) * HTB)
#define PG8_SB(b, h) ((4 + (b) * 2 + (h)) * HTB)
#define PG8_STG(bufoff, gbase, v0, v1) do { \
        __builtin_amdgcn_global_load_lds((const unsigned*)((const char*)(gbase) + (v0)), (LAS unsigned*)(lds + (bufoff) + ldsw), 16, 0, 0); \
        __builtin_amdgcn_global_load_lds((const unsigned*)((const char*)(gbase) + (v1)), (LAS unsigned*)(lds + (bufoff) + ldsw + 8192), 16, 0, 0); } while (0)
#define PG8_STAGE_B(bufoff, gbase) PG8_STG(bufoff, gbase, voffB[0], voffB[1])
#define PG8_LDA(dst, b, h) do { _Pragma("unroll") for (int m = 0; m < 4; ++m) _Pragma("unroll") for (int k = 0; k < 2; ++k) dst[m][k] = *(const LAS bf16x8*)(lds + PG8_SA(b, h) + aoff + m * 2048 + k * 1024); } while (0)
#define PG8_LDB(dst, b, h) do { _Pragma("unroll") for (int n = 0; n < 2; ++n) _Pragma("unroll") for (int k = 0; k < 2; ++k) dst[n][k] = *(const LAS bf16x8*)(lds + PG8_SB(b, h) + boff + n * 2048 + k * 1024); } while (0)
#define PG8_MMA(ai, bj, At, Bt) do { __builtin_amdgcn_s_setprio(1); _Pragma("unroll") for (int m = 0; m < 4; ++m) _Pragma("unroll") for (int n = 0; n < 2; ++n) _Pragma("unroll") for (int k = 0; k < 2; ++k) \
        acc[ai][bj][m][n] = __builtin_amdgcn_mfma_f32_16x16x32_bf16(Bt[n][k], At[m][k], acc[ai][bj][m][n], 0, 0, 0); __builtin_amdgcn_s_setprio(0); } while (0)
#define PG8_WAIT_V(n) asm volatile("s_waitcnt vmcnt(" #n ")" ::: "memory")
#define PG8_WAIT_L(n) asm volatile("s_waitcnt lgkmcnt(" #n ")" ::: "memory")
#define PG8_BAR __builtin_amdgcn_s_barrier()
#define PG8_SCHED __builtin_amdgcn_sched_barrier(0)
    Unit cur, nxt; int ui = 0;
    if (!S.next(0, cur)) return;
    uniformize(cur);
    f32x4 acc[2][2][4][2];
#pragma unroll
    for (int a = 0; a < 2; ++a)
#pragma unroll
        for (int b = 0; b < 2; ++b)
#pragma unroll
            for (int m = 0; m < 4; ++m)
#pragma unroll
                for (int n = 0; n < 2; ++n) acc[a][b][m][n] = (f32x4){0.f, 0.f, 0.f, 0.f};
    bf16x8 At[4][2], B0[2][2], B1[2][2];
    unsigned cvA[4], nvA[4];
    if constexpr (GATHER) {
#pragma unroll
        for (int i = 0; i < 2; ++i) { cvA[i] = (unsigned)((size_t)cur.gidx[gR[i]] * lda + gC[i]) * 2u; cvA[2 + i] = (unsigned)((size_t)cur.gidx[HALF + gR[i]] * lda + gC[i]) * 2u; }
    } else { cvA[0] = voffA[0]; cvA[1] = voffA[1]; cvA[2] = voffA[0]; cvA[3] = voffA[1]; }
#pragma unroll
    for (int i = 0; i < 4; ++i) nvA[i] = cvA[i];
    const char* cA = cur.A; const char* cB = cur.B;
    PG8_STAGE_B(PG8_SB(0, 0), cB); PG8_STAGE_B(PG8_SB(0, 1), cB + hstepB); PG8_STG(PG8_SA(0, 0), cA, cvA[0], cvA[1]); PG8_STG(PG8_SA(0, 1), cA + hstepA, cvA[2], cvA[3]);
    if (wr == 1) PG8_BAR;
    PG8_WAIT_V(2); PG8_BAR;
    PG8_STAGE_B(PG8_SB(1, 0), cB + kstep); PG8_STG(PG8_SA(1, 0), cA + kstep, cvA[0], cvA[1]); PG8_STAGE_B(PG8_SB(1, 1), cB + hstepB + kstep);
    PG8_WAIT_V(6); PG8_BAR;
    for (;;) {
        const bool has_next = S.next(ui + 1, nxt);
        if (has_next) uniformize(nxt);
        const char* nA = has_next ? nxt.A : cA; const char* nB = has_next ? nxt.B : cB;
        if constexpr (GATHER) {
            if (has_next) {
#pragma unroll
                for (int i = 0; i < 2; ++i) { nvA[i] = (unsigned)((size_t)nxt.gidx[gR[i]] * lda + gC[i]) * 2u; nvA[2 + i] = (unsigned)((size_t)nxt.gidx[HALF + gR[i]] * lda + gC[i]) * 2u; }
            }
        }
        const int nt = cur.nt;
        for (int t = 0; t < nt; t += 2) {
            const bool last = (t == nt - 2);
            const char* a1 = cA + (size_t)(t + 1) * kstep;
            const char* a2 = last ? nA : cA + (size_t)(t + 2) * kstep; const char* b2 = last ? nB : cB + (size_t)(t + 2) * kstep;
            const char* a3 = a2 + kstep; const char* b3 = b2 + kstep;
            unsigned w0, w1, w2, w3;
            if constexpr (GATHER) { w0 = last ? nvA[0] : cvA[0]; w1 = last ? nvA[1] : cvA[1]; w2 = last ? nvA[2] : cvA[2]; w3 = last ? nvA[3] : cvA[3]; }
            else { w0 = cvA[0]; w1 = cvA[1]; w2 = cvA[2]; w3 = cvA[3]; }
            PG8_LDB(B0, 0, 0); PG8_LDB(B1, 0, 1); PG8_SCHED; PG8_LDA(At, 0, 0); PG8_STG(PG8_SA(1, 1), a1 + hstepA, cvA[2], cvA[3]);
            PG8_WAIT_V(8); PG8_WAIT_L(0); PG8_BAR; PG8_MMA(0, 0, At, B0); PG8_MMA(0, 1, At, B1); PG8_BAR; PG8_SCHED;
            PG8_LDA(At, 0, 1); PG8_STAGE_B(PG8_SB(0, 0), b2); PG8_STAGE_B(PG8_SB(0, 1), b2 + hstepB); PG8_STG(PG8_SA(0, 0), a2, w0, w1);
            PG8_WAIT_V(8); PG8_WAIT_L(0); PG8_BAR; PG8_MMA(1, 0, At, B0); PG8_MMA(1, 1, At, B1); PG8_BAR; PG8_SCHED;
            PG8_LDB(B0, 1, 0); PG8_LDB(B1, 1, 1); PG8_SCHED; PG8_LDA(At, 1, 0); PG8_STG(PG8_SA(0, 1), a2 + hstepA, w2, w3);
            PG8_WAIT_V(8); PG8_WAIT_L(0); PG8_BAR; PG8_MMA(0, 0, At, B0); PG8_MMA(0, 1, At, B1); PG8_BAR; PG8_SCHED;
            PG8_LDA(At, 1, 1); PG8_STAGE_B(PG8_SB(1, 0), b3); PG8_STAGE_B(PG8_SB(1, 1), b3 + hstepB); PG8_STG(PG8_SA(1, 0), a3, w0, w1);
            PG8_WAIT_V(8); PG8_WAIT_L(0); PG8_BAR; PG8_MMA(1, 0, At, B0); PG8_MMA(1, 1, At, B1); PG8_BAR; PG8_SCHED;
        }
        if constexpr (ALIGN_EPI) { if (wr == 0) PG8_BAR; }
        if (cur.flags & 2) E(acc, cur, wr, wc, fr, fq);
        if (!has_next) break;
        if (nxt.flags & 1) {
#pragma unroll
            for (int a = 0; a < 2; ++a)
#pragma unroll
                for (int b = 0; b < 2; ++b)
#pragma unroll
                    for (int m = 0; m < 4; ++m)
#pragma unroll
                        for (int n = 0; n < 2; ++n) acc[a][b][m][n] = (f32x4){0.f, 0.f, 0.f, 0.f};
        }
        cur = nxt; cA = nA; cB = nB; ++ui;
#pragma unroll
        for (int i = 0; i < 4; ++i) cvA[i] = nvA[i];
        if constexpr (ALIGN_EPI) { if (wr == 1) PG8_BAR; }
    }
    PG8_WAIT_V(0);
    if constexpr (!ALIGN_EPI) { if (wr == 0) PG8_BAR; }
    PG8_BAR;
#undef PG8_SA
#undef PG8_SB
#undef PG8_STG
#undef PG8_STAGE_B
#undef PG8_LDA
#undef PG8_LDB
#undef PG8_MMA
#undef PG8_WAIT_V
#undef PG8_WAIT_L
#undef PG8_BAR
#undef PG8_SCHED
}

typedef f32x4 Acc[2][2][4][2];

struct EpiResGate {
    static constexpr bool PERM = false;
    float* out; const float* res; const float* gate3;
    int ld; int row_cls_base;
    __device__ __forceinline__ void operator()(const Acc& acc, const Unit& u, int wr, int wc, int fr, int fq) const {
        const int row0 = u.pm * BM + wr * 64 + fr, col0 = u.pn * BM + wc * 32 + 4 * fq;
        const float* g = gate3 + (size_t)row_class(u.pm * BM + row_cls_base) * 6144;
        f32x4 gv[2][2];
#pragma unroll
        for (int bj = 0; bj < 2; ++bj)
#pragma unroll
            for (int n = 0; n < 2; ++n) gv[bj][n] = *(const f32x4*)(g + col0 + bj * HALF + n * 16);
#pragma unroll
        for (int ai = 0; ai < 2; ++ai)
#pragma unroll
            for (int m = 0; m < 4; ++m) { const size_t ro = (size_t)(row0 + ai * HALF + m * 16) * ld + col0;
#pragma unroll
                for (int bj = 0; bj < 2; ++bj)
#pragma unroll
                    for (int n = 0; n < 2; ++n) { const f32x4 r = *(const f32x4*)(res + ro + bj * HALF + n * 16);
                        *(f32x4*)(out + ro + bj * HALF + n * 16) = r * ALPHA + gv[bj][n] * acc[ai][bj][m][n]; } }
    }
};
struct EpiCtxPart {
    static constexpr bool PERM = false;
    float* part; const float* gate;
    __device__ __forceinline__ void operator()(const Acc& acc, const Unit& u, int wr, int wc, int fr, int fq) const {
        const int row0 = u.pm * BM + wr * 64 + fr, col0 = u.pn * BM + wc * 32 + 4 * fq;
        float* ob = part + ((size_t)u.aux * NCTX + row0) * 1024 + col0;
        f32x4 gv[2][2];
#pragma unroll
        for (int bj = 0; bj < 2; ++bj)
#pragma unroll
            for (int n = 0; n < 2; ++n) gv[bj][n] = *(const f32x4*)(gate + col0 + bj * HALF + n * 16);
#pragma unroll
        for (int ai = 0; ai < 2; ++ai)
#pragma unroll
            for (int m = 0; m < 4; ++m)
#pragma unroll
                for (int bj = 0; bj < 2; ++bj)
#pragma unroll
                    for (int n = 0; n < 2; ++n) *(f32x4*)(ob + (size_t)(ai * HALF + m * 16) * 1024 + bj * HALF + n * 16) = gv[bj][n] * acc[ai][bj][m][n];
    }
};
struct EpiSwiGLU {
    static constexpr bool PERM = true;
    bf16_t* H; int ldh;
    __device__ __forceinline__ void operator()(const Acc& acc, const Unit& u, int wr, int wc, int fr, int fq) const {
        const int row0 = u.pm * BM + wr * 64 + fr, col0 = u.pn * HALF + wc * 32 + 8 * fq;
#pragma unroll
        for (int ai = 0; ai < 2; ++ai)
#pragma unroll
            for (int m = 0; m < 4; ++m) { bf16_t* rowp = H + (size_t)(row0 + ai * HALF + m * 16) * ldh + col0;
                float v[8];
#pragma unroll
                for (int n = 0; n < 2; ++n)
#pragma unroll
                    for (int j = 0; j < 4; ++j) { const float g = acc[ai][0][m][n][j], up = acc[ai][1][m][n][j]; v[4 * n + j] = silu_f(g) * up; }
                u32x4 w; w.x = cvt_pk_bf16(v[0], v[1]); w.y = cvt_pk_bf16(v[2], v[3]); w.z = cvt_pk_bf16(v[4], v[5]); w.w = cvt_pk_bf16(v[6], v[7]);
                *(u32x4*)rowp = w; }
    }
};

struct EpiBf16 {
    static constexpr bool PERM = true;
    bf16_t* O; int ldc;
    __device__ __forceinline__ void operator()(const Acc& acc, const Unit& u, int wr, int wc, int fr, int fq) const {
        const int row0 = u.pm * BM + wr * 64 + fr, col0 = u.pn * BM + wc * 32 + 8 * fq;
#pragma unroll
        for (int ai = 0; ai < 2; ++ai)
#pragma unroll
            for (int m = 0; m < 4; ++m) { bf16_t* rowp = O + (size_t)(row0 + ai * HALF + m * 16) * ldc + col0;
#pragma unroll
                for (int bj = 0; bj < 2; ++bj) { const f32x4 v0 = acc[ai][bj][m][0], v1 = acc[ai][bj][m][1];
                    u32x4 w; w.x = cvt_pk_bf16(v0[0], v0[1]); w.y = cvt_pk_bf16(v0[2], v0[3]); w.z = cvt_pk_bf16(v1[0], v1[1]); w.w = cvt_pk_bf16(v1[2], v1[3]);
                    *(u32x4*)(rowp + bj * HALF) = w; } }
    }
};
struct EpiBf16Sel {
    static constexpr bool PERM = true;
    bf16_t* O; int ldc; long stride;
    __device__ __forceinline__ void operator()(const Acc& acc, const Unit& u, int wr, int wc, int fr, int fq) const {
        const int row0 = u.pm * BM + wr * 64 + fr, col0 = u.pn * BM + wc * 32 + 8 * fq; bf16_t* Ob = O + (long)u.aux * stride;
#pragma unroll
        for (int ai = 0; ai < 2; ++ai)
#pragma unroll
            for (int m = 0; m < 4; ++m) { bf16_t* rowp = Ob + (size_t)(row0 + ai * HALF + m * 16) * ldc + col0;
#pragma unroll
                for (int bj = 0; bj < 2; ++bj) { const f32x4 v0 = acc[ai][bj][m][0], v1 = acc[ai][bj][m][1];
                    u32x4 w; w.x = cvt_pk_bf16(v0[0], v0[1]); w.y = cvt_pk_bf16(v0[2], v0[3]); w.z = cvt_pk_bf16(v1[0], v1[1]); w.w = cvt_pk_bf16(v1[2], v1[3]);
                    *(u32x4*)(rowp + bj * HALF) = w; } }
    }
};
struct EpiLora {
    static constexpr bool PERM = true;
    float* ld; bf16_t* lr; const float* bias4;
    __device__ __forceinline__ void operator()(const Acc& acc, const Unit& u, int wr, int wc, int fr_in, int fq_in) const {
        int fr = fr_in, fq = fq_in; asm volatile("" : "+v"(fr), "+v"(fq));
        const int blk = u.pn >> 1, row0 = u.pm * BM + wr * 64 + fr, colb = (u.pn & 1) * BM + wc * 32 + 8 * fq;
        const float* bias = bias4 + (blk < 4 ? blk : 0) * 512;
        f32x4 bv[2][2];
#pragma unroll
        for (int bj = 0; bj < 2; ++bj)
#pragma unroll
            for (int n = 0; n < 2; ++n) bv[bj][n] = blk < 4 ? *(const f32x4*)(bias + colb + bj * HALF + 4 * n) : (f32x4){0.f, 0.f, 0.f, 0.f};
#pragma unroll
        for (int ai = 0; ai < 2; ++ai)
#pragma unroll
            for (int m = 0; m < 4; ++m) { const size_t ro = (size_t)(row0 + ai * HALF + m * 16) * 512 + colb;
#pragma unroll
                for (int bj = 0; bj < 2; ++bj) { f32x4 v0 = acc[ai][bj][m][0] + bv[bj][0], v1 = acc[ai][bj][m][1] + bv[bj][1];
                    if (blk < 4) {
#pragma unroll
                        for (int j = 0; j < 4; ++j) { v0[j] = sigmoid_f(v0[j]); v1[j] = sigmoid_f(v1[j]); } }
                    if (blk < 2) { float* o = ld + (size_t)blk * MR * 512 + ro + bj * HALF; *(f32x4*)o = v0 * -0.6065306597126334f; *(f32x4*)(o + 4) = v1 * -0.6065306597126334f; }
                    else { bf16_t* o = lr + (size_t)(blk - 2) * MR * 512 + ro + bj * HALF;
                        u32x4 w; w.x = cvt_pk_bf16(v0[0], v0[1]); w.y = cvt_pk_bf16(v0[2], v0[3]); w.z = cvt_pk_bf16(v1[0], v1[1]); w.w = cvt_pk_bf16(v1[2], v1[3]); *(u32x4*)o = w; } } }
    }
};
struct EpiMlaQK {
    static constexpr bool PERM = false;
    bf16_t* Q; bf16_t* KB; const f32x2* rope; float qscale;
    __device__ __forceinline__ void operator()(const Acc& acc, const Unit& u, int wr, int wc, int fr_in, int fq_in) const {
        int fr = fr_in, fq = fq_in; asm volatile("" : "+v"(fr), "+v"(fq));
        const int row0 = u.pm * BM + wr * 64 + fr;
#pragma unroll
        for (int bj = 0; bj < 2; ++bj) {
            const int cg = u.pn * BM + bj * HALF + wc * 32;
            if (cg < 768) {
                const bool is_rope = ((cg >> 5) % 3) == 2;
#pragma unroll
                for (int ai = 0; ai < 2; ++ai)
#pragma unroll
                    for (int m = 0; m < 4; ++m) { const int row = row0 + ai * HALF + m * 16;
                        f32x4 v0 = acc[ai][bj][m][0] * qscale, v1 = acc[ai][bj][m][1] * qscale;
                        if (is_rope && row < NLAT) { const int t = row & (SEQ - 1), prow = t >> 6, pcol = t & 63;
#pragma unroll
                            for (int j = 0; j < 4; ++j) { const int p = 4 * fq + j, f = p >> 3, i = p & 7; const f32x2 cs = rope[(f ? pcol : prow) * 8 + i];
                                const float t1 = v0[j], t2 = v1[j]; v0[j] = t1 * cs.x - t2 * cs.y; v1[j] = t1 * cs.y + t2 * cs.x; } }
                        bf16_t* o = Q + (size_t)row * 768 + cg + 4 * fq;
                        u32x2 w0; w0.x = cvt_pk_bf16(v0[0], v0[1]); w0.y = cvt_pk_bf16(v0[2], v0[3]); *(u32x2*)o = w0;
                        u32x2 w1; w1.x = cvt_pk_bf16(v1[0], v1[1]); w1.y = cvt_pk_bf16(v1[2], v1[3]); *(u32x2*)(o + 16) = w1; }
            } else {
                const int c = cg - 768, head = c >> 6, d0 = (c & 63) + 4 * fq;
#pragma unroll
                for (int ai = 0; ai < 2; ++ai)
#pragma unroll
                    for (int m = 0; m < 4; ++m) { const int row = row0 + ai * HALF + m * 16;
                        const int b = row < NLAT ? (row >> 13) : ((row - NLAT) >> 8), sk = row < NLAT ? CTX + (row & (SEQ - 1)) : ((row - NLAT) & (CTX - 1));
                        bf16_t* o = KB + ((size_t)(b * SKEYS + sk) * 8 + head) * 96 + d0;
                        const f32x4 v0 = acc[ai][bj][m][0], v1 = acc[ai][bj][m][1];
                        u32x2 w0; w0.x = cvt_pk_bf16(v0[0], v0[1]); w0.y = cvt_pk_bf16(v0[2], v0[3]); *(u32x2*)o = w0;
                        u32x2 w1; w1.x = cvt_pk_bf16(v1[0], v1[1]); w1.y = cvt_pk_bf16(v1[2], v1[3]); *(u32x2*)(o + 16) = w1; }
            }
        }
    }
};
struct EpiVT {
    static constexpr bool PERM = true;
    bf16_t* VT;
    __device__ __forceinline__ void operator()(const Acc& acc, const Unit& u, int wr, int wc, int fr, int fq) const {
        const int m0 = u.pn * BM;
        const int b = m0 < NLAT ? (m0 >> 13) : ((m0 - NLAT) >> 8), s0 = m0 < NLAT ? CTX + (m0 & (SEQ - 1)) : 0;
        const int row0 = u.pm * BM + wr * 64 + fr, col0 = wc * 32 + 8 * fq;
#pragma unroll
        for (int ai = 0; ai < 2; ++ai)
#pragma unroll
            for (int m = 0; m < 4; ++m) { bf16_t* rowp = VT + ((size_t)b * 512 + row0 + ai * HALF + m * 16) * SKEYS + s0 + col0;
#pragma unroll
                for (int bj = 0; bj < 2; ++bj) { const f32x4 v0 = acc[ai][bj][m][0], v1 = acc[ai][bj][m][1];
                    u32x4 w; w.x = cvt_pk_bf16(v0[0], v0[1]); w.y = cvt_pk_bf16(v0[2], v0[3]); w.z = cvt_pk_bf16(v1[0], v1[1]); w.w = cvt_pk_bf16(v1[2], v1[3]);
                    *(u32x4*)(rowp + bj * HALF) = w; } }
    }
};

struct ScoreOrder {
    const bf16_t* Q; const bf16_t* Kk; int G, c, reps;
    __device__ bool next(int i, Unit& u) const { int L = i * G + c; if (L >= 256 * reps) return false; L &= 255; const int bh = L >> 5, ch = L & 31, b = bh >> 2, h = bh & 3;
        const size_t off = ((size_t)(b * SEQ + ch * 256) * 1024 + h * 256); u.A = (const char*)(Q + off); u.B = (const char*)(Kk + off); u.nt = 4; u.flags = 3; u.pm = L; u.pn = 0; u.aux = h; u.gidx = nullptr; return true; }
};
struct StateOrder {
    const bf16_t* VT; const bf16_t* KDT; int G, c, reps;
    __device__ bool next(int i, Unit& u) const { int L = i * G + c; if (L >= 2 * 8 * (RCH - 1) * 2 * reps) return false; L %= 2 * 8 * (RCH - 1) * 2;
        const int half = L & 1, r = L >> 1, dir = r / (8 * (RCH - 1)), q = r % (8 * (RCH - 1)), bh_ = q / (RCH - 1), si = q % (RCH - 1), bhs = bh_ * RCH + ((dir && si) ? si + 1 : si);
        u.A = (const char*)(VT + ((size_t)bhs * 512 + half * 256) * 256); u.B = (const char*)(KDT + ((size_t)dir * 8 * RCH + bhs) * 65536); u.nt = 4; u.flags = 3; u.pm = (dir * 8 * RCH + bhs) * 2 + half; u.pn = 0; u.aux = 0; u.gidx = nullptr; return true; }
};
struct OutOrder {
    const bf16_t* P; const bf16_t* Q; const bf16_t* VT; const bf16_t* ST; int G, c, reps;
    __device__ bool next(int i, Unit& u) const { int tile = (i >> 1) * G + c; const int seg = i & 1; if (tile >= 1024 * reps) return false; tile &= 1023;
        const int half = tile & 1, ch = (tile >> 1) & 31, bh = (tile >> 6) & 7, dir = tile >> 9, b = bh >> 2, h = bh & 3;
        const size_t aoff = (size_t)(b * SEQ + ch * 256) * 1024 + h * 256;
        if (seg == 0) { u.A = (const char*)(P + (size_t)dir * NLAT * 1024 + aoff); u.B = (const char*)(VT + ((size_t)(bh * RCH + ch + 1) * 512 + half * 256) * 256); u.flags = 1; }
        else { const int slot = dir ? ch + 1 : ch; u.A = (const char*)(Q + aoff); u.B = (const char*)(ST + (((size_t)dir * 8 * RCH + bh * RCH + slot) * 512 + half * 256) * 256); u.flags = 2; }
        u.nt = 4; u.pm = tile; u.pn = 0; u.aux = 0; u.gidx = nullptr; return true; }
};
__device__ __forceinline__ float lg2gamma(const float* dec, int h) { return __log2f(1.f - __builtin_amdgcn_exp2f(-dec[h])); }

struct EpiQK1 {
    static constexpr bool PERM = false;
    bf16_t* Q; bf16_t* Kk; const f32x2* rope;
    __device__ __forceinline__ void operator()(const Acc& acc, const Unit& u, int wr, int wc, int fr_in, int fq_in) const {
        int fr = fr_in, fq = fq_in; asm volatile("" : "+v"(fr), "+v"(fq));
        const int row0 = u.pm * BM + wr * 64 + fr;
#pragma unroll
        for (int bj = 0; bj < 2; ++bj) { const int cg = u.pn * BM + bj * HALF + wc * 32, isk = cg >> 10, cq = cg & 1023, f = (cq >> 7) & 1, i0 = ((cq & 127) >> 5) * 16 + 4 * fq;
            bf16_t* dst = (isk ? Kk : Q) + cq + 4 * fq; const float sc = isk ? 0.0625f : 1.f;
#pragma unroll
            for (int ai = 0; ai < 2; ++ai)
#pragma unroll
                for (int m = 0; m < 4; ++m) { const int row = row0 + ai * HALF + m * 16, t = row & (SEQ - 1), pos = f ? (t & 63) : (t >> 6);
                    f32x4 v0 = acc[ai][bj][m][0], v1 = acc[ai][bj][m][1];
#pragma unroll
                    for (int j = 0; j < 4; ++j) { const f32x2 cs = rope[pos * 64 + i0 + j]; const float t1 = v0[j], t2 = v1[j]; v0[j] = (t1 * cs.x - t2 * cs.y) * sc; v1[j] = (t1 * cs.y + t2 * cs.x) * sc; }
                    bf16_t* o = dst + (size_t)row * 1024;
                    u32x2 w0; w0.x = cvt_pk_bf16(v0[0], v0[1]); w0.y = cvt_pk_bf16(v0[2], v0[3]); *(u32x2*)o = w0;
                    u32x2 w1; w1.x = cvt_pk_bf16(v1[0], v1[1]); w1.y = cvt_pk_bf16(v1[2], v1[3]); *(u32x2*)(o + 16) = w1; __builtin_amdgcn_sched_barrier(0); } }
    }
};
struct EpiKVT {
    static constexpr bool PERM = true;
    bf16_t* KDT; bf16_t* VT; const f32x2* rope; const float* decf; const float* decb;
    __device__ __forceinline__ void operator()(const Acc& acc, const Unit& u, int wr, int wc, int fr_in, int fq_in) const {
        int fr = fr_in, fq = fq_in; asm volatile("" : "+v"(fr), "+v"(fq));
        const int m0 = u.pn * BM; const bool lat = m0 < NLAT;
        const int b = lat ? (m0 >> 13) : ((m0 - NLAT) >> 8), slot = lat ? 1 + ((m0 & (SEQ - 1)) >> 8) : 0, t0 = m0 & (SEQ - 1);
        const int rbase = u.pm * BM + wr * 64;
#pragma unroll
        for (int ai = 0; ai < 2; ++ai) { const int rg = rbase + ai * HALF;
            if (rg < 1024) {
                const int h = rg >> 8, lgsel = h; const float lgf = lg2gamma(decf, lgsel), lgb = lg2gamma(decb, lgsel);
#pragma unroll
                for (int mp = 0; mp < 2; ++mp) { const int dk = (rg & 255) + 32 * mp + fr, f = (dk >> 7) & 1, fi = ((dk & 127) >> 5) * 16 + fr;
                    bf16_t* o1 = KDT + (((size_t)(b * 4 + h) * RCH + slot) * 256 + dk) * 256; bf16_t* o2 = o1 + 16 * 256;
#pragma unroll
                    for (int bj = 0; bj < 2; ++bj)
#pragma unroll
                        for (int n = 0; n < 2; ++n) { const int jt0 = bj * HALF + wc * 32 + 8 * fq + 4 * n; float a1[4], a2[4], df[4], db[4];
#pragma unroll
                            for (int j = 0; j < 4; ++j) { float t1 = acc[ai][bj][2 * mp][n][j], t2 = acc[ai][bj][2 * mp + 1][n][j]; const int jt = jt0 + j;
                                if (lat) { const int t = t0 + jt; const f32x2 cs = rope[(f ? (t & 63) : (t >> 6)) * 64 + fi]; const float x1 = t1 * cs.x - t2 * cs.y, x2 = t1 * cs.y + t2 * cs.x; t1 = x1; t2 = x2; }
                                a1[j] = t1 * 0.0625f; a2[j] = t2 * 0.0625f; df[j] = __builtin_amdgcn_exp2f((float)(255 - jt) * lgf); db[j] = __builtin_amdgcn_exp2f((float)jt * lgb); }
                            u32x2 w;
                            w.x = cvt_pk_bf16(a1[0] * df[0], a1[1] * df[1]); w.y = cvt_pk_bf16(a1[2] * df[2], a1[3] * df[3]); *(u32x2*)(o1 + jt0) = w;
                            w.x = cvt_pk_bf16(a2[0] * df[0], a2[1] * df[1]); w.y = cvt_pk_bf16(a2[2] * df[2], a2[3] * df[3]); *(u32x2*)(o2 + jt0) = w;
                            w.x = cvt_pk_bf16(a1[0] * db[0], a1[1] * db[1]); w.y = cvt_pk_bf16(a1[2] * db[2], a1[3] * db[3]); *(u32x2*)(o1 + (size_t)8 * RCH * 65536 + jt0) = w;
                            w.x = cvt_pk_bf16(a2[0] * db[0], a2[1] * db[1]); w.y = cvt_pk_bf16(a2[2] * db[2], a2[3] * db[3]); *(u32x2*)(o2 + (size_t)8 * RCH * 65536 + jt0) = w; __builtin_amdgcn_sched_barrier(0); } }
            } else {
                const int e0 = rg - 1024, h = e0 >> 9;
#pragma unroll
                for (int m = 0; m < 4; ++m) { const int dv = (e0 & 511) + 16 * m + fr; bf16_t* o = VT + (((size_t)(b * 4 + h) * RCH + slot) * 512 + dv) * 256 + wc * 32 + 8 * fq;
#pragma unroll
                    for (int bj = 0; bj < 2; ++bj) { const f32x4 v0 = acc[ai][bj][m][0], v1 = acc[ai][bj][m][1];
                        u32x4 w; w.x = cvt_pk_bf16(v0[0], v0[1]); w.y = cvt_pk_bf16(v0[2], v0[3]); w.z = cvt_pk_bf16(v1[0], v1[1]); w.w = cvt_pk_bf16(v1[2], v1[3]);
                        *(u32x4*)(o + bj * HALF) = w; } }
            }
        }
    }
};
struct EpiScore {
    static constexpr bool PERM = true;
    bf16_t* P; const float* decf; const float* decb;
    __device__ __forceinline__ void operator()(const Acc& acc, const Unit& u, int wr, int wc, int fr_in, int fq_in) const {
        int fr = fr_in, fq = fq_in; asm volatile("" : "+v"(fr), "+v"(fq));
        const int L = u.pm, bh = L >> 5, ch = L & 31, b = bh >> 2, h = bh & 3; const float lgf = lg2gamma(decf, h), lgb = lg2gamma(decb, h);
        bf16_t* base = P + ((size_t)(b * SEQ + ch * 256) * 1024 + h * 256);
        const int jb = wc * 32 + 8 * fq;
#pragma unroll
        for (int ai = 0; ai < 2; ++ai)
#pragma unroll
            for (int m = 0; m < 4; ++m) { const int i = ai * HALF + wr * 64 + 16 * m + fr; bf16_t* rp = base + (size_t)i * 1024 + jb; bf16_t* rpb = rp + (size_t)NLAT * 1024;
#pragma unroll
                for (int bj = 0; bj < 2; ++bj)
#pragma unroll
                    for (int n = 0; n < 2; ++n) { float pf[4], pb[4];
#pragma unroll
                        for (int j = 0; j < 4; ++j) { const int jj = jb + bj * HALF + 4 * n + j; const float a = acc[ai][bj][m][n][j];
                            pf[j] = jj <= i ? a * __builtin_amdgcn_exp2f(-(float)(jj + 1) * lgf) : 0.f; pb[j] = jj >= i ? a * __builtin_amdgcn_exp2f(-(float)(256 - jj) * lgb) : 0.f; }
                        u32x2 w; w.x = cvt_pk_bf16(pf[0], pf[1]); w.y = cvt_pk_bf16(pf[2], pf[3]); *(u32x2*)(rp + bj * HALF + 4 * n) = w;
                        w.x = cvt_pk_bf16(pb[0], pb[1]); w.y = cvt_pk_bf16(pb[2], pb[3]); *(u32x2*)(rpb + bj * HALF + 4 * n) = w; }
                __builtin_amdgcn_sched_barrier(0); }
    }
};
struct EpiRetOut {
    static constexpr bool PERM = true;
    bf16_t* OF; bf16_t* OB; const float* decf; const float* decb; float* gns;
    __device__ __forceinline__ void operator()(const Acc& acc, const Unit& u, int wr, int wc, int fr_in, int fq_in) const {
        int fr = fr_in, fq = fq_in; asm volatile("" : "+v"(fr), "+v"(fq));
        const int tile = u.pm, half = tile & 1, ch = (tile >> 1) & 31, bh = (tile >> 6) & 7, dir = tile >> 9, b = bh >> 2, h = bh & 3;
        const float lg = dir ? lg2gamma(decb, h) : lg2gamma(decf, h);
        bf16_t* base = (dir ? OB : OF) + ((size_t)(b * SEQ + ch * 256) * 2048 + h * 512 + half * 256 + wc * 32 + 8 * fq);
        float* gb = gns + (((size_t)(b * SEQ + ch * 256) * 8 + h * 2 + dir) * 8 + half * 4 + wc) * 2;
#pragma unroll
        for (int ai = 0; ai < 2; ++ai)
#pragma unroll
            for (int m = 0; m < 4; ++m) { const int i = ai * HALF + wr * 64 + 16 * m + fr; const float rs = __builtin_amdgcn_exp2f((float)(dir ? 256 - i : i + 1) * lg); float s1 = 0.f, s2 = 0.f;
#pragma unroll
                for (int bj = 0; bj < 2; ++bj) { const f32x4 v0 = acc[ai][bj][m][0] * rs, v1 = acc[ai][bj][m][1] * rs;
                    s1 += (v0[0] + v0[1]) + (v0[2] + v0[3]) + (v1[0] + v1[1]) + (v1[2] + v1[3]);
                    s2 += (v0[0] * v0[0] + v0[1] * v0[1]) + (v0[2] * v0[2] + v0[3] * v0[3]) + (v1[0] * v1[0] + v1[1] * v1[1]) + (v1[2] * v1[2] + v1[3] * v1[3]);
                    u32x4 w; w.x = cvt_pk_bf16(v0[0], v0[1]); w.y = cvt_pk_bf16(v0[2], v0[3]); w.z = cvt_pk_bf16(v1[0], v1[1]); w.w = cvt_pk_bf16(v1[2], v1[3]);
                    *(u32x4*)(base + (size_t)i * 2048 + bj * HALF) = w; }
                s1 += __shfl_xor(s1, 16); s1 += __shfl_xor(s1, 32); s2 += __shfl_xor(s2, 16); s2 += __shfl_xor(s2, 32);
                if (fq == 0) *(f32x2*)(gb + (size_t)i * 128) = (f32x2){s1, s2}; }
    }
};
struct EpiGate1 {
    static constexpr bool PERM = false;
    bf16_t* MIX; const bf16_t* OF; const bf16_t* OB; const f32x2* st;
    __device__ __forceinline__ void operator()(const Acc& acc, const Unit& u, int wr, int wc, int fr_in, int fq_in) const {
        int fr = fr_in, fq = fq_in; asm volatile("" : "+v"(fr), "+v"(fq));
        const int row0 = u.pm * BM + wr * 64 + fr;
#pragma unroll
        for (int bj = 0; bj < 2; ++bj) { const int cgi = (u.pn * BM + bj * HALF + wc * 32) >> 5, j0 = cgi * 16 + 4 * fq, h = j0 >> 9;
#pragma unroll
            for (int ai = 0; ai < 2; ++ai)
#pragma unroll
                for (int m = 0; m < 4; ++m) { const int row = row0 + ai * HALF + m * 16; const f32x2 sf = st[(size_t)row * 8 + h * 2], sb = st[(size_t)row * 8 + h * 2 + 1];
                    const u32x2 of = *(const u32x2*)(OF + (size_t)row * 2048 + j0), ob = *(const u32x2*)(OB + (size_t)row * 2048 + j0);
                    const float fo[4] = {bflo(of.x), bfhi(of.x), bflo(of.y), bfhi(of.y)}, bo[4] = {bflo(ob.x), bfhi(ob.x), bflo(ob.y), bfhi(ob.y)}; float r[4];
#pragma unroll
                    for (int j = 0; j < 4; ++j) r[j] = silu_f(acc[ai][bj][m][0][j]) * (fo[j] - sf.x) * sf.y + silu_f(acc[ai][bj][m][1][j]) * (bo[j] - sb.x) * sb.y;
                    u32x2 w; w.x = cvt_pk_bf16(r[0], r[1]); w.y = cvt_pk_bf16(r[2], r[3]); *(u32x2*)(MIX + (size_t)row * 2048 + j0) = w; } }
    }
};
}


namespace attn {
typedef float f32x16 __attribute__((ext_vector_type(16)));
constexpr int KROW = 208, VROW = 144, KBYTES = 64 * KROW, VBYTES = 64 * VROW, BUF = KBYTES + VBYTES;
__device__ __forceinline__ void unit(LAS unsigned char* lds, const bf16_t* QB, const bf16_t* KB, const bf16_t* VT, bf16_t* MIX, int b, int h, int qrow0, int nkeys, int tid) {
    const int wave = __builtin_amdgcn_readfirstlane(tid >> 6), lane = tid & 63, r32 = lane & 31, hh = lane >> 5;
    bf16x8 qf[6];
    { const bf16_t* qp = QB + (size_t)(qrow0 + 32 * wave + r32) * 768 + h * 96 + 8 * hh;
#pragma unroll
      for (int s6 = 0; s6 < 6; ++s6) qf[s6] = *(const bf16x8*)(qp + 16 * s6); }
    f32x16 o0, o1;
#pragma unroll
    for (int i = 0; i < 16; ++i) { o0[i] = 0.f; o1[i] = 0.f; }
    float mrun = -1e30f, lrun = 0.f;
    const bf16_t* kbase = KB + ((size_t)b * SKEYS * 8 + h) * 96;
    const bf16_t* vbase = VT + ((size_t)(b * 8 + h) * 64) * SKEYS;
    const int kc0 = tid, kc1 = 512 + tid;
    const int kk0 = kc0 / 12, kp0 = kc0 % 12, kk1 = kc1 / 12, kp1 = kc1 % 12, vd = tid >> 3, vp = tid & 7;
    u32x4 ra0, ra1, rav, rb0, rb1, rbv;
    const int ntile = nkeys / 64;
#define ATT_LOAD(t, r0, r1, rv_) do { const int s0 = (t) * 64; r0 = *(const u32x4*)(kbase + (size_t)(s0 + kk0) * 768 + kp0 * 8); \
        if (tid < 256) r1 = *(const u32x4*)(kbase + (size_t)(s0 + kk1) * 768 + kp1 * 8); rv_ = *(const u32x4*)(vbase + (size_t)vd * SKEYS + s0 + vp * 8); } while (0)
#define ATT_STORE(buf, r0, r1, rv_) do { LAS unsigned char* kb_ = lds + (buf) * BUF; *(LAS u32x4*)(kb_ + kk0 * KROW + kp0 * 16) = r0; \
        if (tid < 256) *(LAS u32x4*)(kb_ + kk1 * KROW + kp1 * 16) = r1; *(LAS u32x4*)(kb_ + KBYTES + vd * VROW + vp * 16) = rv_; } while (0)
    const int krow = ((r32 & 0x13) | ((r32 & 4) << 1) | ((r32 & 8) >> 1));
#define ATT_COMPUTE(t) do { \
        LAS unsigned char* kb = lds + ((t) & 1) * BUF; LAS unsigned char* vb = kb + KBYTES; \
        f32x16 s0, s1; \
        _Pragma("unroll") for (int i = 0; i < 16; ++i) { s0[i] = 0.f; s1[i] = 0.f; } \
        _Pragma("unroll") for (int s6 = 0; s6 < 6; ++s6) { \
            const bf16x8 a0 = *(const LAS bf16x8*)(kb + krow * KROW + (16 * s6 + 8 * hh) * 2); \
            const bf16x8 a1 = *(const LAS bf16x8*)(kb + (32 + krow) * KROW + (16 * s6 + 8 * hh) * 2); \
            s0 = __builtin_amdgcn_mfma_f32_32x32x16_bf16(a0, qf[s6], s0, 0, 0, 0); \
            s1 = __builtin_amdgcn_mfma_f32_32x32x16_bf16(a1, qf[s6], s1, 0, 0, 0); } \
        float mx = s0[0]; \
        _Pragma("unroll") for (int i = 1; i < 16; ++i) mx = fmaxf(mx, s0[i]); \
        _Pragma("unroll") for (int i = 0; i < 16; ++i) mx = fmaxf(mx, s1[i]); \
        mx = fmaxf(mx, __shfl_xor(mx, 32)); \
        if (__any(mx > mrun)) { const float mnew = fmaxf(mrun, mx), alpha = __builtin_amdgcn_exp2f(mrun - mnew); \
            _Pragma("unroll") for (int i = 0; i < 16; ++i) { o0[i] *= alpha; o1[i] *= alpha; } lrun *= alpha; mrun = mnew; } \
        float ps = 0.f; \
        _Pragma("unroll") for (int i = 0; i < 16; ++i) { s0[i] = __builtin_amdgcn_exp2f(s0[i] - mrun); s1[i] = __builtin_amdgcn_exp2f(s1[i] - mrun); ps += s0[i] + s1[i]; } \
        lrun += ps; \
        bf16x8 pf[4]; \
        _Pragma("unroll") for (int g = 0; g < 2; ++g) { u32x4 w0, w1; \
            w0.x = cvt_pk_bf16(s0[8 * g + 0], s0[8 * g + 1]); w0.y = cvt_pk_bf16(s0[8 * g + 2], s0[8 * g + 3]); w0.z = cvt_pk_bf16(s0[8 * g + 4], s0[8 * g + 5]); w0.w = cvt_pk_bf16(s0[8 * g + 6], s0[8 * g + 7]); \
            w1.x = cvt_pk_bf16(s1[8 * g + 0], s1[8 * g + 1]); w1.y = cvt_pk_bf16(s1[8 * g + 2], s1[8 * g + 3]); w1.z = cvt_pk_bf16(s1[8 * g + 4], s1[8 * g + 5]); w1.w = cvt_pk_bf16(s1[8 * g + 6], s1[8 * g + 7]); \
            pf[g] = __builtin_bit_cast(bf16x8, w0); pf[2 + g] = __builtin_bit_cast(bf16x8, w1); } \
        _Pragma("unroll") for (int ks = 0; ks < 4; ++ks) { \
            const bf16x8 v0 = *(const LAS bf16x8*)(vb + r32 * VROW + (16 * ks + 8 * hh) * 2); \
            const bf16x8 v1 = *(const LAS bf16x8*)(vb + (32 + r32) * VROW + (16 * ks + 8 * hh) * 2); \
            o0 = __builtin_amdgcn_mfma_f32_32x32x16_bf16(v0, pf[ks], o0, 0, 0, 0); \
            o1 = __builtin_amdgcn_mfma_f32_32x32x16_bf16(v1, pf[ks], o1, 0, 0, 0); } } while (0)
    ATT_LOAD(0, ra0, ra1, rav); ATT_STORE(0, ra0, ra1, rav);
    ATT_LOAD(1, rb0, rb1, rbv);
    __syncthreads();
    for (int t = 0; t < ntile; t += 2) {
        if (t + 2 < ntile) ATT_LOAD(t + 2, ra0, ra1, rav);
        ATT_COMPUTE(t);
        ATT_STORE(1, rb0, rb1, rbv);
        __syncthreads();
        if (t + 3 < ntile) ATT_LOAD(t + 3, rb0, rb1, rbv);
        ATT_COMPUTE(t + 1);
        if (t + 2 < ntile) ATT_STORE(0, ra0, ra1, rav);
        __syncthreads();
    }
#undef ATT_COMPUTE
#undef ATT_LOAD
#undef ATT_STORE
    const float linv = 1.f / (lrun + __shfl_xor(lrun, 32));
    bf16_t* op = MIX + (size_t)(qrow0 + 32 * wave + r32) * 1024 + h * 64 + 4 * hh;
#pragma unroll
    for (int g = 0; g < 4; ++g) {
        u32x2 w0; w0.x = cvt_pk_bf16(o0[4 * g] * linv, o0[4 * g + 1] * linv); w0.y = cvt_pk_bf16(o0[4 * g + 2] * linv, o0[4 * g + 3] * linv); *(u32x2*)(op + 8 * g) = w0;
        u32x2 w1; w1.x = cvt_pk_bf16(o1[4 * g] * linv, o1[4 * g + 1] * linv); w1.y = cvt_pk_bf16(o1[4 * g + 2] * linv, o1[4 * g + 3] * linv); *(u32x2*)(op + 32 + 8 * g) = w1;
    }
}
}


namespace rwkv {
constexpr int C = 32, NCH = SKEYS / C, NCS = 2 * NB * 8 * NCH;
constexpr int TC = 144, CT = 80;
constexpr int O_A = 0, O_B = 4608, O_K = 9216, O_R = 13824, O_BH = 18432, O_KH = 23552, O_VT = 28672, O_WT = 33792, O_UT = 38912, O_GT = 44032,
              O_AAB = 49152, O_AAK = 53248, O_ARB = 55808, O_ARK = 58368, O_TOT = 60928, O_WSUM = 61184, ITEM_BYTES = 62464;
__device__ __forceinline__ int token_row(int dir, int b, int p) {
    if (p < CTX) return NLAT + b * CTX + (dir ? CTX - 1 - p : p);
    const int t = p - CTX; return b * SEQ + (dir ? SEQ - 1 - t : t);
}
__device__ __forceinline__ f32x4 mfma16(bf16x8 a, bf16x8 b, f32x4 c) { return __builtin_amdgcn_mfma_f32_16x16x32_bf16(a, b, c, 0, 0, 0); }
__device__ __forceinline__ bf16x8 ldfrag(const LAS unsigned char* img, int stride, int row, int kbyte) { return *(const LAS bf16x8*)(img + row * stride + kbyte); }

__device__ __forceinline__ void prep_item(LAS unsigned char* L, int cs, bool valid, int tid4, int solve_base, const bf16_t* RKV, const float* LD, const bf16_t* LR, const float* k_k, const float* k_a,
                                          bf16_t* MT, bf16_t* NT, bf16_t* QC, float* Y0) {
    const int w = tid4 >> 6, lane = tid4 & 63, l15 = lane & 15, q4 = lane >> 4;
    const int chunk = cs % NCH, sq = cs / NCH, h = sq & 7, b = (sq >> 3) & 1, dir = sq >> 4;
    { const int t = tid4 >> 3, c0 = (tid4 & 7) * 8; const int m = token_row(dir, b, chunk * C + t);
      const u32x4 xr = *(const u32x4*)(RKV + (size_t)m * 1536 + h * 64 + c0), xk = *(const u32x4*)(RKV + (size_t)m * 1536 + 512 + h * 64 + c0), xv = *(const u32x4*)(RKV + (size_t)m * 1536 + 1024 + h * 64 + c0);
      const u32x4 xl = *(const u32x4*)(LR + (size_t)dir * MR * 512 + (size_t)m * 512 + h * 64 + c0);
      const float* ldp = LD + (size_t)dir * MR * 512 + (size_t)m * 512 + h * 64 + c0; const f32x4 l0 = *(const f32x4*)ldp, l1 = *(const f32x4*)(ldp + 4);
      const f32x4 kk0 = *(const f32x4*)(k_k + h * 64 + c0), kk1 = *(const f32x4*)(k_k + h * 64 + c0 + 4), ka0 = *(const f32x4*)(k_a + h * 64 + c0), ka1 = *(const f32x4*)(k_a + h * 64 + c0 + 4);
      float r[8] = {bflo(xr.x), bfhi(xr.x), bflo(xr.y), bfhi(xr.y), bflo(xr.z), bfhi(xr.z), bflo(xr.w), bfhi(xr.w)};
      float k[8] = {bflo(xk.x), bfhi(xk.x), bflo(xk.y), bfhi(xk.y), bflo(xk.z), bfhi(xk.z), bflo(xk.w), bfhi(xk.w)};
      float v[8] = {bflo(xv.x), bfhi(xv.x), bflo(xv.y), bfhi(xv.y), bflo(xv.z), bfhi(xv.z), bflo(xv.w), bfhi(xv.w)};
      float lr[8] = {bflo(xl.x), bfhi(xl.x), bflo(xl.y), bfhi(xl.y), bflo(xl.z), bfhi(xl.z), bflo(xl.w), bfhi(xl.w)};
      float ld[8] = {l0.x, l0.y, l0.z, l0.w, l1.x, l1.y, l1.z, l1.w};
      const float kkv[8] = {kk0.x, kk0.y, kk0.z, kk0.w, kk1.x, kk1.y, kk1.z, kk1.w}, kav[8] = {ka0.x, ka0.y, ka0.z, ka0.w, ka1.x, ka1.y, ka1.z, ka1.w};
      float cum[8];
#pragma unroll
      for (int j = 0; j < 8; ++j) { float x = ld[j];
#pragma unroll
          for (int d = 8; d < 64; d <<= 1) { const float y = __shfl_up(x, d); if (lane >= d) x += y; }
          cum[j] = x; }
      LAS float* wsum = (LAS float*)(L + O_WSUM);
      if (lane >= 56) {
#pragma unroll
          for (int j = 0; j < 8; ++j) wsum[w * 64 + c0 + j] = cum[j]; }
      __syncthreads();
      float tot[8];
#pragma unroll
      for (int j = 0; j < 8; ++j) { float pre = 0.f, all = 0.f;
#pragma unroll
          for (int ww = 0; ww < 4; ++ww) { const float x = wsum[ww * 64 + c0 + j]; all += x; pre += (ww < w) ? x : 0.f; }
          cum[j] += pre; tot[j] = all; }
      if (t == 0) {
#pragma unroll
          for (int j = 0; j < 8; ++j) ((LAS float*)(L + O_TOT))[c0 + j] = tot[j]; }
      float x2 = 0.f; float xs[8];
#pragma unroll
      for (int j = 0; j < 8; ++j) { xs[j] = k[j] * kkv[j]; x2 += xs[j] * xs[j]; }
      x2 += __shfl_xor(x2, 1); x2 += __shfl_xor(x2, 2); x2 += __shfl_xor(x2, 4);
      const float inv = 1.f / fmaxf(sqrtf(x2), 1e-12f);
      float ia[8], ib[8], ik[8], ir[8], hb[8], hk[8];
#pragma unroll
      for (int j = 0; j < 8; ++j) { const float kkn = xs[j] * inv, bb = kkn * lr[j], kd = k[j] * (1.f + (lr[j] - 1.f) * kav[j]);
          const float ec = __expf(cum[j]), ece = __expf(cum[j] - ld[j]), em = __expf(-cum[j]), eh = __expf(tot[j] - cum[j]);
          ia[j] = -kkn * ece; ib[j] = bb * em; ik[j] = kd * em; ir[j] = r[j] * ec; hb[j] = bb * eh; hk[j] = kd * eh; }
      u32x4 wv;
      wv.x = cvt_pk_bf16(ia[0], ia[1]); wv.y = cvt_pk_bf16(ia[2], ia[3]); wv.z = cvt_pk_bf16(ia[4], ia[5]); wv.w = cvt_pk_bf16(ia[6], ia[7]); *(LAS u32x4*)(L + O_A + t * TC + c0 * 2) = wv;
      wv.x = cvt_pk_bf16(ib[0], ib[1]); wv.y = cvt_pk_bf16(ib[2], ib[3]); wv.z = cvt_pk_bf16(ib[4], ib[5]); wv.w = cvt_pk_bf16(ib[6], ib[7]); *(LAS u32x4*)(L + O_B + t * TC + c0 * 2) = wv;
      wv.x = cvt_pk_bf16(ik[0], ik[1]); wv.y = cvt_pk_bf16(ik[2], ik[3]); wv.z = cvt_pk_bf16(ik[4], ik[5]); wv.w = cvt_pk_bf16(ik[6], ik[7]); *(LAS u32x4*)(L + O_K + t * TC + c0 * 2) = wv;
      wv.x = cvt_pk_bf16(ir[0], ir[1]); wv.y = cvt_pk_bf16(ir[2], ir[3]); wv.z = cvt_pk_bf16(ir[4], ir[5]); wv.w = cvt_pk_bf16(ir[6], ir[7]); *(LAS u32x4*)(L + O_R + t * TC + c0 * 2) = wv;
#pragma unroll
      for (int j = 0; j < 8; ++j) { *(LAS unsigned short*)(L + O_BH + (c0 + j) * CT + t * 2) = (unsigned short)f2bf(hb[j]); *(LAS unsigned short*)(L + O_KH + (c0 + j) * CT + t * 2) = (unsigned short)f2bf(hk[j]);
          *(LAS unsigned short*)(L + O_VT + (c0 + j) * CT + t * 2) = (unsigned short)f2bf(v[j]); }
    }
    __syncthreads();
    { const int offI = (w == 0 || w == 2) ? O_B : O_K, offT = (w < 2) ? O_A : O_R; const bool strict = w < 2;
#pragma unroll
      for (int mi = 0; mi < 2; ++mi)
#pragma unroll
          for (int nt = 0; nt < 2; ++nt) { f32x4 d = {0.f, 0.f, 0.f, 0.f};
#pragma unroll
              for (int ks = 0; ks < 2; ++ks) d = mfma16(ldfrag(L + offI, TC, 16 * mi + l15, (32 * ks + 8 * q4) * 2), ldfrag(L + offT, TC, 16 * nt + l15, (32 * ks + 8 * q4) * 2), d);
              const int t = 16 * nt + l15, i0 = 16 * mi + 4 * q4;
#pragma unroll
              for (int j = 0; j < 4; ++j) { const int i = i0 + j; if (strict ? !(i < t) : !(i <= t)) d[j] = 0.f; }
              if (w == 0) *(LAS f32x4*)(L + O_AAB + t * 128 + i0 * 4) = d;
              else { u32x2 o; o.x = cvt_pk_bf16(d[0], d[1]); o.y = cvt_pk_bf16(d[2], d[3]); *(LAS u32x2*)(L + (w == 1 ? O_AAK : w == 2 ? O_ARB : O_ARK) + t * CT + i0 * 2) = o; } }
    }
    __syncthreads();
    {
#pragma unroll
      for (int mt = 0; mt < 2; ++mt) { f32x4 d = {0.f, 0.f, 0.f, 0.f};
          d = mfma16(ldfrag(L + O_AAK, CT, 16 * mt + l15, 16 * q4), ldfrag(L + O_VT, CT, 16 * w + l15, 16 * q4), d);
          u32x2 o; o.x = cvt_pk_bf16(d[0], d[1]); o.y = cvt_pk_bf16(d[2], d[3]); *(LAS u32x2*)(L + O_GT + (16 * w + l15) * CT + (16 * mt + 4 * q4) * 2) = o; }
    }
    __syncthreads();
    const int sw = w - solve_base;
    if (sw == 0 || sw == 1) {
        float x[32];
        if (sw == 0) {
#pragma unroll
            for (int t = 0; t < 32; ++t) x[t] = bf2f(*(const LAS unsigned short*)(L + O_A + t * TC + lane * 2));
        } else {
#pragma unroll
            for (int g = 0; g < 4; ++g) { const u32x4 y = *(const LAS u32x4*)(L + O_GT + lane * CT + g * 16);
                x[8 * g + 0] = bflo(y.x); x[8 * g + 1] = bfhi(y.x); x[8 * g + 2] = bflo(y.y); x[8 * g + 3] = bfhi(y.y); x[8 * g + 4] = bflo(y.z); x[8 * g + 5] = bfhi(y.z); x[8 * g + 6] = bflo(y.w); x[8 * g + 7] = bfhi(y.w); }
        }
#pragma unroll
        for (int t = 1; t < 32; ++t) { float acc = x[t];
#pragma unroll
            for (int i4 = 0; i4 < (t + 3) / 4; ++i4) { const f32x4 a = *(const LAS f32x4*)(L + O_AAB + t * 128 + i4 * 16);
                acc += a.x * x[4 * i4]; if (4 * i4 + 1 < t) acc += a.y * x[4 * i4 + 1]; if (4 * i4 + 2 < t) acc += a.z * x[4 * i4 + 2]; if (4 * i4 + 3 < t) acc += a.w * x[4 * i4 + 3]; }
            x[t] = acc; }
        LAS unsigned char* dst = L + (sw == 0 ? O_WT : O_UT) + lane * CT;
#pragma unroll
        for (int g = 0; g < 4; ++g) { u32x4 o; o.x = cvt_pk_bf16(x[8 * g], x[8 * g + 1]); o.y = cvt_pk_bf16(x[8 * g + 2], x[8 * g + 3]); o.z = cvt_pk_bf16(x[8 * g + 4], x[8 * g + 5]); o.w = cvt_pk_bf16(x[8 * g + 6], x[8 * g + 7]);
            *(LAS u32x4*)(dst + g * 16) = o; }
    }
    __syncthreads();
    if (valid) {
        const int kb = w >> 1, hf = w & 1;
#pragma unroll
        for (int nt = 0; nt < 2; ++nt) { f32x4 d = {0.f, 0.f, 0.f, 0.f};
            d = mfma16(ldfrag(L + O_WT, CT, 16 * w + l15, 16 * q4), ldfrag(L + O_ARB, CT, 16 * nt + l15, 16 * q4), d);
            const int t = 16 * nt + l15; const u32x2 rr = *(const LAS u32x2*)(L + O_R + t * TC + (16 * w + 4 * q4) * 2);
            u32x2 o; o.x = cvt_pk_bf16(d[0] + bflo(rr.x), d[1] + bfhi(rr.x)); o.y = cvt_pk_bf16(d[2] + bflo(rr.y), d[3] + bfhi(rr.y));
            *(u32x2*)(QC + (size_t)cs * 2048 + t * 64 + 32 * kb + 8 * q4 + 4 * hf) = o; }
#pragma unroll
        for (int mt = 0; mt < 2; ++mt) { f32x4 d = {0.f, 0.f, 0.f, 0.f};
            d = mfma16(ldfrag(L + O_ARK, CT, 16 * mt + l15, 16 * q4), ldfrag(L + O_VT, CT, 16 * w + l15, 16 * q4), d);
            d = mfma16(ldfrag(L + O_ARB, CT, 16 * mt + l15, 16 * q4), ldfrag(L + O_UT, CT, 16 * w + l15, 16 * q4), d);
            *(f32x4*)(Y0 + (size_t)cs * 2048 + ((w * 2 + mt) * 64 + lane) * 4) = d; }
#pragma unroll
        for (int m1 = 0; m1 < 4; ++m1) { f32x4 d = {0.f, 0.f, 0.f, 0.f};
            d = mfma16(ldfrag(L + O_WT, CT, 16 * m1 + l15, 16 * q4), ldfrag(L + O_BH, CT, 16 * w + l15, 16 * q4), d);
            const int c2 = 16 * w + l15, c1 = 16 * m1 + 4 * q4;
#pragma unroll
            for (int j = 0; j < 4; ++j) if (c1 + j == c2) d[j] += __expf(((const LAS float*)(L + O_TOT))[c2]);
            u32x2 o; o.x = cvt_pk_bf16(d[0], d[1]); o.y = cvt_pk_bf16(d[2], d[3]);
            *(u32x2*)(MT + (size_t)cs * 4096 + c2 * 64 + 32 * (m1 >> 1) + 8 * q4 + 4 * (m1 & 1)) = o; }
#pragma unroll
        for (int mc = 0; mc < 4; ++mc) { f32x4 d = {0.f, 0.f, 0.f, 0.f};
            d = mfma16(ldfrag(L + O_BH, CT, 16 * mc + l15, 16 * q4), ldfrag(L + O_UT, CT, 16 * w + l15, 16 * q4), d);
            d = mfma16(ldfrag(L + O_KH, CT, 16 * mc + l15, 16 * q4), ldfrag(L + O_VT, CT, 16 * w + l15, 16 * q4), d);
            u32x2 o; o.x = cvt_pk_bf16(d[0], d[1]); o.y = cvt_pk_bf16(d[2], d[3]);
            *(u32x2*)(NT + (size_t)cs * 4096 + ((w * 4 + mc) * 64 + lane) * 4) = o; }
    }
    __syncthreads();
}

constexpr int RING = 8;
struct StateData { bf16x8 mf[4][2]; u32x2 nt[4]; };
struct OutData { bf16x8 qf[2][2]; f32x4 y0[2]; };
__device__ __forceinline__ void state_load(StateData& d, size_t cs, int slab, int lane, const bf16_t* MT, const bf16_t* NT) {
    const int l15 = lane & 15, q4 = lane >> 4;
#pragma unroll
    for (int mt = 0; mt < 4; ++mt)
#pragma unroll
        for (int kb = 0; kb < 2; ++kb) d.mf[mt][kb] = *(const bf16x8*)(MT + cs * 4096 + (16 * mt + l15) * 64 + 32 * kb + 8 * q4);
#pragma unroll
    for (int mc = 0; mc < 4; ++mc) d.nt[mc] = *(const u32x2*)(NT + cs * 4096 + ((slab * 4 + mc) * 64 + lane) * 4);
}
__device__ __forceinline__ void state_step(const StateData& d, bf16x8 (&sb)[2], int ch, int lane, LAS unsigned char* ring, volatile LAS int* prog, volatile LAS int* ydone) {
    { int guard = 0; while (ch >= *ydone + RING && guard < (1 << 22)) { __builtin_amdgcn_s_sleep(1); ++guard; } }
    LAS bf16x8* slot = (LAS bf16x8*)(ring + (ch & (RING - 1)) * 2048) + lane * 2;
    slot[0] = sb[0]; slot[1] = sb[1];
    __builtin_amdgcn_fence(__ATOMIC_RELEASE, "workgroup");
    if (lane == 0) *prog = ch + 1;
    f32x4 an[4];
#pragma unroll
    for (int mc = 0; mc < 4; ++mc) an[mc] = (f32x4){bflo(d.nt[mc].x), bfhi(d.nt[mc].x), bflo(d.nt[mc].y), bfhi(d.nt[mc].y)};
#pragma unroll
    for (int kb = 0; kb < 2; ++kb)
#pragma unroll
        for (int mt = 0; mt < 4; ++mt) an[mt] = mfma16(d.mf[mt][kb], sb[kb], an[mt]);
#pragma unroll
    for (int kb = 0; kb < 2; ++kb) { u32x4 o; o.x = cvt_pk_bf16(an[2 * kb][0], an[2 * kb][1]); o.y = cvt_pk_bf16(an[2 * kb][2], an[2 * kb][3]); o.z = cvt_pk_bf16(an[2 * kb + 1][0], an[2 * kb + 1][1]); o.w = cvt_pk_bf16(an[2 * kb + 1][2], an[2 * kb + 1][3]);
        sb[kb] = __builtin_bit_cast(bf16x8, o); }
}
__device__ __forceinline__ void state_wave(int sq, int slab, int lane, const bf16_t* MT, const bf16_t* NT, LAS unsigned char* ring, volatile LAS int* prog, volatile LAS int* ydone) {
    bf16x8 sb[2]; { const u32x4 z = {0u, 0u, 0u, 0u}; sb[0] = __builtin_bit_cast(bf16x8, z); sb[1] = sb[0]; }
    const size_t cs0 = (size_t)sq * NCH;
    StateData d0, d1, d2, d3;
    state_load(d0, cs0, slab, lane, MT, NT); state_load(d1, cs0 + 1, slab, lane, MT, NT); state_load(d2, cs0 + 2, slab, lane, MT, NT); state_load(d3, cs0 + 3, slab, lane, MT, NT);
    for (int ch = 0; ch < NCH; ch += 4) {
        const size_t nb = cs0 + (ch + 4 < NCH ? ch + 4 : ch);
        state_step(d0, sb, ch, lane, ring, prog, ydone);     state_load(d0, nb, slab, lane, MT, NT);
        state_step(d1, sb, ch + 1, lane, ring, prog, ydone); state_load(d1, nb + 1, slab, lane, MT, NT);
        state_step(d2, sb, ch + 2, lane, ring, prog, ydone); state_load(d2, nb + 2, slab, lane, MT, NT);
        state_step(d3, sb, ch + 3, lane, ring, prog, ydone); state_load(d3, nb + 3, slab, lane, MT, NT);
    }
}
__device__ __forceinline__ void out_load(OutData& d, size_t cs, int slab, int lane, const bf16_t* QC, const float* Y) {
    const int l15 = lane & 15, q4 = lane >> 4;
#pragma unroll
    for (int mt = 0; mt < 2; ++mt)
#pragma unroll
        for (int kb = 0; kb < 2; ++kb) d.qf[mt][kb] = *(const bf16x8*)(QC + cs * 2048 + (16 * mt + l15) * 64 + 32 * kb + 8 * q4);
#pragma unroll
    for (int mt = 0; mt < 2; ++mt) d.y0[mt] = *(const f32x4*)(Y + cs * 2048 + ((slab * 2 + mt) * 64 + lane) * 4);
}
__device__ __forceinline__ void out_step(const OutData& d, size_t cs, int ch, int slab, int lane, bf16_t* YS, const LAS unsigned char* ring, volatile LAS int* prog, volatile LAS int* ydone) {
    { int guard = 0; while (*prog <= ch && guard < (1 << 22)) { __builtin_amdgcn_s_sleep(1); ++guard; } }
    __builtin_amdgcn_fence(__ATOMIC_ACQUIRE, "workgroup");
    const LAS bf16x8* slot = (const LAS bf16x8*)(ring + (ch & (RING - 1)) * 2048) + lane * 2;
    const bf16x8 s0 = slot[0], s1 = slot[1];
    f32x4 ay[2] = {d.y0[0], d.y0[1]};
#pragma unroll
    for (int mt = 0; mt < 2; ++mt) { ay[mt] = mfma16(d.qf[mt][0], s0, ay[mt]); ay[mt] = mfma16(d.qf[mt][1], s1, ay[mt]); }
    __builtin_amdgcn_fence(__ATOMIC_RELEASE, "workgroup");
    if (lane == 0) *ydone = ch + 1;
#pragma unroll
    for (int mt = 0; mt < 2; ++mt) { u32x2 o; o.x = cvt_pk_bf16(ay[mt][0], ay[mt][1]); o.y = cvt_pk_bf16(ay[mt][2], ay[mt][3]); *(u32x2*)(YS + cs * 2048 + ((slab * 2 + mt) * 64 + lane) * 4) = o; }
}
__device__ __forceinline__ void out_wave(int sq, int slab, int lane, const bf16_t* QC, const float* Y, bf16_t* YS, const LAS unsigned char* ring, volatile LAS int* prog, volatile LAS int* ydone) {
    const size_t cs0 = (size_t)sq * NCH;
    OutData d0, d1, d2;
    out_load(d0, cs0, slab, lane, QC, Y); out_load(d1, cs0 + 1, slab, lane, QC, Y); out_load(d2, cs0 + 2, slab, lane, QC, Y);
    for (int ch = 0; ch < NCH; ch += 3) {
        const size_t nb = cs0 + (ch + 3 < NCH ? ch + 3 : ch);
        out_step(d0, cs0 + ch, ch, slab, lane, YS, ring, prog, ydone);         out_load(d0, nb, slab, lane, QC, Y);
        out_step(d1, cs0 + ch + 1, ch + 1, slab, lane, YS, ring, prog, ydone); out_load(d1, nb + 1, slab, lane, QC, Y);
        out_step(d2, cs0 + ch + 2, ch + 2, slab, lane, YS, ring, prog, ydone); out_load(d2, nb + 2, slab, lane, QC, Y);
    }
}
}

constexpr int NWAVES = 8;
struct Frame {
    LAS unsigned char* lds; volatile LAS unsigned* MISC; unsigned* ctl;
    int tid, lane, wave, vcu, G;
    float* out; unsigned char* ws;
};
enum { I_X = 0, I_C, I_CTX, I_CCTX,
       I0_MODW, I0_MODB, I0_WIN, I0_QNORM, I0_WQUP, I0_KVNORM, I0_WKVUP, I0_CONV, I0_W0F, I0_W2F, I0_W0B, I0_W2B, I0_A0F, I0_A2F, I0_A0B, I0_A2B, I0_G2,
       I0_KK, I0_KA, I0_RK, I0_LNXG, I0_LNXB, I0_WOUT, I0_LN1G, I0_LN1B, I0_FFG, I0_FFU, I0_FFD, I0_LN2G, I0_LN2B,
       I1_MODW, I1_MODB, I1_WIN, I1_DECF, I1_DECB, I1_WOUT, I1_LN1G, I1_LN1B, I1_ROUTER, I1_MOEG, I1_MOEU, I1_MOED, I1_LN2G, I1_LN2B, N_IN };

template <class RowMap>
__device__ __forceinline__ void transpose_item(const float* W, int ldw, int k0, int n0, bf16_t* WT, int ldt, int kofs, const RowMap& rm, LAS float* scr, int lane) {
#pragma unroll 8
    for (int i = 0; i < 32; ++i) { const int kk = 2 * i + (lane >> 5); scr[kk * 33 + (lane & 31)] = W[(size_t)(k0 + kk) * ldw + n0 + (lane & 31)]; }
    asm volatile("s_waitcnt lgkmcnt(0)" ::: "memory");
    const int c = lane & 7;
#pragma unroll
    for (int j = 0; j < 4; ++j) { const int n = (lane >> 3) + 8 * j; const LAS float* s = scr + (8 * c) * 33 + n;
        u32x4 o; o.x = pk2(s[0 * 33], s[1 * 33]); o.y = pk2(s[2 * 33], s[3 * 33]); o.z = pk2(s[4 * 33], s[5 * 33]); o.w = pk2(s[6 * 33], s[7 * 33]);
        *(u32x4*)(WT + (size_t)rm(n0 + n) * ldt + kofs + k0 + 8 * c) = o; }
    asm volatile("s_waitcnt lgkmcnt(0)" ::: "memory");
}
struct RmPlain { int off; __device__ int operator()(int n) const { return off + n; } };
struct RmGU { int off; __device__ int operator()(int n) const { return off + (n >> 7) * 256 + (n & 127); } };

struct RmRope1 { int off; __device__ int operator()(int n) const { const int hf = n & ~127, u = n & 127, i = u & 63; return off + hf + (i >> 4) * 32 + (u >= 64 ? 16 : 0) + (i & 15); } };
struct RmGate1 { __device__ int operator()(int n) const { const int j = n & 2047, isb = n >> 11; return 4096 + (j >> 4) * 32 + isb * 16 + (j & 15); } };
struct RmMlaQ { __device__ int operator()(int n) const { const int h = n / 96, u = n % 96; if (u < 64) return h * 96 + u; const int up = u - 64, f = up >> 4, w = up & 15, i = w & 7, sec = w >> 3; return h * 96 + 64 + sec * 16 + f * 8 + i; } };
struct RmKV2 { __device__ int operator()(int n) const { const int h = n >> 7, d = n & 127; return d < 64 ? h * 64 + d : 512 + h * 64 + (d - 64); } };
struct RmMlaKV { __device__ int operator()(int n) const { const int h = n >> 7, d = n & 127; return d < 64 ? 768 + h * 64 + d : 1280 + h * 64 + (d - 64); } };
__device__ __forceinline__ void sincos_tab(double a, float& sn, float& cs) {
    const double k = rint(a * 0.63661977236758134308);
    const double r = (a - k * 1.57079632679489655800) - k * 6.123233995736766e-17;
    const int q = ((int)k) & 3; const double r2 = r * r;
    const double sv = r * (1.0 - r2 / 6.0 * (1.0 - r2 / 20.0 * (1.0 - r2 / 42.0 * (1.0 - r2 / 72.0 * (1.0 - r2 / 110.0 * (1.0 - r2 / 156.0))))));
    const double cv = 1.0 - r2 / 2.0 * (1.0 - r2 / 12.0 * (1.0 - r2 / 30.0 * (1.0 - r2 / 56.0 * (1.0 - r2 / 90.0 * (1.0 - r2 / 132.0)))));
    const double ss = (q == 0) ? sv : (q == 1) ? cv : (q == 2) ? -sv : -cv;
    const double cc = (q == 0) ? cv : (q == 1) ? -sv : (q == 2) ? -cv : sv;
    sn = (float)ss; cs = (float)cc;
}
__device__ __forceinline__ void rope_tables(Frame& F) {
    f32x2* t0 = (f32x2*)(F.ws + WS_SMALL + SM_ROPE0); f32x2* t1 = (f32x2*)(F.ws + WS_SMALL + SM_ROPE1);
    const int gt = (F.vcu * NWAVES + F.wave) * 64 + F.lane, NGT = F.G * NWAVES * 64;
    for (int i = gt; i < 128 * 8 + 128 * 64; i += NGT) {
        const bool first = i < 1024; const int j = first ? i : i - 1024, nf = first ? 8 : 64, pos = j / nf, fi = j % nf;
        const float invf = (float)exp2(-(double)fi / (double)nf * 13.287712379549449);
        const float ang = (float)pos * invf; float sn, cs; sincos_tab((double)ang, sn, cs);
        (first ? t0 : t1)[j] = (f32x2){cs, sn};
    }
}
template <class RowMap>
__device__ __forceinline__ void convert_matrix(Frame& F, int& cursor, const float* W, int K, int N, int ldw, bf16_t* WT, int ldt, int kofs, const RowMap& rm, int gw = -1, int NGW = 0) {
    LAS float* scr = (LAS float*)(F.lds + F.wave * 16384);
    if (gw < 0) { gw = F.vcu * NWAVES + F.wave; NGW = F.G * NWAVES; }
    const int nblk = N / 32, nit = (K / 64) * nblk;
    int first = (gw - cursor % NGW + NGW) % NGW;
    for (int it = first; it < nit; it += NGW) transpose_item(W, ldw, 64 * (it / nblk), 32 * (it % nblk), WT, ldt, kofs, rm, scr, F.lane);
    cursor += nit;
}
__device__ __forceinline__ void zero_rect(Frame& F, bf16_t* base, int ld, int r0, int nr, int c0, int nc) {
    const int per_row = nc / 8, total = nr * per_row, gt = (F.vcu * NWAVES + F.wave) * 64 + F.lane, NGT = F.G * NWAVES * 64;
    for (int i = gt; i < total; i += NGT) { const int r = i / per_row, c = (i % per_row) * 8; *(u32x4*)(base + (size_t)(r0 + r) * ld + c0 + c) = (u32x4){0u, 0u, 0u, 0u}; }
}

__device__ __forceinline__ void mod_vectors(Frame& F, const float* modw0, const float* modb0, const float* modw1, const float* modb1, const float* cvec, const float* cctx) {
    if (blockIdx.x >= 96) return;
    const int layer = blockIdx.x / 48, cb = blockIdx.x % 48;
    const float* W = layer ? modw1 : modw0; const float* bias = layer ? modb1 : modb0;
    LAS float* sc = (LAS float*)F.lds;
    LAS float* red = sc + 3 * 1024;
    for (int i = F.tid; i < 3 * 1024; i += 512) { const int cls = i / 1024, k = i % 1024; const float v = cls < 2 ? cvec[cls * 1024 + k] : cctx[k]; sc[i] = silu_f(v); }
    __syncthreads();
    const int col = cb * 128 + 2 * F.lane;
    float a[3][2] = {{0.f, 0.f}, {0.f, 0.f}, {0.f, 0.f}};
    for (int k = F.wave * 128; k < F.wave * 128 + 128; ++k) {
        const f32x2 w = *(const f32x2*)(W + (size_t)k * 6144 + col);
#pragma unroll
        for (int c = 0; c < 3; ++c) { const float s = sc[c * 1024 + k]; a[c][0] += s * w.x; a[c][1] += s * w.y; }
    }
#pragma unroll
    for (int c = 0; c < 3; ++c) { red[(F.wave * 3 + c) * 128 + 2 * F.lane] = a[c][0]; red[(F.wave * 3 + c) * 128 + 2 * F.lane + 1] = a[c][1]; }
    __syncthreads();
    float* mod = (float*)(F.ws + WS_SMALL + SM_MOD) + (size_t)layer * 3 * 6144;
    if (F.tid < 384) { const int c = F.tid / 128, j = F.tid % 128; float s = bias[cb * 128 + j];
#pragma unroll
        for (int w = 0; w < 8; ++w) s += red[(w * 3 + c) * 128 + j];
        mod[c * 6144 + cb * 128 + j] = s; }
    __syncthreads();
}

struct Row4 { f32x4 v[4]; };
__device__ __forceinline__ Row4 row_load(const float* p, int lane) { Row4 r; const f32x4* q = (const f32x4*)p + lane;
#pragma unroll
    for (int j = 0; j < 4; ++j) r.v[j] = q[64 * j]; return r; }
__device__ __forceinline__ void row_store(float* p, int lane, const Row4& r) { f32x4* q = (f32x4*)p + lane;
#pragma unroll
    for (int j = 0; j < 4; ++j) q[64 * j] = r.v[j]; }
__device__ __forceinline__ void row_store_bf16(bf16_t* p, int lane, const Row4& r) { u32x2* q = (u32x2*)p + lane;
#pragma unroll
    for (int j = 0; j < 4; ++j) { u32x2 w; w.x = pk2(r.v[j].x, r.v[j].y); w.y = pk2(r.v[j].z, r.v[j].w); q[64 * j] = w; } }
__device__ __forceinline__ Row4 row_ln(const Row4& a, const float* g, const float* b, int lane) {
    float s = 0.f;
#pragma unroll
    for (int j = 0; j < 4; ++j) s += (a.v[j].x + a.v[j].y) + (a.v[j].z + a.v[j].w);
    const float mean = wave_sum(s) * (1.f / DM); float s2 = 0.f; Row4 d;
#pragma unroll
    for (int j = 0; j < 4; ++j) { d.v[j] = a.v[j] - mean; s2 += (d.v[j].x * d.v[j].x + d.v[j].y * d.v[j].y) + (d.v[j].z * d.v[j].z + d.v[j].w * d.v[j].w); }
    const float rstd = 1.f / sqrtf(wave_sum(s2) * (1.f / DM) + LN_EPS);
    const Row4 gg = row_load(g, lane), bb = row_load(b, lane); Row4 o;
#pragma unroll
    for (int j = 0; j < 4; ++j) o.v[j] = d.v[j] * rstd * gg.v[j] + bb.v[j];
    return o;
}
__device__ __forceinline__ void ctx_fix(Row4& p, const float* part, int nsl, int lane) {
#pragma unroll
    for (int j = 0; j < 4; ++j) p.v[j] = p.v[j] * ALPHA;
    for (int sl = 0; sl < nsl; ++sl) { const Row4 q = row_load(part + (size_t)sl * NCTX * 1024, lane);
#pragma unroll
        for (int j = 0; j < 4; ++j) p.v[j] = p.v[j] + q.v[j]; }
}
__device__ __forceinline__ Row4 row_mod(const Row4& a, const float* shift, const float* scale, int lane) {
    const Row4 sh = row_load(shift, lane), sc = row_load(scale, lane); Row4 o;
#pragma unroll
    for (int j = 0; j < 4; ++j) o.v[j] = a.v[j] * (sc.v[j] + 1.f) + sh.v[j];
    return o;
}

struct Args { const float* in[N_IN]; float* out; unsigned char* ws; int ph_lo, ph_hi; };
constexpr int N_PHASES = 32;

__global__ void __launch_bounds__(NWAVES * 64, 2) mk_fwd(Args args) {
    extern __shared__ __attribute__((aligned(16))) unsigned char lds_raw[];
    Frame F;
    F.lds = (LAS unsigned char*)lds_raw; F.MISC = (volatile LAS unsigned*)(F.lds + MISC_OFF);
    F.tid = threadIdx.x; F.lane = F.tid & 63; F.wave = __builtin_amdgcn_readfirstlane(F.tid >> 6);
    F.G = gridDim.x; { const int bx = blockIdx.x; F.vcu = (F.G % 8 == 0) ? (bx % 8) * (F.G / 8) + bx / 8 : bx; }
    F.out = args.out; F.ws = args.ws; F.ctl = (unsigned*)(args.ws + WS_CTL);
    for (int u = F.tid; u < (LDS_BYTES - LDSCTL_OFF) / 4; u += NWAVES * 64) ((LAS unsigned*)(F.lds + LDSCTL_OFF))[u] = 0u;
    __syncthreads();
    XcdBarrier bar = xcd_barrier_post(F.ctl + CW_BAR, F.MISC + 8);
    const int lo = args.ph_lo, hi = args.ph_hi;
#ifndef ONLY_PH
#define ONLY_PH -1
#endif
#define IN(k) ((ONLY_PH < 0 || ONLY_PH == (k)) && lo <= (k) && (k) < hi)
#define INP(i) (args.in[i])
#ifndef DBL_PH
#define DBL_PH -1
#endif
#define REPS(k) (((k) == DBL_PH) ? 2 : 1)
#define SEAM(k) do { if (IN(k) && IN((k) + 1)) xcd_barrier(bar); } while (0)
    unsigned char* ws = args.ws;
    const float* mod0 = (const float*)(ws + WS_SMALL + SM_MOD);
    const float* mod1 = mod0 + 3 * 6144;
    const int gw = F.vcu * NWAVES + F.wave, NGW = F.G * NWAVES;

    if (IN(0)) {
        for (int r_ = 0; r_ < REPS(0); ++r_) mod_vectors(F, INP(I0_MODW), INP(I0_MODB), INP(I1_MODW), INP(I1_MODB), INP(I_C), INP(I_CCTX));
        int cur = 0;
        if (DBL_PH == 29) for (int r_ = 0; r_ < 2; ++r_) { convert_matrix(F, cur, INP(I1_WIN), 1024, 1024, ODD_IN, (bf16_t*)(ws + WS_W1IN), 1024, 0, RmRope1{0}); convert_matrix(F, cur, INP(I1_WIN) + 4096, 1024, 4096, ODD_IN, (bf16_t*)(ws + WS_W1IN), 1024, 0, RmGate1{}); convert_matrix(F, cur, INP(I0_FFD), FF, 1024, 1024, (bf16_t*)(ws + WS_W0DN), FF, 0, RmPlain{0}); }
        rope_tables(F);
        if (blockIdx.x == 100) { float* b4 = (float*)(ws + WS_SMALL + SM_BIAS4); b4[F.tid] = INP(I0_W0F)[F.tid]; b4[512 + F.tid] = INP(I0_W0B)[F.tid]; b4[1024 + F.tid] = INP(I0_A0F)[F.tid]; b4[1536 + F.tid] = INP(I0_A0B)[F.tid]; }
        convert_matrix(F, cur, INP(I0_WIN), 1024, E_IN, E_IN, (bf16_t*)(ws + WS_W0IN), 1024, 0, RmPlain{0});
        zero_rect(F, (bf16_t*)(ws + WS_W0IN), 1024, E_IN, E_INP - E_IN, 0, 1024);
        convert_matrix(F, cur, INP(I0_WQUP), 256, 768, 768, (bf16_t*)(ws + WS_WMLAQ), 256, 0, RmMlaQ{});
        convert_matrix(F, cur, INP(I0_WKVUP), 128, 1024, 1024, (bf16_t*)(ws + WS_WKV), 128, 0, RmKV2{});
        { bf16_t* WL = (bf16_t*)(ws + WS_WLORA);
          convert_matrix(F, cur, INP(I0_W2F), 64, 512, 512, WL, 128, 0, RmPlain{0});
          convert_matrix(F, cur, INP(I0_W2B), 64, 512, 512, WL, 128, 0, RmPlain{512});
          convert_matrix(F, cur, INP(I0_A2F), 64, 512, 512, WL, 128, 0, RmPlain{1024});
          convert_matrix(F, cur, INP(I0_A2B), 64, 512, 512, WL, 128, 0, RmPlain{1536});
          convert_matrix(F, cur, INP(I0_G2), 128, 512, 512, WL, 128, 0, RmPlain{2048});
          zero_rect(F, WL, 128, 0, 2048, 64, 64); }
    }
    SEAM(0);


    if (IN(1)) {
        for (int m_ = gw; m_ < MR * REPS(1); m_ += NGW) { const int m = m_ % MR;
            const Row4 xr = row_load(m < NLAT ? INP(I_X) + (size_t)m * 1024 : INP(I_CTX) + (size_t)(m - NLAT) * 1024, F.lane);
            const float* md = mod0 + (size_t)row_class(m) * 6144;
            row_store_bf16((bf16_t*)(ws + WS_XMOD) + (size_t)m * 1024, F.lane, row_mod(xr, md, md + 1024, F.lane));
        }
    }
    SEAM(1);

    if (IN(2)) {
        pg8::DenseOrder S; S.init((const bf16_t*)(ws + WS_XMOD), 1024, (const bf16_t*)(ws + WS_W0IN), 1024, MR, E_INP, 1024, F.G, (int)blockIdx.x); S.reps = REPS(2);
        pg8::EpiBf16 E{(bf16_t*)(ws + WS_Z0), E_INP};
        pg8::gemm_phase<pg8::EpiBf16, pg8::DenseOrder, true, false>(F.lds, 1024, 1024, S, E);
    }
    SEAM(2);

    if (IN(3)) {
        LAS unsigned short* wscr = (LAS unsigned short*)(F.lds + F.wave * 128);
        const f32x2* rope0 = (const f32x2*)(ws + WS_SMALL + SM_ROPE0);
        bf16_t* AM = (bf16_t*)(ws + WS_AMLA); bf16_t* AL = (bf16_t*)(ws + WS_ALORA); bf16_t* RKV = (bf16_t*)(ws + WS_RKV); bf16_t* KBp = (bf16_t*)(ws + WS_KB);
        const float* convw = INP(I0_CONV);
        for (int m_ = gw; m_ < MR * REPS(3); m_ += NGW) { const int m = m_ % MR;
            const bf16_t* Z = (const bf16_t*)(ws + WS_Z0) + (size_t)m * E_INP;
            const bool lat = m < NLAT;
            const int b = lat ? (m >> 13) : ((m - NLAT) >> 8), tpos = lat ? (m & (SEQ - 1)) : ((m - NLAT) & (CTX - 1)), slen = lat ? SEQ : CTX;
            { const u32x2 w = *(const u32x2*)(Z + 4 * F.lane); const float v0 = bflo(w.x), v1 = bfhi(w.x), v2 = bflo(w.y), v3 = bfhi(w.y);
              const float r = rsqrtf(wave_sum(v0 * v0 + v1 * v1 + v2 * v2 + v3 * v3) * (1.f / 256.f) + 1e-6f);
              const f32x4 g = *(const f32x4*)(INP(I0_QNORM) + 4 * F.lane);
              u32x2 o; o.x = pk2(v0 * r * g.x, v1 * r * g.y); o.y = pk2(v2 * r * g.z, v3 * r * g.w); *(u32x2*)(AM + (size_t)m * 384 + 4 * F.lane) = o; }
            { const unsigned w = *(const unsigned*)(Z + 256 + 2 * F.lane); const float v0 = bflo(w), v1 = bfhi(w);
              const float r = rsqrtf(wave_sum(v0 * v0 + v1 * v1) * (1.f / 128.f) + 1e-6f);
              const f32x2 g = *(const f32x2*)(INP(I0_KVNORM) + 2 * F.lane);
              *(unsigned*)(AM + (size_t)m * 384 + 256 + 2 * F.lane) = pk2(v0 * r * g.x, v1 * r * g.y); }
            { if (F.lane < 16) { const int f = F.lane >> 3, i = F.lane & 7; const float t1 = bf2f(Z[384 + f * 16 + i]), t2 = bf2f(Z[384 + f * 16 + i + 8]);
                  float o1 = t1, o2 = t2;
                  if (lat) { const f32x2 cs = rope0[(f ? (tpos & 63) : (tpos >> 6)) * 8 + i]; o1 = t1 * cs.x - t2 * cs.y; o2 = t1 * cs.y + t2 * cs.x; }
                  wscr[F.lane] = (unsigned short)f2bf(o1); wscr[16 + F.lane] = (unsigned short)f2bf(o2); }
              asm volatile("s_waitcnt lgkmcnt(0)" ::: "memory");
              if (F.lane < 32) { const u32x4 c = *(const LAS u32x4*)((const LAS unsigned char*)wscr + (F.lane & 3) * 16);
                  const int sk = lat ? CTX + tpos : tpos;
                  *(u32x4*)(KBp + ((size_t)(b * SKEYS + sk) * 8 + (F.lane >> 2)) * 96 + 64 + (F.lane & 3) * 8) = c; }
              asm volatile("s_waitcnt lgkmcnt(0)" ::: "memory"); }
            { const bf16_t* R0 = Z + 416; const bool hp = tpos > 0, hn = tpos < slen - 1;
#pragma unroll
              for (int g = 0; g < 3; ++g) { const int c = 8 * (F.lane + 64 * g);
                  const u32x4 xc = *(const u32x4*)(R0 + c);
                  const u32x4 xp = hp ? *(const u32x4*)(R0 - E_INP + c) : (u32x4){0u, 0u, 0u, 0u};
                  const u32x4 xn = hn ? *(const u32x4*)(R0 + E_INP + c) : (u32x4){0u, 0u, 0u, 0u};
                  float o[8];
#pragma unroll
                  for (int q = 0; q < 2; ++q) { const f32x4 w0 = *(const f32x4*)(convw + c + 4 * q), w1 = *(const f32x4*)(convw + 1536 + c + 4 * q), w2 = *(const f32x4*)(convw + 3072 + c + 4 * q);
                      const unsigned p0 = q ? xp.z : xp.x, p1 = q ? xp.w : xp.y, c0 = q ? xc.z : xc.x, c1 = q ? xc.w : xc.y, n0 = q ? xn.z : xn.x, n1 = q ? xn.w : xn.y;
                      o[4 * q + 0] = bflo(p0) * w0.x + bflo(c0) * w1.x + bflo(n0) * w2.x; o[4 * q + 1] = bfhi(p0) * w0.y + bfhi(c0) * w1.y + bfhi(n0) * w2.y;
                      o[4 * q + 2] = bflo(p1) * w0.z + bflo(c1) * w1.z + bflo(n1) * w2.z; o[4 * q + 3] = bfhi(p1) * w0.w + bfhi(c1) * w1.w + bfhi(n1) * w2.w; }
                  u32x4 w; w.x = pk2(o[0], o[1]); w.y = pk2(o[2], o[3]); w.z = pk2(o[4], o[5]); w.w = pk2(o[6], o[7]);
                  *(u32x4*)(RKV + (size_t)m * 1536 + c) = w; } }
            { if (F.lane < 48) { const u32x4 x = *(const u32x4*)(Z + 1952 + 8 * F.lane); float v[8] = {bflo(x.x), bfhi(x.x), bflo(x.y), bfhi(x.y), bflo(x.z), bfhi(x.z), bflo(x.w), bfhi(x.w)};
#pragma unroll
                  for (int j = 0; j < 8; ++j) { if (F.lane < 16) { const float e = __expf(2.f * v[j]); v[j] = 1.f - 2.f / (e + 1.f); } else if (F.lane >= 32) v[j] = sigmoid_f(v[j]); }
                  u32x4 w; w.x = pk2(v[0], v[1]); w.y = pk2(v[2], v[3]); w.z = pk2(v[4], v[5]); w.w = pk2(v[6], v[7]);
                  *(u32x4*)(AL + (size_t)m * 384 + 8 * F.lane) = w; } }
        }
    }
    SEAM(3);

    if (IN(4)) {
        { pg8::BlockOrder S{(const bf16_t*)(ws + WS_ALORA), (const bf16_t*)(ws + WS_WLORA), 384, 128, 128, MR / 256, 2, 5, 64, F.G, (int)blockIdx.x, REPS(4)};
          pg8::EpiLora E{(float*)(ws + WS_LDF), (bf16_t*)(ws + WS_LRF), (const float*)(ws + WS_SMALL + SM_BIAS4)};
          pg8::gemm_phase<pg8::EpiLora, pg8::BlockOrder, true, false>(F.lds, 384, 128, S, E); }
        { pg8::EpiMlaQK E{(bf16_t*)(ws + WS_QB), (bf16_t*)(ws + WS_KB), (const f32x2*)(ws + WS_SMALL + SM_ROPE0), 0.10206207261596577f * 1.4426950408889634f};
          { pg8::DenseOrder S; S.init((const bf16_t*)(ws + WS_AMLA), 384, (const bf16_t*)(ws + WS_WMLAQ), 256, MR, 768, 256, F.G, (int)blockIdx.x); S.reps = REPS(4);
            pg8::gemm_phase<pg8::EpiMlaQK, pg8::DenseOrder, true, false>(F.lds, 384, 256, S, E); }
          { pg8::BlockOrder S{(const bf16_t*)(ws + WS_AMLA) + 256 - 3 * 0, (const bf16_t*)(ws + WS_WKV) - (size_t)3 * 256 * 128, 384, 128, 128, MR / 256, 2, 1, 0, F.G, (int)blockIdx.x, REPS(4)}; S.nblk = 1;
            pg8::gemm_phase<pg8::EpiMlaQK, pg8::KnopeOrder, true, false>(F.lds, 384, 128, pg8::KnopeOrder{S}, E); } }
        { pg8::DenseOrder S; S.init((const bf16_t*)(ws + WS_WKV) + (size_t)512 * 128, 128, (const bf16_t*)(ws + WS_AMLA) + 256, 384, 512, MR, 128, F.G, (int)blockIdx.x); S.reps = REPS(4);
          pg8::EpiVT E{(bf16_t*)(ws + WS_VT)};
          pg8::gemm_phase<pg8::EpiVT, pg8::DenseOrder, true, false>(F.lds, 128, 384, S, E); }
    }
    SEAM(4);


    if (IN(5)) {
        const int grp = F.tid >> 8, tid4 = F.tid & 255;
        for (int it0 = F.vcu * 2 + grp; it0 < ((rwkv::NCS * REPS(5) + 2 * F.G - 1) / (2 * F.G)) * 2 * F.G; it0 += 2 * F.G) {
            const bool valid = it0 < rwkv::NCS * REPS(5); const int it = it0 % rwkv::NCS; const int cs = valid ? it : rwkv::NCS - 1;
            rwkv::prep_item(F.lds + grp * rwkv::ITEM_BYTES, cs, valid, tid4, 2 * grp, (const bf16_t*)(ws + WS_RKV), (const float*)(ws + WS_LDF), (const bf16_t*)(ws + WS_LRF), INP(I0_KK), INP(I0_KA),
                            (bf16_t*)(ws + WS_MT), (bf16_t*)(ws + WS_NT), (bf16_t*)(ws + WS_QC), (float*)(ws + WS_Y0));
        }
    }
    SEAM(5);

    if (IN(6)) {
        const bf16_t* QBp = (const bf16_t*)(ws + WS_QB); const bf16_t* KBp = (const bf16_t*)(ws + WS_KB); const bf16_t* VTp = (const bf16_t*)(ws + WS_VT); bf16_t* MIX = (bf16_t*)(ws + WS_MIX0);
        for (int uu = F.vcu; uu < (512 + 32) * REPS(6); uu += F.G) { const int u = uu % 544; if (u >= 512 && !(u & 1)) continue;
            if (u < 512) { const int bh = u >> 5, qb = u & 31, b = bh >> 3, h = bh & 7; attn::unit(F.lds, QBp, KBp, VTp, MIX, b, h, b * SEQ + qb * 256, SKEYS, F.tid); }
            else { const int bh = (u - 512) >> 1, b = bh >> 3, h = bh & 7; attn::unit(F.lds, QBp, KBp, VTp, MIX, b, h, NLAT + b * CTX, CTX, F.tid); }
        }
        __syncthreads();
        { volatile LAS int* prog = (volatile LAS int*)(F.lds + 0);
          if (F.tid == 0) { *prog = 0; *(prog + 16) = 0; }
          __syncthreads();
          if ((F.vcu & 1) == 0) { const int k = F.vcu >> 1; volatile LAS int* ydone = prog + 16; LAS unsigned char* ring = F.lds + 1024;
              if (F.wave == 0) rwkv::state_wave(k >> 2, k & 3, F.lane, (const bf16_t*)(ws + WS_MT), (const bf16_t*)(ws + WS_NT), ring, prog, ydone);
              else if (F.wave == 1) rwkv::out_wave(k >> 2, k & 3, F.lane, (const bf16_t*)(ws + WS_QC), (const float*)(ws + WS_Y0), (bf16_t*)(ws + WS_YS), ring, prog, ydone);
          }
          if (F.vcu & 1) {
              const int gwo = (F.vcu >> 1) * NWAVES + F.wave, NGWo = (F.G >> 1) * NWAVES; int cur = 0;
              convert_matrix(F, cur, INP(I0_WOUT), 1024, 1024, 1024, (bf16_t*)(ws + WS_W0OUT), 1024, 0, RmPlain{0}, gwo, NGWo);
              convert_matrix(F, cur, INP(I0_FFG), 1024, FF, FF, (bf16_t*)(ws + WS_W0GU), 1024, 0, RmGU{0}, gwo, NGWo);
              convert_matrix(F, cur, INP(I0_FFU), 1024, FF, FF, (bf16_t*)(ws + WS_W0GU), 1024, 0, RmGU{128}, gwo, NGWo);
              convert_matrix(F, cur, INP(I0_FFD), FF, 1024, 1024, (bf16_t*)(ws + WS_W0DN), FF, 0, RmPlain{0}, gwo, NGWo);
              convert_matrix(F, cur, INP(I1_WOUT), RET_VD, 1024, 1024, (bf16_t*)(ws + WS_W1OUT), RET_VD, 0, RmPlain{0}, gwo, NGWo);
              convert_matrix(F, cur, INP(I1_WIN), 1024, 1024, ODD_IN, (bf16_t*)(ws + WS_W1IN), 1024, 0, RmRope1{0}, gwo, NGWo);
              convert_matrix(F, cur, INP(I1_WIN) + 1024, 1024, 1024, ODD_IN, (bf16_t*)(ws + WS_W1IN), 1024, 0, RmRope1{1024}, gwo, NGWo);
              convert_matrix(F, cur, INP(I1_WIN) + 2048, 1024, 2048, ODD_IN, (bf16_t*)(ws + WS_W1IN), 1024, 0, RmPlain{2048}, gwo, NGWo);
              convert_matrix(F, cur, INP(I1_WIN) + 4096, 1024, 4096, ODD_IN, (bf16_t*)(ws + WS_W1IN), 1024, 0, RmGate1{}, gwo, NGWo); } }
    }
    SEAM(6);

    if (IN(7)) {
        const bf16_t* Y = (const bf16_t*)(ws + WS_YS); const bf16_t* RKV = (const bf16_t*)(ws + WS_RKV); const bf16_t* LRF = (const bf16_t*)(ws + WS_LRF); const bf16_t* GG = (const bf16_t*)(ws + WS_GG);
        const float* k_a = INP(I0_KA); const float* r_k = INP(I0_RK); const float* lnx_g = INP(I0_LNXG); const float* lnx_b = INP(I0_LNXB);
        for (int m_ = gw; m_ < MR * REPS(7); m_ += NGW) { const int m = m_ % MR;
            const bool lat = m < NLAT; const int b = lat ? (m >> 13) : ((m - NLAT) >> 8), tp = lat ? (m & (SEQ - 1)) : ((m - NLAT) & (CTX - 1));
            const int pf = lat ? CTX + tp : tp, pb = lat ? CTX + (SEQ - 1 - tp) : (CTX - 1 - tp);
            const int tf = pf & 31, tb = pb & 31, lo_ = ((F.lane >> 4) * 2) * 256 + (F.lane & 15) * 4;
            const size_t yfo = ((size_t)((0 * 2 + b) * 8) * rwkv::NCH + (pf >> 5)) * 2048 + lo_ + (tf >> 4) * 256 + ((tf & 15) >> 2) * 64 + (tf & 3);
            const size_t ybo = ((size_t)((1 * 2 + b) * 8) * rwkv::NCH + (pb >> 5)) * 2048 + lo_ + (tb >> 4) * 256 + ((tb & 15) >> 2) * 64 + (tb & 3);
            unsigned short ry[8][8];
#pragma unroll
            for (int h = 0; h < 8; ++h) { const int ch = h * 64 + F.lane;
                ry[h][0] = Y[yfo + (size_t)h * rwkv::NCH * 2048]; ry[h][1] = Y[ybo + (size_t)h * rwkv::NCH * 2048];
                ry[h][2] = RKV[(size_t)m * 1536 + ch]; ry[h][3] = RKV[(size_t)m * 1536 + 512 + ch]; ry[h][4] = RKV[(size_t)m * 1536 + 1024 + ch];
                ry[h][5] = LRF[(size_t)m * 512 + ch]; ry[h][6] = LRF[(size_t)MR * 512 + (size_t)m * 512 + ch]; ry[h][7] = GG[(size_t)m * 512 + ch]; }
            float res[8];
#pragma unroll
            for (int h = 0; h < 8; ++h) { const int ch = h * 64 + F.lane;
                const float ys = bf2f(ry[h][0]) + bf2f(ry[h][1]), mean = wave_sum(ys) * (1.f / 64.f), dv = ys - mean, var = wave_sum(dv * dv) * (1.f / 64.f);
                const float yn = dv * rsqrtf(var + 64e-5f) * lnx_g[ch] + lnx_b[ch];
                const float r = bf2f(ry[h][2]), k = bf2f(ry[h][3]), v = bf2f(ry[h][4]), lf = bf2f(ry[h][5]), lb = bf2f(ry[h][6]);
                const float ksum = k * (2.f + (lf + lb - 2.f) * k_a[ch]);
                const float bonus = wave_sum(r * ksum * r_k[ch]) * v;
                res[h] = (yn + bonus) * bf2f(ry[h][7]); }
#pragma unroll
            for (int h = 0; h < 8; ++h) ((bf16_t*)(ws + WS_MIX0))[(size_t)m * 1024 + 512 + h * 64 + F.lane] = (bf16_t)f2bf(res[h]);
        }
    }
    SEAM(7);

    if (IN(8)) {
        { pg8::DenseOrder S; S.init((const bf16_t*)(ws + WS_MIX0), 1024, (const bf16_t*)(ws + WS_W0OUT), 1024, NLAT, 1024, 1024, F.G, (int)blockIdx.x); S.reps = REPS(8);
          pg8::EpiResGate E{(float*)(ws + WS_PRE), INP(I_X), mod0 + 2 * 1024, 1024, 0};
          pg8::gemm_phase<pg8::EpiResGate, pg8::DenseOrder, true, false>(F.lds, 1024, 1024, S, E); }
        { pg8::CtxSliceOrder S{(const bf16_t*)(ws + WS_MIX0) + (size_t)NLAT * 1024, (const bf16_t*)(ws + WS_W0OUT), 1024, 1024, 4, 4, F.G, (int)blockIdx.x, REPS(8)};
          pg8::EpiCtxPart E{(float*)(ws + WS_PART8), mod0 + 2 * 6144 + 2 * 1024};
          pg8::gemm_phase<pg8::EpiCtxPart, pg8::CtxSliceOrder, true, false>(F.lds, 1024, 1024, S, E); }
    }
    SEAM(8);

    if (IN(9)) {
        for (int m_ = gw; m_ < MR * REPS(9); m_ += NGW) { const int m = m_ % MR;
            const bool isctx = m >= NLAT;
            Row4 p = row_load(isctx ? INP(I_CTX) + (size_t)(m - NLAT) * 1024 : (const float*)(ws + WS_PRE) + (size_t)m * 1024, F.lane);
            if (isctx) ctx_fix(p, (const float*)(ws + WS_PART8) + (size_t)(m - NLAT) * 1024, 4, F.lane);
            const Row4 x1 = row_ln(p, INP(I0_LN1G), INP(I0_LN1B), F.lane);
            row_store((float*)(ws + WS_X1) + (size_t)m * 1024, F.lane, x1);
            const float* md = mod0 + (size_t)row_class(m) * 6144;
            row_store_bf16((bf16_t*)(ws + WS_XMOD) + (size_t)m * 1024, F.lane, row_mod(x1, md + 3 * 1024, md + 4 * 1024, F.lane));
        }
    }
    SEAM(9);

    if (IN(10)) {
        pg8::DenseOrder S; S.init((const bf16_t*)(ws + WS_XMOD), 1024, (const bf16_t*)(ws + WS_W0GU), 1024, MR, 2 * FF, 1024, F.G, (int)blockIdx.x); S.reps = REPS(10);
        pg8::EpiSwiGLU E{(bf16_t*)(ws + WS_HFF), FF};
        pg8::gemm_phase<pg8::EpiSwiGLU, pg8::DenseOrder, true, false>(F.lds, 1024, 1024, S, E);
    }
    SEAM(10);

    if (IN(11)) {
        { pg8::DenseOrder S; S.init((const bf16_t*)(ws + WS_HFF), FF, (const bf16_t*)(ws + WS_W0DN), FF, NLAT, 1024, FF, F.G, (int)blockIdx.x); S.reps = REPS(11);
          pg8::EpiResGate E{(float*)(ws + WS_PRE), (const float*)(ws + WS_X1), mod0 + 5 * 1024, 1024, 0};
          pg8::gemm_phase<pg8::EpiResGate, pg8::DenseOrder, true, false>(F.lds, FF, FF, S, E); }
        { pg8::CtxSliceOrder S{(const bf16_t*)(ws + WS_HFF) + (size_t)NLAT * FF, (const bf16_t*)(ws + WS_W0DN), FF, FF, 4, 11, F.G, (int)blockIdx.x, REPS(11)};
          pg8::EpiCtxPart E{(float*)(ws + WS_PART11), mod0 + 2 * 6144 + 5 * 1024};
          pg8::gemm_phase<pg8::EpiCtxPart, pg8::CtxSliceOrder, true, false>(F.lds, FF, FF, S, E); }
    }
    SEAM(11);

    if (IN(12)) {
        for (int m_ = gw; m_ < MR * REPS(12); m_ += NGW) { const int m = m_ % MR;
            const bool isctx = m >= NLAT;
            Row4 p = row_load((const float*)(ws + (isctx ? WS_X1 : WS_PRE)) + (size_t)m * 1024, F.lane);
            if (isctx) ctx_fix(p, (const float*)(ws + WS_PART11) + (size_t)(m - NLAT) * 1024, 11, F.lane);
            const Row4 x2 = row_ln(p, INP(I0_LN2G), INP(I0_LN2B), F.lane);
            float* dst = m < NLAT ? F.out + (size_t)m * 1024 : (float*)(ws + WS_XC2) + (size_t)(m - NLAT) * 1024;
            row_store(dst, F.lane, x2);
            const float* md = mod1 + (size_t)row_class(m) * 6144;
            row_store_bf16((bf16_t*)(ws + WS_XMOD1) + (size_t)m * 1024, F.lane, row_mod(x2, md, md + 1024, F.lane));
        }
    }
    SEAM(12);


    if (IN(13)) {
        { pg8::DenseOrder S; S.init((const bf16_t*)(ws + WS_XMOD1), 1024, (const bf16_t*)(ws + WS_W1IN), 1024, NLAT, 2048, 1024, F.G, (int)blockIdx.x); S.reps = REPS(13);
          pg8::EpiQK1 E{(bf16_t*)(ws + WS_Q1), (bf16_t*)(ws + WS_K1), (const f32x2*)(ws + WS_SMALL + SM_ROPE1)};
          pg8::gemm_phase<pg8::EpiQK1, pg8::DenseOrder, true, false>(F.lds, 1024, 1024, S, E); }
        { pg8::DenseOrder S; S.init((const bf16_t*)(ws + WS_W1IN) + (size_t)1024 * 1024, 1024, (const bf16_t*)(ws + WS_XMOD1), 1024, 3072, MR, 1024, F.G, (int)blockIdx.x); S.reps = REPS(13);
          pg8::EpiKVT E{(bf16_t*)(ws + WS_KDT), (bf16_t*)(ws + WS_VT1), (const f32x2*)(ws + WS_SMALL + SM_ROPE1), INP(I1_DECF), INP(I1_DECB)};
          pg8::gemm_phase<pg8::EpiKVT, pg8::DenseOrder, true, false>(F.lds, 1024, 1024, S, E); }
    }
    SEAM(13);

    if (IN(14)) {
#ifndef SKIP_SCORE
        { pg8::ScoreOrder S{(const bf16_t*)(ws + WS_Q1), (const bf16_t*)(ws + WS_K1), F.G, (int)blockIdx.x, REPS(14)};
          pg8::EpiScore E{(bf16_t*)(ws + WS_PFB), INP(I1_DECF), INP(I1_DECB)};
          pg8::gemm_phase<pg8::EpiScore, pg8::ScoreOrder, true, false>(F.lds, 1024, 1024, S, E); }
#endif
#ifndef SKIP_STATE
        { pg8::StateOrder S{(const bf16_t*)(ws + WS_VT1), (const bf16_t*)(ws + WS_KDT), F.G, (int)blockIdx.x, REPS(14)};
          pg8::EpiBf16 E{(bf16_t*)(ws + WS_ST), 256};
          pg8::gemm_phase<pg8::EpiBf16, pg8::StateOrder, true, false>(F.lds, 256, 256, S, E); }
#endif
    }
    SEAM(14);

    if (IN(15)) {
        const int gt = gw * 64 + F.lane, NGT = NGW * 64; bf16_t* ST = (bf16_t*)(ws + WS_ST);
        for (int it = gt; it < 2 * 8 * 16384; it += NGT) { const int e8 = it & 16383, bh = (it >> 14) & 7, dir = it >> 17, h = bh & 3;
            const float g256 = exp2f(256.f * pg8::lg2gamma(dir ? INP(I1_DECB) : INP(I1_DECF), h));
            bf16_t* p = ST + ((size_t)dir * 8 * RCH + bh * RCH) * 131072 + (size_t)e8 * 8;
            float run[8]; { const u32x4 x = *(const u32x4*)p; run[0] = bflo(x.x); run[1] = bfhi(x.x); run[2] = bflo(x.y); run[3] = bfhi(x.y); run[4] = bflo(x.z); run[5] = bfhi(x.z); run[6] = bflo(x.w); run[7] = bfhi(x.w); }
#pragma unroll 1
            for (int g8 = 0; g8 < 4; ++g8) {
                u32x4 x[8];
#pragma unroll
                for (int q = 0; q < 8; ++q) { const int sl = dir ? RCH - 1 - (8 * g8 + q) : 1 + 8 * g8 + q; x[q] = *(const u32x4*)(p + (size_t)sl * 131072); }
#pragma unroll
                for (int q = 0; q < 8; ++q) { const int sl = dir ? RCH - 1 - (8 * g8 + q) : 1 + 8 * g8 + q;
                    const float kv[8] = {bflo(x[q].x), bfhi(x[q].x), bflo(x[q].y), bfhi(x[q].y), bflo(x[q].z), bfhi(x[q].z), bflo(x[q].w), bfhi(x[q].w)};
                    if (dir) { u32x4 w; w.x = pk2(run[0], run[1]); w.y = pk2(run[2], run[3]); w.z = pk2(run[4], run[5]); w.w = pk2(run[6], run[7]); *(u32x4*)(p + (size_t)sl * 131072) = w; }
#pragma unroll
                    for (int j = 0; j < 8; ++j) run[j] = run[j] * g256 + kv[j];
                    if (!dir) { u32x4 w; w.x = pk2(run[0], run[1]); w.y = pk2(run[2], run[3]); w.z = pk2(run[4], run[5]); w.w = pk2(run[6], run[7]); *(u32x4*)(p + (size_t)sl * 131072) = w; } } }
        }
    }
    SEAM(15);

    if (IN(16)) {
        pg8::OutOrder S{(const bf16_t*)(ws + WS_PFB), (const bf16_t*)(ws + WS_Q1), (const bf16_t*)(ws + WS_VT1), (const bf16_t*)(ws + WS_ST), F.G, (int)blockIdx.x, REPS(16)};
        pg8::EpiRetOut E{(bf16_t*)(ws + WS_OF), (bf16_t*)(ws + WS_OB), INP(I1_DECF), INP(I1_DECB), (float*)(ws + WS_GNP)};
        pg8::gemm_phase<pg8::EpiRetOut, pg8::OutOrder, true, false>(F.lds, 1024, 256, S, E);
    }
    SEAM(16);

    if (IN(17)) {
        const int gt = gw * 64 + F.lane, NGT = NGW * 64; const f32x4* gp = (const f32x4*)(ws + WS_GNP); f32x2* st = (f32x2*)(ws + WS_GNS);
        for (int i = gt; i < NLAT * 8; i += NGT) { float s1 = 0.f, s2 = 0.f;
#pragma unroll
            for (int q = 0; q < 4; ++q) { const f32x4 v = gp[(size_t)i * 4 + q]; s1 += v.x + v.z; s2 += v.y + v.w; }
            const float mean = s1 * (1.f / 512.f); st[i] = (f32x2){mean, rsqrtf(fmaxf(s2 * (1.f / 512.f) - mean * mean, 0.f) + 1e-6f)}; }
    }
    SEAM(17);

    if (IN(18)) {
        pg8::DenseOrder S; S.init((const bf16_t*)(ws + WS_XMOD1), 1024, (const bf16_t*)(ws + WS_W1IN) + (size_t)4096 * 1024, 1024, NLAT, 4096, 1024, F.G, (int)blockIdx.x); S.reps = REPS(18);
        pg8::EpiGate1 E{(bf16_t*)(ws + WS_MIX1), (const bf16_t*)(ws + WS_OF), (const bf16_t*)(ws + WS_OB), (const f32x2*)(ws + WS_GNS)};
        pg8::gemm_phase<pg8::EpiGate1, pg8::DenseOrder, true, false>(F.lds, 1024, 1024, S, E);
    }
    SEAM(18);

    if (IN(19)) {
        pg8::DenseOrder S; S.init((const bf16_t*)(ws + WS_MIX1), RET_VD, (const bf16_t*)(ws + WS_W1OUT), RET_VD, NLAT, 1024, RET_VD, F.G, (int)blockIdx.x); S.reps = REPS(19);
        pg8::EpiResGate E{F.out, F.out, mod1 + 2 * 1024, 1024, 0};
        pg8::gemm_phase<pg8::EpiResGate, pg8::DenseOrder, true, false>(F.lds, RET_VD, RET_VD, S, E);
    }
    SEAM(19);

    if (IN(20)) {
        const float* router = INP(I1_ROUTER);
        int* tok_e = (int*)(ws + WS_SMALL + SM_TOKE); float* tok_g = (float*)(ws + WS_SMALL + SM_TOKG); int* tok_p = (int*)(ws + WS_SMALL + SM_TOKP);
        LAS unsigned* lcnt = (LAS unsigned*)(F.lds + 64); LAS unsigned* lbase = lcnt + 8;
        if (F.tid < 8) lcnt[F.tid] = 0u;
        __syncthreads();
        for (int m = gw; m < NLAT; m += NGW) {
            const Row4 p = row_load(F.out + (size_t)m * 1024, F.lane);
            const Row4 x3 = row_ln(p, INP(I1_LN1G), INP(I1_LN1B), F.lane);
            row_store(F.out + (size_t)m * 1024, F.lane, x3);
            const float* md = mod1 + (size_t)row_class(m) * 6144;
            const Row4 h = row_mod(x3, md + 3 * 1024, md + 4 * 1024, F.lane);
            row_store_bf16((bf16_t*)(ws + WS_HMOE) + (size_t)m * 1024, F.lane, h);
            float lg[8] = {0.f, 0.f, 0.f, 0.f, 0.f, 0.f, 0.f, 0.f};
#pragma unroll
            for (int j = 0; j < 4; ++j)
#pragma unroll
                for (int q = 0; q < 4; ++q) { const int k = 4 * F.lane + 256 * j + q; const f32x4 r0 = *(const f32x4*)(router + (size_t)k * 8), r1 = *(const f32x4*)(router + (size_t)k * 8 + 4); const float hv = h.v[j][q];
                    lg[0] += hv * r0.x; lg[1] += hv * r0.y; lg[2] += hv * r0.z; lg[3] += hv * r0.w; lg[4] += hv * r1.x; lg[5] += hv * r1.y; lg[6] += hv * r1.z; lg[7] += hv * r1.w; }
#pragma unroll
            for (int e = 0; e < 8; ++e) lg[e] = wave_sum(lg[e]);
            int e0 = 0; float v0 = lg[0];
#pragma unroll
            for (int e = 1; e < 8; ++e) if (lg[e] > v0) { v0 = lg[e]; e0 = e; }
            int e1 = -1; float v1 = -3.0e38f;
#pragma unroll
            for (int e = 0; e < 8; ++e) if (e != e0 && lg[e] > v1) { v1 = lg[e]; e1 = e; }
            const float g0 = 1.f / (1.f + __expf(v1 - v0));
            if (F.lane == 0) {
                const int p0 = (int)__hip_atomic_fetch_add(lcnt + e0, 1u, __ATOMIC_RELAXED, __HIP_MEMORY_SCOPE_WORKGROUP), p1 = (int)__hip_atomic_fetch_add(lcnt + e1, 1u, __ATOMIC_RELAXED, __HIP_MEMORY_SCOPE_WORKGROUP);
                tok_e[2 * m] = e0; tok_e[2 * m + 1] = e1; tok_g[2 * m] = g0; tok_g[2 * m + 1] = 1.f - g0; tok_p[2 * m] = p0; tok_p[2 * m + 1] = p1; }
        }
        __syncthreads();
        if (F.tid < 8) lbase[F.tid] = atomicAdd(F.ctl + CW_MOECNT + 64 * F.tid, lcnt[F.tid]);
        __syncthreads();
        for (int m = gw; m < NLAT; m += NGW) { if (F.lane < 2) { const int i = 2 * m + F.lane; tok_p[i] += (int)lbase[tok_e[i]]; } }
        __syncthreads();
        int cur = 0;
        for (int e_ = 0; e_ < 8 * REPS(20); ++e_) { const int e = e_ & 7;
            convert_matrix(F, cur, INP(I1_MOEG) + (size_t)e * 1024 * DFE, 1024, DFE, DFE, (bf16_t*)(ws + WS_MOEGU) + (size_t)e * 2 * DFE * 1024, 1024, 0, RmGU{0});
            convert_matrix(F, cur, INP(I1_MOEU) + (size_t)e * 1024 * DFE, 1024, DFE, DFE, (bf16_t*)(ws + WS_MOEGU) + (size_t)e * 2 * DFE * 1024, 1024, 0, RmGU{128});
            convert_matrix(F, cur, INP(I1_MOED) + (size_t)e * DFE * 1024, DFE, 1024, 1024, (bf16_t*)(ws + WS_MOEDN) + (size_t)e * 1024 * DFE, DFE, 0, RmPlain{0});
        }
    }
    SEAM(20);

    if (IN(21)) {
        int* tok_e = (int*)(ws + WS_SMALL + SM_TOKE); int* tok_p = (int*)(ws + WS_SMALL + SM_TOKP); int* slot_tok = (int*)(ws + WS_SMALL + SM_SLOT);
        int pst[8], cn[8]; { int bs = 0;
#pragma unroll
            for (int e = 0; e < 8; ++e) { cn[e] = (int)__hip_atomic_load(F.ctl + CW_MOECNT + 64 * e, RLX_AGENT); pst[e] = bs; bs += ((cn[e] + 255) >> 8) << 8; } }
        const int gt = gw * 64 + F.lane, NGT = NGW * 64;
        for (int i = gt; i < 2 * NLAT; i += NGT) { const int e = tok_e[i]; int ps = 0;
#pragma unroll
            for (int j = 0; j < 8; ++j) ps = (e == j) ? pst[j] : ps;
            const int slot = ps + tok_p[i]; ((int*)(ws + WS_SMALL + SM_TOKS))[i] = slot; slot_tok[slot] = i >> 1; }
        if (gt < 8 * 256) { const int e = gt >> 8, j = gt & 255; int ps = 0, c = 0;
#pragma unroll
            for (int q = 0; q < 8; ++q) { ps = (e == q) ? pst[q] : ps; c = (e == q) ? cn[q] : c; }
            if (c + j < (((c + 255) >> 8) << 8)) slot_tok[ps + c + j] = 0; }
    }
    SEAM(21);

#define MOE_HALF_PHASES(PHGU, PHDN, B0_, B1_) \
    if (IN(PHGU)) { pg8::MoeOrder S; S.A = (const char*)(ws + WS_HMOE); S.W = (const char*)(ws + WS_MOEGU); S.slot_tok = (const int*)(ws + WS_SMALL + SM_SLOT); S.wstride = (size_t)2 * DFE * 1024 * 2; \
        S.lda = 1024; S.ldb = 1024; S.K = 1024; S.npn = 2 * DFE / 256; S.G = F.G; S.c = (int)blockIdx.x; S.gather = true; S.reps = REPS(PHGU); S.init(F.ctl + CW_MOECNT, B0_, B1_); \
        pg8::EpiSwiGLU E{(bf16_t*)(ws + WS_HMID), DFE}; \
        pg8::gemm_phase<pg8::EpiSwiGLU, pg8::MoeOrder, true, true>(F.lds, 1024, 1024, S, E); } \
    SEAM(PHGU); \
    if (IN(PHDN)) { pg8::MoeOrder S; S.A = (const char*)(ws + WS_HMID); S.W = (const char*)(ws + WS_MOEDN); S.slot_tok = (const int*)(ws + WS_SMALL + SM_SLOT); S.wstride = (size_t)1024 * DFE * 2; \
        S.lda = DFE; S.ldb = DFE; S.K = DFE; S.npn = 4; S.G = F.G; S.c = (int)blockIdx.x; S.gather = false; S.reps = REPS(PHDN); S.ksplit = 2; S.init(F.ctl + CW_MOECNT, B0_, B1_); \
        pg8::EpiBf16Sel E{(bf16_t*)(ws + WS_YB), 1024, ((long)WS_YB2 - (long)WS_YB) / 2}; \
        pg8::gemm_phase<pg8::EpiBf16Sel, pg8::MoeOrder, true, false>(F.lds, DFE, DFE, S, E); } \
    SEAM(PHDN);
    MOE_HALF_PHASES(22, 23, 0, MOE_MAXBLK)
#undef MOE_HALF_PHASES

    if (IN(26)) {
        const float* tok_g = (const float*)(ws + WS_SMALL + SM_TOKG); const int* tok_s = (const int*)(ws + WS_SMALL + SM_TOKS); const bf16_t* YB = (const bf16_t*)(ws + WS_YB);
        for (int m = gw; m < NLAT; m += NGW) {
            const Row4 x3 = row_load(F.out + (size_t)m * 1024, F.lane);
            const float g0 = tok_g[2 * m], g1 = tok_g[2 * m + 1]; const int s0 = tok_s[2 * m], s1 = tok_s[2 * m + 1];
            const Row4 gate = row_load(mod1 + (size_t)row_class(m) * 6144 + 5 * 1024, F.lane);
            const u32x2* y0 = (const u32x2*)(YB + (size_t)s0 * 1024) + F.lane; const u32x2* y1 = (const u32x2*)(YB + (size_t)s1 * 1024) + F.lane;
            const u32x2* z0 = (const u32x2*)((const bf16_t*)(ws + WS_YB2) + (size_t)s0 * 1024) + F.lane; const u32x2* z1 = (const u32x2*)((const bf16_t*)(ws + WS_YB2) + (size_t)s1 * 1024) + F.lane;
            Row4 q;
#pragma unroll
            for (int j = 0; j < 4; ++j) { const u32x2 a = y0[64 * j], b = y1[64 * j], a2 = z0[64 * j], b2 = z1[64 * j];
                const f32x4 y = ((f32x4){bflo(a.x), bfhi(a.x), bflo(a.y), bfhi(a.y)} + (f32x4){bflo(a2.x), bfhi(a2.x), bflo(a2.y), bfhi(a2.y)}) * g0
                              + ((f32x4){bflo(b.x), bfhi(b.x), bflo(b.y), bfhi(b.y)} + (f32x4){bflo(b2.x), bfhi(b2.x), bflo(b2.y), bfhi(b2.y)}) * g1;
                q.v[j] = x3.v[j] * ALPHA + gate.v[j] * y; }
            row_store(F.out + (size_t)m * 1024, F.lane, row_ln(q, INP(I1_LN2G), INP(I1_LN2B), F.lane));
        }
    }
    if (DBL_PH == 28) { for (int i_ = 0; i_ < 20; ++i_) xcd_barrier(bar); }
#undef IN
#undef INP
#undef SEAM
}

extern "C" void kernel_launch(void* const* d_in, const int* in_sizes, int n_in, void* d_out, int out_size, void* d_ws, size_t ws_size, hipStream_t stream) {
    static int grid = 0;
    if (grid == 0) {
        if (n_in != N_IN || out_size != NLAT * DM || ws_size < WS_END) { fprintf(stderr, "kernel_launch: unexpected shapes: n_in %d out %d ws %zu (need %zu)\n", n_in, out_size, ws_size, (size_t)WS_END); }
        int dev = 0, cus = 0, per_cu = 0;
        hipGetDevice(&dev); hipDeviceGetAttribute(&cus, hipDeviceAttributeMultiprocessorCount, dev);
        hipFuncSetAttribute((const void*)mk_fwd, hipFuncAttributeMaxDynamicSharedMemorySize, LDS_BYTES);
        hipOccupancyMaxActiveBlocksPerMultiprocessor(&per_cu, (const void*)mk_fwd, NWAVES * 64, LDS_BYTES);
        (void)hipGetLastError();
        grid = cus > 0 ? cus : 256;
        if (per_cu < 1) fprintf(stderr, "kernel_launch: occupancy query reports %d\n", per_cu);
    }
    hipMemsetAsync((char*)d_ws + WS_CTL, 0, CTL_BYTES, stream);
    Args a{};
    for (int i = 0; i < N_IN; ++i) a.in[i] = (const float*)d_in[i];
    a.out = (float*)d_out; a.ws = (unsigned char*)d_ws; a.ph_lo = 0; a.ph_hi = N_PHASES;
    hipLaunchKernelGGL(mk_fwd, dim3(grid), dim3(NWAVES * 64), LDS_BYTES, stream, a);
}
```

```cpp
#include <hip/hip_runtime.h>
#include <cstdio>
#include <cstdint>

#define LAS __attribute__((address_space(3)))
#define GAS __attribute__((address_space(1)))
typedef unsigned short bf16_t;
typedef short bf16x8 __attribute__((ext_vector_type(8)));
typedef float f32x4 __attribute__((ext_vector_type(4)));
typedef float f32x2 __attribute__((ext_vector_type(2)));
typedef unsigned u32x4 __attribute__((ext_vector_type(4)));
typedef unsigned u32x2 __attribute__((ext_vector_type(2)));

constexpr int DM = 1024, NB = 2, SEQ = 8192, NLAT = NB * SEQ, CTX = 256, NCTX = NB * CTX, MR = NLAT + NCTX;
constexpr int SKEYS = CTX + SEQ;
constexpr int E_IN = 2336, E_INP = 2560, FF = 2816, ODD_IN = 8192, RET_VD = 2048, DFE = 3584, NEXP = 8;
constexpr float ALPHA = 1.4142135623730951f;
constexpr float LN_EPS = 1e-5f;

constexpr size_t MiB = 1048576;
constexpr size_t WS_CTL = 0, CTL_BYTES = 65536;
constexpr size_t WS_SMALL = 1 * MiB;
constexpr size_t SM_MOD = 0;
constexpr size_t SM_ROPE0 = 262144;
constexpr size_t SM_ROPE1 = 262144 + 65536;
constexpr size_t SM_BIAS4 = 200704;
constexpr size_t SM_TOKE = 393216;
constexpr size_t SM_TOKG = 524288;
constexpr size_t SM_TOKP = 655360;
constexpr size_t SM_SLOT = 786432;
constexpr size_t SM_TOKS = 1179648;
constexpr size_t SM_END = 2 * MiB;
constexpr size_t WS_W0IN = 3 * MiB;
constexpr size_t WS_X3 = 3 * MiB;
constexpr size_t WS_WMLAQ = 8 * MiB;
constexpr size_t WS_WKV = 8 * MiB + 768 * 256 * 2;
constexpr size_t WS_WMLAV = 8 * MiB + 1280 * 384 * 2;
constexpr size_t WS_WLORA = 9 * MiB + MiB / 2;
constexpr size_t WS_W0OUT = 11 * MiB + MiB / 2;
constexpr size_t WS_W0GU = 13 * MiB + MiB / 2;
constexpr size_t WS_W0DN = 24 * MiB + MiB / 2;
constexpr size_t WS_W1IN = 30 * MiB;
constexpr size_t WS_W1OUT = 46 * MiB;
constexpr size_t WS_R0 = 50 * MiB;
constexpr size_t WS_R1 = 218 * MiB;
constexpr size_t WS_END = 536 * MiB;
constexpr size_t WS_XMOD = 50 * MiB;
constexpr size_t WS_MIX0 = 267 * MiB + MiB / 2;
constexpr size_t WS_PRE = 383 * MiB;
constexpr size_t WS_X1 = 481 * MiB;
constexpr size_t WS_Z0 = 83 * MiB;
constexpr size_t WS_AMLA = 165 * MiB + MiB / 2;
constexpr size_t WS_ALORA = 178 * MiB;
constexpr size_t WS_RKV = 218 * MiB;
constexpr size_t WS_LDF = 267 * MiB + MiB / 2;
constexpr size_t WS_LDB = 300 * MiB + MiB / 2;
constexpr size_t WS_LRF = 333 * MiB + MiB / 2;
constexpr size_t WS_LRB = 350 * MiB;
constexpr size_t WS_GG = 366 * MiB + MiB / 2;
constexpr size_t WS_QB = 50 * MiB;
constexpr size_t WS_KB = 190 * MiB + MiB / 2;
constexpr size_t WS_VT = 74 * MiB + 3 * MiB / 4;
constexpr size_t WS_QC = 91 * MiB + MiB / 4;
constexpr size_t WS_Y0 = 124 * MiB + MiB / 4;
constexpr size_t WS_YS = 300 * MiB + MiB / 2;
constexpr size_t WS_MT = 383 * MiB;
constexpr size_t WS_NT = 449 * MiB;
constexpr size_t WS_HFF = 83 * MiB;
constexpr size_t WS_PART8 = 515 * MiB;
constexpr size_t WS_PART11 = 176 * MiB;
constexpr size_t WS_XC2 = 531 * MiB + MiB / 2;
constexpr size_t WS_XMOD1 = 480 * MiB;
constexpr size_t WS_K1 = 83 * MiB;
constexpr size_t WS_Q1 = 115 * MiB;
constexpr size_t WS_VT1 = 147 * MiB;
constexpr size_t WS_KDT = 218 * MiB;
constexpr size_t WS_PFB = 284 * MiB;
constexpr size_t WS_ST = 348 * MiB;
constexpr size_t WS_OF = 218 * MiB;
constexpr size_t WS_OB = 50 * MiB;
constexpr size_t WS_GNP = 522 * MiB;
constexpr size_t WS_GNS = 514 * MiB;
constexpr size_t WS_XMOD1B = 284 * MiB;
constexpr size_t WS_MIX1 = 348 * MiB;
constexpr size_t WS_PRE1 = 412 * MiB;
constexpr int RCH = 33;
constexpr size_t WS_MOEGU = 50 * MiB;
constexpr size_t WS_MOEDN = 162 * MiB;
constexpr size_t WS_HMID = 218 * MiB;
constexpr size_t WS_HMOE = 456 * MiB;
constexpr size_t WS_YB = 456 * MiB;
constexpr size_t WS_YB2 = 50 * MiB;
constexpr int MOE_MAXBLK = 136;

constexpr int CW_BAR = 4096;
constexpr int CW_MOECNT = 8192;

constexpr int RING_BYTES = 131072, LDSCTL_OFF = RING_BYTES, MISC_OFF = LDSCTL_OFF + 320, LDS_BYTES = 147456;

#define RLX_AGENT __ATOMIC_RELAXED, __HIP_MEMORY_SCOPE_AGENT
__device__ __forceinline__ unsigned f2bf(float f) { unsigned u = __builtin_bit_cast(unsigned, f); return (u + 0x7fffu + ((u >> 16) & 1u)) >> 16; }
__device__ __forceinline__ unsigned pk2(float lo, float hi) { return f2bf(lo) | (f2bf(hi) << 16); }
__device__ __forceinline__ float bf2f(unsigned short b) { return __builtin_bit_cast(float, ((unsigned)b) << 16); }
__device__ __forceinline__ float bflo(unsigned u) { return __builtin_bit_cast(float, u << 16); }
__device__ __forceinline__ float bfhi(unsigned u) { return __builtin_bit_cast(float, u & 0xffff0000u); }
typedef __bf16 bf16x2_t __attribute__((ext_vector_type(2)));
__device__ __forceinline__ unsigned cvt_pk_bf16(float lo, float hi) { const f32x2 v = {lo, hi}; const bf16x2_t b = __builtin_convertvector(v, bf16x2_t); return __builtin_bit_cast(unsigned, b); }
template <int CTRL, int ROWMASK>
__device__ __forceinline__ float dpp_take(float v) { return __builtin_bit_cast(float, __builtin_amdgcn_update_dpp(0, __builtin_bit_cast(int, v), CTRL, ROWMASK, 0xf, false)); }
__device__ __forceinline__ float wave_sum(float v) {
    v += dpp_take<0xB1, 0xf>(v);
    v += dpp_take<0x4E, 0xf>(v);
    v += dpp_take<0x141, 0xf>(v);
    v += dpp_take<0x140, 0xf>(v);
    v += dpp_take<0x142, 0xa>(v);
    v += dpp_take<0x143, 0xc>(v);
    return __builtin_bit_cast(float, __builtin_amdgcn_readlane(__builtin_bit_cast(int, v), 63));
}
__device__ __forceinline__ float silu_f(float t) { return t * __builtin_amdgcn_rcpf(1.f + __builtin_amdgcn_exp2f(-1.4426950408889634f * t)); }
__device__ __forceinline__ float sigmoid_f(float t) { return __builtin_amdgcn_rcpf(1.f + __builtin_amdgcn_exp2f(-1.4426950408889634f * t)); }
__device__ __forceinline__ int row_class(int m) { return m < SEQ ? 0 : (m < NLAT ? 1 : 2); }

#define XB_TMO      128
#define XB_XCNT(j)  (256  + 64 * (j))
#define XB_XSUB(j)  (1280 + 64 * (j))
#define XB_XGEN(j)  (2304 + 64 * (j))
#define XB_TOP      3328
#define XB_TOPGEN   3392
#define XCD_BAR_WORDS 3456
#define XB_SPIN_CAP (1u << 18)
__device__ __forceinline__ unsigned xb_ld(unsigned* p)              { return __hip_atomic_load(p, __ATOMIC_RELAXED, __HIP_MEMORY_SCOPE_AGENT); }
__device__ __forceinline__ unsigned xb_add(unsigned* p, unsigned v) { return __hip_atomic_fetch_add(p, v, __ATOMIC_RELAXED, __HIP_MEMORY_SCOPE_AGENT); }
__device__ __forceinline__ unsigned xb_xcc_id() { return (unsigned)__builtin_amdgcn_s_getreg((3 << 11) | 20) & 0xFu; }
#define XB_SPIN(cond, bar) do { unsigned _sp = 0; while (cond) { __builtin_amdgcn_s_sleep(1); \
    if ((++_sp & 255u) == 0u) { if (xb_ld(&(bar)[XB_TMO])) break; if (_sp > XB_SPIN_CAP) { atomicAdd(&(bar)[XB_TMO], 1u); break; } } } } while (0)
struct XcdBarrier { unsigned* bar; unsigned x; volatile LAS unsigned* st; };
__device__ __forceinline__ XcdBarrier xcd_barrier_post(unsigned* bar, volatile LAS unsigned* st) {
    XcdBarrier b; b.bar = bar; b.x = xb_xcc_id(); b.st = st;
    if (threadIdx.x == 0) (void)xb_add(&bar[XB_XCNT(b.x)], 1u);
    return b;
}
__device__ __forceinline__ void xcd_barrier_complete(unsigned* bar, unsigned x, unsigned& nloc, unsigned& nx) {
    const unsigned G = gridDim.x * gridDim.y * gridDim.z;
    unsigned sum, cnt, mine, sp = 0u;
    for (;;) {
        sum = 0u; cnt = 0u; mine = 0u;
#pragma unroll
        for (unsigned j = 0; j < 16; ++j) { const unsigned c = xb_ld(&bar[XB_XCNT(j)]); sum += c; cnt += (c > 0u) ? 1u : 0u; mine = (j == x) ? c : mine; }
        if (sum == G) break;
        __builtin_amdgcn_s_sleep(1);
        if ((++sp & 255u) == 0u) { if (xb_ld(&bar[XB_TMO])) break; if (sp > XB_SPIN_CAP) { atomicAdd(&bar[XB_TMO], 1u); break; } }
    }
    nloc = mine > 0u ? mine : 1u; nx = cnt > 0u ? cnt : 1u;
}
__device__ __forceinline__ void xcd_barrier(const XcdBarrier& b) {
    asm volatile("s_waitcnt vmcnt(0)" ::: "memory");
    __syncthreads();
    if (threadIdx.x == 0) {
        unsigned* bar = b.bar;
        __builtin_amdgcn_s_waitcnt(0);
        unsigned nloc = b.st[0], nx = b.st[1];
        if (nloc == 0u) { xcd_barrier_complete(bar, b.x, nloc, nx); b.st[0] = nloc; b.st[1] = nx; }
        const unsigned old = xb_add(&bar[XB_XSUB(b.x)], 1u);
        const unsigned gen = old / nloc;
        if (old + 1u == (gen + 1u) * nloc) {
            __builtin_amdgcn_fence(__ATOMIC_RELEASE, "agent");
            asm volatile("s_waitcnt vmcnt(0)" ::: "memory");
            const unsigned og = xb_add(&bar[XB_TOP], 1u);
            const unsigned tg = og / nx;
            if (og + 1u == (tg + 1u) * nx) xb_add(&bar[XB_TOPGEN], 1u);
            else XB_SPIN(xb_ld(&bar[XB_TOPGEN]) == tg, bar);
            __builtin_amdgcn_fence(__ATOMIC_ACQUIRE, "agent");
            xb_add(&bar[XB_XGEN(b.x)], 1u);
            asm volatile("s_waitcnt vmcnt(0)" ::: "memory");
        } else {
            XB_SPIN(xb_ld(&bar[XB_XGEN(b.x)]) == gen, bar);
            __builtin_amdgcn_fence(__ATOMIC_ACQUIRE, "agent");
            asm volatile("s_waitcnt vmcnt(0)" ::: "memory");
        }
    }
    __syncthreads();
}

namespace pg8 {
constexpr int BM = 256, BK = 64, HALF = 128, HTB = HALF * BK * 2, STAGE_BYTES = 8 * HTB, NXCD = 8, WGM = 8;
__host__ __device__ __forceinline__ int lds_byte(int r, int c) { const int st = (r >> 4) * 2 + (c >> 5), rr = r & 15, cc = c & 31, ob = rr * 64 + cc * 2; return st * 1024 + (ob ^ (((ob >> 9) & 1) << 5)); }
__host__ __device__ __forceinline__ void stage_rc(int b, int& R, int& C) { const int st = b / 1024, sb = b % 1024, swz = sb ^ (((sb >> 9) & 1) << 5); R = (st >> 1) * 16 + swz / 64; C = (st & 1) * 32 + (swz % 64) / 2; }
__host__ __device__ __forceinline__ int perm32(int rho) { const int n = rho >> 4, i = rho & 15; return 8 * (i >> 2) + 4 * n + (i & 3); }

struct Unit { const char* A; const char* B; int nt, flags, pm, pn, aux; const int* gidx; };


__device__ __forceinline__ const char* rfl_ptr(const char* p) { const unsigned long long v = (unsigned long long)p; const unsigned lo = __builtin_amdgcn_readfirstlane((unsigned)v), hi = __builtin_amdgcn_readfirstlane((unsigned)(v >> 32)); return (const char*)(((unsigned long long)hi << 32) | lo); }
__device__ __forceinline__ void uniformize(Unit& u) { u.A = rfl_ptr(u.A); u.B = rfl_ptr(u.B); u.nt = __builtin_amdgcn_readfirstlane(u.nt); u.flags = __builtin_amdgcn_readfirstlane(u.flags);
    u.pm = __builtin_amdgcn_readfirstlane(u.pm); u.pn = __builtin_amdgcn_readfirstlane(u.pn); u.aux = __builtin_amdgcn_readfirstlane(u.aux); u.gidx = (const int*)rfl_ptr((const char*)u.gidx); }
struct DenseOrder {
    const bf16_t* A; const bf16_t* Bt; int lda, ldb, K, nM, nN, nwg, G, c, reps = 1;
    __device__ void init(const bf16_t* A_, int lda_, const bf16_t* Bt_, int ldb_, int M, int N, int K_, int G_, int c_) { A = A_; Bt = Bt_; lda = lda_; ldb = ldb_; K = K_; nM = M / BM; nN = N / BM; nwg = nM * nN; G = G_; c = c_; }
    __device__ bool next(int i, Unit& u) const {
        const long L = (long)i * G + c; if (L >= (long)nwg * reps) return false;
        return next_l((int)(L % nwg), u);
    }
    __device__ bool next_l(int wgid, Unit& u) const { { const int q = nwg / NXCD, r = nwg % NXCD, xcd = wgid % NXCD, off = wgid / NXCD; wgid = (xcd < r ? xcd * (q + 1) : r * (q + 1) + (xcd - r) * q) + off; }
        const int nig = WGM * nN, gid = wgid / nig, fm = gid * WGM, gsz = (nM - fm) < WGM ? (nM - fm) : WGM;
        u.pm = fm + ((wgid % nig) % gsz); u.pn = (wgid % nig) / gsz;
        u.A = (const char*)(A + (size_t)u.pm * BM * lda); u.B = (const char*)(Bt + (size_t)u.pn * BM * ldb); u.nt = K / BK; u.flags = 3; u.aux = 0; u.gidx = nullptr;
        return true;
    }
};


struct CtxSliceOrder {
    const bf16_t* A; const bf16_t* Bt; int lda, ldb, nN, ks, G, c, reps;
    __device__ bool next(int i, Unit& u) const { int L = i * G + c; const int n = 2 * nN * ks; if (L >= n * reps) return false; L %= n;
        const int tile = L / ks, sl = L % ks, pmc = tile / nN, pn = tile % nN;
        u.pm = pmc; u.pn = pn; u.A = (const char*)(A + (size_t)pmc * BM * lda + sl * 256); u.B = (const char*)(Bt + (size_t)pn * BM * ldb + sl * 256); u.nt = 4; u.flags = 3; u.aux = sl; u.gidx = nullptr; return true; }
};

struct BlockOrder {
    const bf16_t* A; const bf16_t* Bt; int lda, ldb, K, nM, nNb, nblk, acol, G, c, reps;
    __device__ bool next(int i, Unit& u) const { int L = i * G + c; const int per = nM * nNb, n = per * nblk; if (L >= n * reps) return false; L %= n;
        const int b = L / per, r = L % per, pm = r % nM, pn = r / nM;
        u.pm = pm; u.pn = b * nNb + pn; u.A = (const char*)(A + (size_t)pm * BM * lda + b * acol); u.B = (const char*)(Bt + (size_t)u.pn * BM * ldb); u.nt = K / BK; u.flags = 3; u.aux = 0; u.gidx = nullptr; return true; }
};

struct KnopeOrder { BlockOrder S;
    __device__ bool next(int i, Unit& u) const { if (!S.next(i, u)) return false; u.B = (const char*)(S.Bt + (size_t)(u.pn + 3) * BM * S.ldb); u.pn += 3; return true; } };

struct MoeOrder {
    const char* A; const char* W; const int* slot_tok; size_t wstride; int lda, ldb, K, npn, B0, G, c, reps = 1, ksplit = 1; bool gather;
    int eb[NEXP], en[NEXP], us[NEXP + 1];
    __device__ void init(const unsigned* cnt, int B0_, int B1_) {
        int bs = 0, u = 0; B0 = B0_;
#pragma unroll
        for (int e = 0; e < NEXP; ++e) { const int n = (int)__hip_atomic_load(cnt + 64 * e, __ATOMIC_RELAXED, __HIP_MEMORY_SCOPE_AGENT), nb = (n + 255) >> 8;
            const int lo = bs > B0_ ? bs : B0_, hi = (bs + nb) < B1_ ? (bs + nb) : B1_; eb[e] = lo; en[e] = hi > lo ? hi - lo : 0; us[e] = u; u += en[e] * npn * ksplit; bs += nb; }
        us[NEXP] = u;
    }
    __device__ bool next(int i, Unit& u) const {
        int L = i * G + c; if (L >= us[NEXP] * reps) return false; L %= us[NEXP];
        int e = 0, base = 0, nb = 1, fb = 0;
#pragma unroll
        for (int j = 0; j < NEXP; ++j) if (L >= us[j] && en[j] > 0) { e = j; base = us[j]; nb = en[j]; fb = eb[j]; }
        const int l0 = L - base, kh = l0 % ksplit, l = l0 / ksplit, pn = l / nb, blk = fb + l % nb, kq = K / ksplit;
        u.A = (gather ? A : A + (size_t)(blk - B0) * BM * lda * 2) + (size_t)kh * kq * 2; u.B = W + (size_t)e * wstride + (size_t)pn * BM * ldb * 2 + (size_t)kh * kq * 2; u.nt = kq / BK; u.flags = 3;
        u.pm = gather ? (blk - B0) : blk; u.pn = pn; u.aux = kh; u.gidx = slot_tok + blk * BM;
        return true;
    }
};

template <class Epi, class Sched, bool ALIGN_EPI, bool GATHER>
__device__ __forceinline__ void gemm_phase(LAS unsigned char* lds, const int lda, const int ldb, const Sched& S, const Epi& E) {
    const int tid = threadIdx.x, wid = __builtin_amdgcn_readfirstlane(tid >> 6), lane = tid & 63, wr = wid >> 2, wc = wid & 3, fr = lane & 15, fq = lane >> 4;
    unsigned voffA[2], voffB[2]; int gR[2], gC[2];
#pragma unroll
    for (int i = 0; i < 2; ++i) { int R, C; stage_rc(tid * 16 + i * 8192, R, C); const int Rb = Epi::PERM ? ((R & ~31) + perm32(R & 31)) : R;
        voffA[i] = (unsigned)(R * lda + C) * 2u; voffB[i] = (unsigned)(Rb * ldb + C) * 2u; gR[i] = R; gC[i] = C; }
    const size_t kstep = (size_t)(BK * 2);
    const size_t hstepA = GATHER ? 0 : (size_t)HALF * lda * 2, hstepB = (size_t)HALF * ldb * 2;
    const unsigned ldsw = (unsigned)wid * 1024u;
    const int aoff = lds_byte(wr * 64 + fr, fq * 8), boff = lds_byte(wc * 32 + fr, fq * 8);
#define PG8_SA(b, h) (((b) * 2 + (h)) * HTB)
#define PG8_SB(b, h) ((4 + (b) * 2 + (h)) * HTB)
#define PG8_STG(bufoff, gbase, v0, v1) do { \
        __builtin_amdgcn_global_load_lds((const unsigned*)((const char*)(gbase) + (v0)), (LAS unsigned*)(lds + (bufoff) + ldsw), 16, 0, 0); \
        __builtin_amdgcn_global_load_lds((const unsigned*)((const char*)(gbase) + (v1)), (LAS unsigned*)(lds + (bufoff) + ldsw + 8192), 16, 0, 0); } while (0)
#define PG8_STAGE_B(bufoff, gbase) PG8_STG(bufoff, gbase, voffB[0], voffB[1])
#define PG8_LDA(dst, b, h) do { _Pragma("unroll") for (int m = 0; m < 4; ++m) _Pragma("unroll") for (int k = 0; k < 2; ++k) dst[m][k] = *(const LAS bf16x8*)(lds + PG8_SA(b, h) + aoff + m * 2048 + k * 1024); } while (0)
#define PG8_LDB(dst, b, h) do { _Pragma("unroll") for (int n = 0; n < 2; ++n) _Pragma("unroll") for (int k = 0; k < 2; ++k) dst[n][k] = *(const LAS bf16x8*)(lds + PG8_SB(b, h) + boff + n * 2048 + k * 1024); } while (0)
#define PG8_MMA(ai, bj, At, Bt) do { __builtin_amdgcn_s_setprio(1); _Pragma("unroll") for (int m = 0; m < 4; ++m) _Pragma("unroll") for (int n = 0; n < 2; ++n) _Pragma("unroll") for (int k = 0; k < 2; ++k) \
        acc[ai][bj][m][n] = __builtin_amdgcn_mfma_f32_16x16x32_bf16(Bt[n][k], At[m][k], acc[ai][bj][m][n], 0, 0, 0); __builtin_amdgcn_s_setprio(0); } while (0)
#define PG8_WAIT_V(n) asm volatile("s_waitcnt vmcnt(" #n ")" ::: "memory")
#define PG8_WAIT_L(n) asm volatile("s_waitcnt lgkmcnt(" #n ")" ::: "memory")
#define PG8_BAR __builtin_amdgcn_s_barrier()
#define PG8_SCHED __builtin_amdgcn_sched_barrier(0)
    Unit cur, nxt; int ui = 0;
    if (!S.next(0, cur)) return;
    uniformize(cur);
    f32x4 acc[2][2][4][2];
#pragma unroll
    for (int a = 0; a < 2; ++a)
#pragma unroll
        for (int b = 0; b < 2; ++b)
#pragma unroll
            for (int m = 0; m < 4; ++m)
#pragma unroll
                for (int n = 0; n < 2; ++n) acc[a][b][m][n] = (f32x4){0.f, 0.f, 0.f, 0.f};
    bf16x8 At[4][2], B0[2][2], B1[2][2];
    unsigned cvA[4], nvA[4];
    if constexpr (GATHER) {
#pragma unroll
        for (int i = 0; i < 2; ++i) { cvA[i] = (unsigned)((size_t)cur.gidx[gR[i]] * lda + gC[i]) * 2u; cvA[2 + i] = (unsigned)((size_t)cur.gidx[HALF + gR[i]] * lda + gC[i]) * 2u; }
    } else { cvA[0] = voffA[0]; cvA[1] = voffA[1]; cvA[2] = voffA[0]; cvA[3] = voffA[1]; }
#pragma unroll
    for (int i = 0; i < 4; ++i) nvA[i] = cvA[i];
    const char* cA = cur.A; const char* cB = cur.B;
    PG8_STAGE_B(PG8_SB(0, 0), cB); PG8_STAGE_B(PG8_SB(0, 1), cB + hstepB); PG8_STG(PG8_SA(0, 0), cA, cvA[0], cvA[1]); PG8_STG(PG8_SA(0, 1), cA + hstepA, cvA[2], cvA[3]);
    if (wr == 1) PG8_BAR;
    PG8_WAIT_V(2); PG8_BAR;
    PG8_STAGE_B(PG8_SB(1, 0), cB + kstep); PG8_STG(PG8_SA(1, 0), cA + kstep, cvA[0], cvA[1]); PG8_STAGE_B(PG8_SB(1, 1), cB + hstepB + kstep);
    PG8_WAIT_V(6); PG8_BAR;
    for (;;) {
        const bool has_next = S.next(ui + 1, nxt);
        if (has_next) uniformize(nxt);
        const char* nA = has_next ? nxt.A : cA; const char* nB = has_next ? nxt.B : cB;
        if constexpr (GATHER) {
            if (has_next) {
#pragma unroll
                for (int i = 0; i < 2; ++i) { nvA[i] = (unsigned)((size_t)nxt.gidx[gR[i]] * lda + gC[i]) * 2u; nvA[2 + i] = (unsigned)((size_t)nxt.gidx[HALF + gR[i]] * lda + gC[i]) * 2u; }
            }
        }
        const int nt = cur.nt;
        for (int t = 0; t < nt; t += 2) {
            const bool last = (t == nt - 2);
            const char* a1 = cA + (size_t)(t + 1) * kstep;
            const char* a2 = last ? nA : cA + (size_t)(t + 2) * kstep; const char* b2 = last ? nB : cB + (size_t)(t + 2) * kstep;
            const char* a3 = a2 + kstep; const char* b3 = b2 + kstep;
            unsigned w0, w1, w2, w3;
            if constexpr (GATHER) { w0 = last ? nvA[0] : cvA[0]; w1 = last ? nvA[1] : cvA[1]; w2 = last ? nvA[2] : cvA[2]; w3 = last ? nvA[3] : cvA[3]; }
            else { w0 = cvA[0]; w1 = cvA[1]; w2 = cvA[2]; w3 = cvA[3]; }
            PG8_LDB(B0, 0, 0); PG8_LDB(B1, 0, 1); PG8_SCHED; PG8_LDA(At, 0, 0); PG8_STG(PG8_SA(1, 1), a1 + hstepA, cvA[2], cvA[3]);
            PG8_WAIT_V(8); PG8_WAIT_L(0); PG8_BAR; PG8_MMA(0, 0, At, B0); PG8_MMA(0, 1, At, B1); PG8_BAR; PG8_SCHED;
            PG8_LDA(At, 0, 1); PG8_STAGE_B(PG8_SB(0, 0), b2); PG8_STAGE_B(PG8_SB(0, 1), b2 + hstepB); PG8_STG(PG8_SA(0, 0), a2, w0, w1);
            PG8_WAIT_V(8); PG8_WAIT_L(0); PG8_BAR; PG8_MMA(1, 0, At, B0); PG8_MMA(1, 1, At, B1); PG8_BAR; PG8_SCHED;
            PG8_LDB(B0, 1, 0); PG8_LDB(B1, 1, 1); PG8_SCHED; PG8_LDA(At, 1, 0); PG8_STG(PG8_SA(0, 1), a2 + hstepA, w2, w3);
            PG8_WAIT_V(8); PG8_WAIT_L(0); PG8_BAR; PG8_MMA(0, 0, At, B0); PG8_MMA(0, 1, At, B1); PG8_BAR; PG8_SCHED;
            PG8_LDA(At, 1, 1); PG8_STAGE_B(PG8_SB(1, 0), b3); PG8_STAGE_B(PG8_SB(1, 1), b3 + hstepB); PG8_STG(PG8_SA(1, 0), a3, w0, w1);
            PG8_WAIT_V(8); PG8_WAIT_L(0); PG8_BAR; PG8_MMA(1, 0, At, B0); PG8_MMA(1, 1, At, B1); PG8_BAR; PG8_SCHED;
        }
        if constexpr (ALIGN_EPI) { if (wr == 0) PG8_BAR; }
        if (cur.flags & 2) E(acc, cur, wr, wc, fr, fq);
        if (!has_next) break;
        if (nxt.flags & 1) {
#pragma unroll
            for (int a = 0; a < 2; ++a)
#pragma unroll
                for (int b = 0; b < 2; ++b)
#pragma unroll
                    for (int m = 0; m < 4; ++m)
#pragma unroll
                        for (int n = 0; n < 2; ++n) acc[a][b][m][n] = (f32x4){0.f, 0.f, 0.f, 0.f};
        }
        cur = nxt; cA = nA; cB = nB; ++ui;
#pragma unroll
        for (int i = 0; i < 4; ++i) cvA[i] = nvA[i];
        if constexpr (ALIGN_EPI) { if (wr == 1) PG8_BAR; }
    }
    PG8_WAIT_V(0);
    if constexpr (!ALIGN_EPI) { if (wr == 0) PG8_BAR; }
    PG8_BAR;
#undef PG8_SA
#undef PG8_SB
#undef PG8_STG
#undef PG8_STAGE_B
#undef PG8_LDA
#undef PG8_LDB
#undef PG8_MMA
#undef PG8_WAIT_V
#undef PG8_WAIT_L
#undef PG8_BAR
#undef PG8_SCHED
}

typedef f32x4 Acc[2][2][4][2];
__device__ __forceinline__ u32x4 widen16(u32x2 a, u32x2 b) {
    const auto r0 = __builtin_amdgcn_permlane16_swap(a.x, b.x, false, false), r1 = __builtin_amdgcn_permlane16_swap(a.y, b.y, false, false);
    u32x4 w; w.x = r0[0]; w.y = r1[0]; w.z = r0[1]; w.w = r1[1]; return w; }

struct EpiResGate {
    static constexpr bool PERM = false;
    float* out; const float* res; const float* gate3;
    int ld; int row_cls_base;
    __device__ __forceinline__ void operator()(const Acc& acc, const Unit& u, int wr, int wc, int fr, int fq) const {
        const int row0 = u.pm * BM + wr * 64 + fr, col0 = u.pn * BM + wc * 32 + 4 * fq;
        const float* g = gate3 + (size_t)row_class(u.pm * BM + row_cls_base) * 6144;
        f32x4 gv[2][2];
#pragma unroll
        for (int bj = 0; bj < 2; ++bj)
#pragma unroll
            for (int n = 0; n < 2; ++n) gv[bj][n] = *(const f32x4*)(g + col0 + bj * HALF + n * 16);
#pragma unroll
        for (int ai = 0; ai < 2; ++ai)
#pragma unroll
            for (int m = 0; m < 4; ++m) { const size_t ro = (size_t)(row0 + ai * HALF + m * 16) * ld + col0;
#pragma unroll
                for (int bj = 0; bj < 2; ++bj)
#pragma unroll
                    for (int n = 0; n < 2; ++n) { const f32x4 r = *(const f32x4*)(res + ro + bj * HALF + n * 16);
                        *(f32x4*)(out + ro + bj * HALF + n * 16) = r * ALPHA + gv[bj][n] * acc[ai][bj][m][n]; } }
    }
};
template <bool RB>
struct EpiResGateB {
    static constexpr bool PERM = false;
    bf16_t* out; const void* res; const float* gate3; int ld; int row_cls_base;
    __device__ __forceinline__ void operator()(const Acc& acc, const Unit& u, int wr, int wc, int fr, int fq) const {
        const int row0 = u.pm * BM + wr * 64 + fr, col0 = u.pn * BM + wc * 32 + 4 * fq, colw = u.pn * BM + wc * 32 + (fq & 1) * 16 + (fq >> 1) * 8;
        const float* g = gate3 + (size_t)row_class(u.pm * BM + row_cls_base) * 6144;
        f32x4 gv[2][2];
#pragma unroll
        for (int bj = 0; bj < 2; ++bj)
#pragma unroll
            for (int n = 0; n < 2; ++n) gv[bj][n] = *(const f32x4*)(g + col0 + bj * HALF + n * 16);
#pragma unroll
        for (int ai = 0; ai < 2; ++ai)
#pragma unroll
            for (int m = 0; m < 4; ++m) { const size_t rb = (size_t)(row0 + ai * HALF + m * 16) * ld;
#pragma unroll
                for (int bj = 0; bj < 2; ++bj) { f32x4 r0, r1;
                    if constexpr (RB) { const u32x2 a = *(const u32x2*)((const bf16_t*)res + rb + col0 + bj * HALF), b = *(const u32x2*)((const bf16_t*)res + rb + col0 + bj * HALF + 16);
                        r0 = (f32x4){bflo(a.x), bfhi(a.x), bflo(a.y), bfhi(a.y)}; r1 = (f32x4){bflo(b.x), bfhi(b.x), bflo(b.y), bfhi(b.y)}; }
                    else { r0 = *(const f32x4*)((const float*)res + rb + col0 + bj * HALF); r1 = *(const f32x4*)((const float*)res + rb + col0 + bj * HALF + 16); }
                    const f32x4 v0 = r0 * ALPHA + gv[bj][0] * acc[ai][bj][m][0], v1 = r1 * ALPHA + gv[bj][1] * acc[ai][bj][m][1];
                    u32x2 w0, w1; w0.x = cvt_pk_bf16(v0[0], v0[1]); w0.y = cvt_pk_bf16(v0[2], v0[3]); w1.x = cvt_pk_bf16(v1[0], v1[1]); w1.y = cvt_pk_bf16(v1[2], v1[3]);
                    *(u32x4*)(out + rb + colw + bj * HALF) = widen16(w0, w1); } }
    }
};
struct EpiCtxPart {
    static constexpr bool PERM = false;
    float* part; const float* gate;
    __device__ __forceinline__ void operator()(const Acc& acc, const Unit& u, int wr, int wc, int fr, int fq) const {
        const int row0 = u.pm * BM + wr * 64 + fr, col0 = u.pn * BM + wc * 32 + 4 * fq;
        float* ob = part + ((size_t)u.aux * NCTX + row0) * 1024 + col0;
        f32x4 gv[2][2];
#pragma unroll
        for (int bj = 0; bj < 2; ++bj)
#pragma unroll
            for (int n = 0; n < 2; ++n) gv[bj][n] = *(const f32x4*)(gate + col0 + bj * HALF + n * 16);
#pragma unroll
        for (int ai = 0; ai < 2; ++ai)
#pragma unroll
            for (int m = 0; m < 4; ++m)
#pragma unroll
                for (int bj = 0; bj < 2; ++bj)
#pragma unroll
                    for (int n = 0; n < 2; ++n) *(f32x4*)(ob + (size_t)(ai * HALF + m * 16) * 1024 + bj * HALF + n * 16) = gv[bj][n] * acc[ai][bj][m][n];
    }
};
struct EpiSwiGLU {
    static constexpr bool PERM = true;
    bf16_t* H; int ldh;
    __device__ __forceinline__ void operator()(const Acc& acc, const Unit& u, int wr, int wc, int fr, int fq) const {
        const int row0 = u.pm * BM + wr * 64 + fr, col0 = u.pn * HALF + wc * 32 + 8 * fq;
#pragma unroll
        for (int ai = 0; ai < 2; ++ai)
#pragma unroll
            for (int m = 0; m < 4; ++m) { bf16_t* rowp = H + (size_t)(row0 + ai * HALF + m * 16) * ldh + col0;
                float v[8];
#pragma unroll
                for (int n = 0; n < 2; ++n)
#pragma unroll
                    for (int j = 0; j < 4; ++j) { const float g = acc[ai][0][m][n][j], up = acc[ai][1][m][n][j]; v[4 * n + j] = silu_f(g) * up; }
                u32x4 w; w.x = cvt_pk_bf16(v[0], v[1]); w.y = cvt_pk_bf16(v[2], v[3]); w.z = cvt_pk_bf16(v[4], v[5]); w.w = cvt_pk_bf16(v[6], v[7]);
                *(u32x4*)rowp = w; }
    }
};

struct EpiBf16 {
    static constexpr bool PERM = true;
    bf16_t* O; int ldc;
    __device__ __forceinline__ void operator()(const Acc& acc, const Unit& u, int wr, int wc, int fr, int fq) const {
        const int row0 = u.pm * BM + wr * 64 + fr, col0 = u.pn * BM + wc * 32 + 8 * fq;
#pragma unroll
        for (int ai = 0; ai < 2; ++ai)
#pragma unroll
            for (int m = 0; m < 4; ++m) { bf16_t* rowp = O + (size_t)(row0 + ai * HALF + m * 16) * ldc + col0;
#pragma unroll
                for (int bj = 0; bj < 2; ++bj) { const f32x4 v0 = acc[ai][bj][m][0], v1 = acc[ai][bj][m][1];
                    u32x4 w; w.x = cvt_pk_bf16(v0[0], v0[1]); w.y = cvt_pk_bf16(v0[2], v0[3]); w.z = cvt_pk_bf16(v1[0], v1[1]); w.w = cvt_pk_bf16(v1[2], v1[3]);
                    *(u32x4*)(rowp + bj * HALF) = w; } }
    }
};
struct EpiBf16Sel {
    static constexpr bool PERM = true;
    bf16_t* O; int ldc; long stride;
    __device__ __forceinline__ void operator()(const Acc& acc, const Unit& u, int wr, int wc, int fr, int fq) const {
        const int row0 = u.pm * BM + wr * 64 + fr, col0 = u.pn * BM + wc * 32 + 8 * fq; bf16_t* Ob = O + (long)u.aux * stride;
#pragma unroll
        for (int ai = 0; ai < 2; ++ai)
#pragma unroll
            for (int m = 0; m < 4; ++m) { bf16_t* rowp = Ob + (size_t)(row0 + ai * HALF + m * 16) * ldc + col0;
#pragma unroll
                for (int bj = 0; bj < 2; ++bj) { const f32x4 v0 = acc[ai][bj][m][0], v1 = acc[ai][bj][m][1];
                    u32x4 w; w.x = cvt_pk_bf16(v0[0], v0[1]); w.y = cvt_pk_bf16(v0[2], v0[3]); w.z = cvt_pk_bf16(v1[0], v1[1]); w.w = cvt_pk_bf16(v1[2], v1[3]);
                    *(u32x4*)(rowp + bj * HALF) = w; } }
    }
};
struct EpiLora {
    static constexpr bool PERM = true;
    float* ld; bf16_t* lr; const float* bias4;
    __device__ __forceinline__ void operator()(const Acc& acc, const Unit& u, int wr, int wc, int fr_in, int fq_in) const {
        int fr = fr_in, fq = fq_in; asm volatile("" : "+v"(fr), "+v"(fq));
        const int blk = u.pn >> 1, row0 = u.pm * BM + wr * 64 + fr, colb = (u.pn & 1) * BM + wc * 32 + 8 * fq;
        const float* bias = bias4 + (blk < 4 ? blk : 0) * 512;
        f32x4 bv[2][2];
#pragma unroll
        for (int bj = 0; bj < 2; ++bj)
#pragma unroll
            for (int n = 0; n < 2; ++n) bv[bj][n] = blk < 4 ? *(const f32x4*)(bias + colb + bj * HALF + 4 * n) : (f32x4){0.f, 0.f, 0.f, 0.f};
#pragma unroll
        for (int ai = 0; ai < 2; ++ai)
#pragma unroll
            for (int m = 0; m < 4; ++m) { const size_t ro = (size_t)(row0 + ai * HALF + m * 16) * 512 + colb;
#pragma unroll
                for (int bj = 0; bj < 2; ++bj) { f32x4 v0 = acc[ai][bj][m][0] + bv[bj][0], v1 = acc[ai][bj][m][1] + bv[bj][1];
                    if (blk < 4) {
#pragma unroll
                        for (int j = 0; j < 4; ++j) { v0[j] = sigmoid_f(v0[j]); v1[j] = sigmoid_f(v1[j]); } }
                    if (blk < 2) { float* o = ld + (size_t)blk * MR * 512 + ro + bj * HALF; *(f32x4*)o = v0 * -0.6065306597126334f; *(f32x4*)(o + 4) = v1 * -0.6065306597126334f; }
                    else { bf16_t* o = lr + (size_t)(blk - 2) * MR * 512 + ro + bj * HALF;
                        u32x4 w; w.x = cvt_pk_bf16(v0[0], v0[1]); w.y = cvt_pk_bf16(v0[2], v0[3]); w.z = cvt_pk_bf16(v1[0], v1[1]); w.w = cvt_pk_bf16(v1[2], v1[3]); *(u32x4*)o = w; } } }
    }
};
struct EpiMlaQK {
    static constexpr bool PERM = false;
    bf16_t* Q; bf16_t* KB; const f32x2* rope; float qscale;
    __device__ __forceinline__ void operator()(const Acc& acc, const Unit& u, int wr, int wc, int fr_in, int fq_in) const {
        int fr = fr_in, fq = fq_in; asm volatile("" : "+v"(fr), "+v"(fq));
        const int row0 = u.pm * BM + wr * 64 + fr;
#pragma unroll
        for (int bj = 0; bj < 2; ++bj) {
            const int cg = u.pn * BM + bj * HALF + wc * 32;
            if (cg < 768) {
                const bool is_rope = ((cg >> 5) % 3) == 2;
#pragma unroll
                for (int ai = 0; ai < 2; ++ai)
#pragma unroll
                    for (int m = 0; m < 4; ++m) { const int row = row0 + ai * HALF + m * 16;
                        f32x4 v0 = acc[ai][bj][m][0] * qscale, v1 = acc[ai][bj][m][1] * qscale;
                        if (is_rope && row < NLAT) { const int t = row & (SEQ - 1), prow = t >> 6, pcol = t & 63;
#pragma unroll
                            for (int j = 0; j < 4; ++j) { const int p = 4 * fq + j, f = p >> 3, i = p & 7; const f32x2 cs = rope[(f ? pcol : prow) * 8 + i];
                                const float t1 = v0[j], t2 = v1[j]; v0[j] = t1 * cs.x - t2 * cs.y; v1[j] = t1 * cs.y + t2 * cs.x; } }
                        bf16_t* o = Q + (size_t)row * 768 + cg + (fq & 1) * 16 + (fq >> 1) * 8;
                        u32x2 w0; w0.x = cvt_pk_bf16(v0[0], v0[1]); w0.y = cvt_pk_bf16(v0[2], v0[3]);
                        u32x2 w1; w1.x = cvt_pk_bf16(v1[0], v1[1]); w1.y = cvt_pk_bf16(v1[2], v1[3]); *(u32x4*)o = widen16(w0, w1); }
            } else {
                const int c = cg - 768, head = c >> 6, d0 = (c & 63) + (fq & 1) * 16 + (fq >> 1) * 8;
#pragma unroll
                for (int ai = 0; ai < 2; ++ai)
#pragma unroll
                    for (int m = 0; m < 4; ++m) { const int row = row0 + ai * HALF + m * 16;
                        const int b = row < NLAT ? (row >> 13) : ((row - NLAT) >> 8), sk = row < NLAT ? CTX + (row & (SEQ - 1)) : ((row - NLAT) & (CTX - 1));
                        bf16_t* o = KB + ((size_t)(b * SKEYS + sk) * 8 + head) * 96 + d0;
                        const f32x4 v0 = acc[ai][bj][m][0], v1 = acc[ai][bj][m][1];
                        u32x2 w0; w0.x = cvt_pk_bf16(v0[0], v0[1]); w0.y = cvt_pk_bf16(v0[2], v0[3]);
                        u32x2 w1; w1.x = cvt_pk_bf16(v1[0], v1[1]); w1.y = cvt_pk_bf16(v1[2], v1[3]); *(u32x4*)o = widen16(w0, w1); }
            }
        }
    }
};
struct EpiVT {
    static constexpr bool PERM = true;
    bf16_t* VT;
    __device__ __forceinline__ void operator()(const Acc& acc, const Unit& u, int wr, int wc, int fr, int fq) const {
        const int m0 = u.pn * BM;
        const int b = m0 < NLAT ? (m0 >> 13) : ((m0 - NLAT) >> 8), s0 = m0 < NLAT ? CTX + (m0 & (SEQ - 1)) : 0;
        const int row0 = u.pm * BM + wr * 64 + fr, col0 = wc * 32 + 8 * fq;
#pragma unroll
        for (int ai = 0; ai < 2; ++ai)
#pragma unroll
            for (int m = 0; m < 4; ++m) { bf16_t* rowp = VT + ((size_t)b * 512 + row0 + ai * HALF + m * 16) * SKEYS + s0 + col0;
#pragma unroll
                for (int bj = 0; bj < 2; ++bj) { const f32x4 v0 = acc[ai][bj][m][0], v1 = acc[ai][bj][m][1];
                    u32x4 w; w.x = cvt_pk_bf16(v0[0], v0[1]); w.y = cvt_pk_bf16(v0[2], v0[3]); w.z = cvt_pk_bf16(v1[0], v1[1]); w.w = cvt_pk_bf16(v1[2], v1[3]);
                    *(u32x4*)(rowp + bj * HALF) = w; } }
    }
};

struct ScoreOrder {
    const bf16_t* Q; const bf16_t* Kk; int G, c, reps;
    __device__ bool next(int i, Unit& u) const { int L = i * G + c; if (L >= 256 * reps) return false; L &= 255; const int bh = L >> 5, ch = L & 31, b = bh >> 2, h = bh & 3;
        const size_t off = ((size_t)(b * SEQ + ch * 256) * 1024 + h * 256); u.A = (const char*)(Q + off); u.B = (const char*)(Kk + off); u.nt = 4; u.flags = 3; u.pm = L; u.pn = 0; u.aux = h; u.gidx = nullptr; return true; }
};
struct StateOrder {
    const bf16_t* VT; const bf16_t* KDT; int G, c, reps;
    __device__ bool next(int i, Unit& u) const { int L = i * G + c; if (L >= 2 * 8 * (RCH - 1) * 2 * reps) return false; L %= 2 * 8 * (RCH - 1) * 2;
        const int half = L & 1, p = L >> 1, bh_ = p >> 6, k = p & 63;
        const int slot = k < 2 ? 0 : (k == 2 ? 1 : (k == 63 ? RCH - 1 : 2 + ((k - 3) >> 1))), dir = k < 2 ? k : (k == 2 ? 0 : (k == 63 ? 1 : ((k - 3) & 1))), bhs = bh_ * RCH + slot;
        u.A = (const char*)(VT + ((size_t)bhs * 512 + half * 256) * 256); u.B = (const char*)(KDT + ((size_t)dir * 8 * RCH + bhs) * 65536); u.nt = 4; u.flags = 3; u.pm = (dir * 8 * RCH + bhs) * 2 + half; u.pn = 0; u.aux = 0; u.gidx = nullptr; return true; }
};
struct OutOrder {
    const bf16_t* P; const bf16_t* Q; const bf16_t* VT; const bf16_t* ST; int G, c, reps;
    __device__ bool next(int i, Unit& u) const { int tile = (i >> 1) * G + c; const int seg = i & 1; if (tile >= 1024 * reps) return false; tile &= 1023;
        const int half = tile & 1, dir = (tile >> 1) & 1, h = (tile >> 2) & 3, ch = (tile >> 4) & 31, b = tile >> 9, bh = b * 4 + h;
        const size_t aoff = (size_t)(b * SEQ + ch * 256) * 1024 + h * 256;
        if (seg == 0) { u.A = (const char*)(P + (size_t)dir * NLAT * 1024 + aoff); u.B = (const char*)(VT + ((size_t)(bh * RCH + ch + 1) * 512 + half * 256) * 256); u.flags = 1; }
        else { const int slot = dir ? ch + 1 : ch; u.A = (const char*)(Q + aoff); u.B = (const char*)(ST + (((size_t)dir * 8 * RCH + bh * RCH + slot) * 512 + half * 256) * 256); u.flags = 2; }
        u.nt = 4; u.pm = tile; u.pn = 0; u.aux = 0; u.gidx = nullptr; return true; }
};
__device__ __forceinline__ float lg2gamma(const float* dec, int h) { return __log2f(1.f - __builtin_amdgcn_exp2f(-dec[h])); }

struct EpiQK1 {
    static constexpr bool PERM = false;
    bf16_t* Q; bf16_t* Kk; const f32x2* rope;
    __device__ __forceinline__ void operator()(const Acc& acc, const Unit& u, int wr, int wc, int fr_in, int fq_in) const {
        int fr = fr_in, fq = fq_in; asm volatile("" : "+v"(fr), "+v"(fq));
        const int row0 = u.pm * BM + wr * 64 + fr;
#pragma unroll
        for (int bj = 0; bj < 2; ++bj) { const int cg = u.pn * BM + bj * HALF + wc * 32, isk = cg >> 10, cq = cg & 1023, f = (cq >> 7) & 1, i0 = ((cq & 127) >> 5) * 16 + 4 * fq;
            bf16_t* dst = (isk ? Kk : Q) + cq + (fq & 1) * 16 + (fq >> 1) * 8; const float sc = isk ? 0.0625f : 1.f;
#pragma unroll
            for (int ai = 0; ai < 2; ++ai)
#pragma unroll
                for (int m = 0; m < 4; ++m) { const int row = row0 + ai * HALF + m * 16, t = row & (SEQ - 1), pos = f ? (t & 63) : (t >> 6);
                    f32x4 v0 = acc[ai][bj][m][0], v1 = acc[ai][bj][m][1];
#pragma unroll
                    for (int j = 0; j < 4; ++j) { const f32x2 cs = rope[pos * 64 + i0 + j]; const float t1 = v0[j], t2 = v1[j]; v0[j] = (t1 * cs.x - t2 * cs.y) * sc; v1[j] = (t1 * cs.y + t2 * cs.x) * sc; }
                    bf16_t* o = dst + (size_t)row * 1024;
                    u32x2 w0; w0.x = cvt_pk_bf16(v0[0], v0[1]); w0.y = cvt_pk_bf16(v0[2], v0[3]);
                    u32x2 w1; w1.x = cvt_pk_bf16(v1[0], v1[1]); w1.y = cvt_pk_bf16(v1[2], v1[3]); *(u32x4*)o = widen16(w0, w1); __builtin_amdgcn_sched_barrier(0); } }
    }
};
struct EpiKVT {
    static constexpr bool PERM = true;
    bf16_t* KDT; bf16_t* VT; const f32x2* rope; const float* decf; const float* decb;
    __device__ __forceinline__ void operator()(const Acc& acc, const Unit& u, int wr, int wc, int fr_in, int fq_in) const {
        int fr = fr_in, fq = fq_in; asm volatile("" : "+v"(fr), "+v"(fq));
        const int m0 = u.pn * BM; const bool lat = m0 < NLAT;
        const int b = lat ? (m0 >> 13) : ((m0 - NLAT) >> 8), slot = lat ? 1 + ((m0 & (SEQ - 1)) >> 8) : 0, t0 = m0 & (SEQ - 1);
        const int rbase = u.pm * BM + wr * 64;
#pragma unroll
        for (int ai = 0; ai < 2; ++ai) { const int rg = rbase + ai * HALF;
            if (rg < 1024) {
                const int h = rg >> 8, lgsel = h; const float lgf = lg2gamma(decf, lgsel), lgb = lg2gamma(decb, lgsel);
                float dfv[2][8], dbv[2][8];
#pragma unroll
                for (int bj = 0; bj < 2; ++bj)
#pragma unroll
                    for (int q = 0; q < 8; ++q) { const int jt = bj * HALF + wc * 32 + 8 * fq + q; dfv[bj][q] = __builtin_amdgcn_exp2f((float)(255 - jt) * lgf); dbv[bj][q] = __builtin_amdgcn_exp2f((float)jt * lgb); }
#pragma unroll
                for (int mp = 0; mp < 2; ++mp) { const int dk = (rg & 255) + 32 * mp + fr, fi = ((dk & 127) >> 5) * 16 + fr;
                    bf16_t* o1 = KDT + (((size_t)(b * 4 + h) * RCH + slot) * 256 + dk) * 256; bf16_t* o2 = o1 + 16 * 256;
                    f32x2 csq[8];
                    if (lat) {
                        if (ai == 0) { csq[0] = rope[((t0 >> 6) + (wc >> 1)) * 64 + fi]; csq[1] = rope[((t0 >> 6) + 2 + (wc >> 1)) * 64 + fi]; }
                        else {
#pragma unroll
                            for (int q = 0; q < 8; ++q) csq[q] = rope[((wc * 32 + 8 * fq + q) & 63) * 64 + fi]; } }
#pragma unroll
                    for (int bj = 0; bj < 2; ++bj) { const int jt0 = bj * HALF + wc * 32 + 8 * fq; float a1[8], a2[8], df[8], db[8];
#pragma unroll
                        for (int n = 0; n < 2; ++n)
#pragma unroll
                            for (int j = 0; j < 4; ++j) { float t1 = acc[ai][bj][2 * mp][n][j], t2 = acc[ai][bj][2 * mp + 1][n][j]; const int q = 4 * n + j;
                                if (lat) { const f32x2 cs = ai == 0 ? csq[bj] : csq[q]; const float x1 = t1 * cs.x - t2 * cs.y, x2 = t1 * cs.y + t2 * cs.x; t1 = x1; t2 = x2; }
                                a1[q] = t1 * 0.0625f; a2[q] = t2 * 0.0625f; df[q] = dfv[bj][q]; db[q] = dbv[bj][q]; }
                        u32x4 w;
                        w.x = cvt_pk_bf16(a1[0] * df[0], a1[1] * df[1]); w.y = cvt_pk_bf16(a1[2] * df[2], a1[3] * df[3]); w.z = cvt_pk_bf16(a1[4] * df[4], a1[5] * df[5]); w.w = cvt_pk_bf16(a1[6] * df[6], a1[7] * df[7]); *(u32x4*)(o1 + jt0) = w;
                        w.x = cvt_pk_bf16(a2[0] * df[0], a2[1] * df[1]); w.y = cvt_pk_bf16(a2[2] * df[2], a2[3] * df[3]); w.z = cvt_pk_bf16(a2[4] * df[4], a2[5] * df[5]); w.w = cvt_pk_bf16(a2[6] * df[6], a2[7] * df[7]); *(u32x4*)(o2 + jt0) = w;
                        w.x = cvt_pk_bf16(a1[0] * db[0], a1[1] * db[1]); w.y = cvt_pk_bf16(a1[2] * db[2], a1[3] * db[3]); w.z = cvt_pk_bf16(a1[4] * db[4], a1[5] * db[5]); w.w = cvt_pk_bf16(a1[6] * db[6], a1[7] * db[7]); *(u32x4*)(o1 + (size_t)8 * RCH * 65536 + jt0) = w;
                        w.x = cvt_pk_bf16(a2[0] * db[0], a2[1] * db[1]); w.y = cvt_pk_bf16(a2[2] * db[2], a2[3] * db[3]); w.z = cvt_pk_bf16(a2[4] * db[4], a2[5] * db[5]); w.w = cvt_pk_bf16(a2[6] * db[6], a2[7] * db[7]); *(u32x4*)(o2 + (size_t)8 * RCH * 65536 + jt0) = w; __builtin_amdgcn_sched_barrier(0); } }
            } else {
                const int e0 = rg - 1024, h = e0 >> 9;
#pragma unroll
                for (int m = 0; m < 4; ++m) { const int dv = (e0 & 511) + 16 * m + fr; bf16_t* o = VT + (((size_t)(b * 4 + h) * RCH + slot) * 512 + dv) * 256 + wc * 32 + 8 * fq;
#pragma unroll
                    for (int bj = 0; bj < 2; ++bj) { const f32x4 v0 = acc[ai][bj][m][0], v1 = acc[ai][bj][m][1];
                        u32x4 w; w.x = cvt_pk_bf16(v0[0], v0[1]); w.y = cvt_pk_bf16(v0[2], v0[3]); w.z = cvt_pk_bf16(v1[0], v1[1]); w.w = cvt_pk_bf16(v1[2], v1[3]);
                        *(u32x4*)(o + bj * HALF) = w; } }
            }
        }
    }
};
struct EpiScore {
    static constexpr bool PERM = true;
    bf16_t* P; const float* decf; const float* decb;
    __device__ __forceinline__ void operator()(const Acc& acc, const Unit& u, int wr, int wc, int fr_in, int fq_in) const {
        int fr = fr_in, fq = fq_in; asm volatile("" : "+v"(fr), "+v"(fq));
        const int L = u.pm, bh = L >> 5, ch = L & 31, b = bh >> 2, h = bh & 3; const float lgf = lg2gamma(decf, h), lgb = lg2gamma(decb, h);
        bf16_t* base = P + ((size_t)(b * SEQ + ch * 256) * 1024 + h * 256);
        const int jb = wc * 32 + 8 * fq;
        float cf[2][8], cb[2][8];
#pragma unroll
        for (int bj = 0; bj < 2; ++bj)
#pragma unroll
            for (int q = 0; q < 8; ++q) { const int jj = jb + bj * HALF + q; cf[bj][q] = __builtin_amdgcn_exp2f(-(float)(jj + 1) * lgf); cb[bj][q] = __builtin_amdgcn_exp2f(-(float)(256 - jj) * lgb); }
#pragma unroll
        for (int ai = 0; ai < 2; ++ai)
#pragma unroll
            for (int m = 0; m < 4; ++m) { const int i = ai * HALF + wr * 64 + 16 * m + fr; bf16_t* rp = base + (size_t)i * 1024 + jb; bf16_t* rpb = rp + (size_t)NLAT * 1024;
#pragma unroll
                for (int bj = 0; bj < 2; ++bj) { float pf[8], pb[8];
#pragma unroll
                    for (int n = 0; n < 2; ++n)
#pragma unroll
                        for (int j = 0; j < 4; ++j) { const int jj = jb + bj * HALF + 4 * n + j; const float a = acc[ai][bj][m][n][j];
                            pf[4 * n + j] = jj <= i ? a * cf[bj][4 * n + j] : 0.f; pb[4 * n + j] = jj >= i ? a * cb[bj][4 * n + j] : 0.f; }
                    u32x4 w; w.x = cvt_pk_bf16(pf[0], pf[1]); w.y = cvt_pk_bf16(pf[2], pf[3]); w.z = cvt_pk_bf16(pf[4], pf[5]); w.w = cvt_pk_bf16(pf[6], pf[7]); *(u32x4*)(rp + bj * HALF) = w;
                    w.x = cvt_pk_bf16(pb[0], pb[1]); w.y = cvt_pk_bf16(pb[2], pb[3]); w.z = cvt_pk_bf16(pb[4], pb[5]); w.w = cvt_pk_bf16(pb[6], pb[7]); *(u32x4*)(rpb + bj * HALF) = w; }
                __builtin_amdgcn_sched_barrier(0); }
    }
};
struct EpiRetOut {
    static constexpr bool PERM = true;
    bf16_t* OF; bf16_t* OB; const float* decf; const float* decb; float* gns;
    __device__ __forceinline__ void operator()(const Acc& acc, const Unit& u, int wr, int wc, int fr_in, int fq_in) const {
        int fr = fr_in, fq = fq_in; asm volatile("" : "+v"(fr), "+v"(fq));
        const int tile = u.pm, half = tile & 1, dir = (tile >> 1) & 1, h = (tile >> 2) & 3, ch = (tile >> 4) & 31, b = tile >> 9, bh = b * 4 + h;
        const float lg = dir ? lg2gamma(decb, h) : lg2gamma(decf, h);
        bf16_t* base = (dir ? OB : OF) + ((size_t)(b * SEQ + ch * 256) * 2048 + h * 512 + half * 256 + wc * 32 + 8 * fq);
        float* gb = gns + (((size_t)(b * SEQ + ch * 256) * 8 + h * 2 + dir) * 8 + half * 4 + wc) * 2;
#pragma unroll
        for (int ai = 0; ai < 2; ++ai)
#pragma unroll
            for (int m = 0; m < 4; ++m) { const int i = ai * HALF + wr * 64 + 16 * m + fr; const float rs = __builtin_amdgcn_exp2f((float)(dir ? 256 - i : i + 1) * lg); float s1 = 0.f, s2 = 0.f;
#pragma unroll
                for (int bj = 0; bj < 2; ++bj) { const f32x4 v0 = acc[ai][bj][m][0] * rs, v1 = acc[ai][bj][m][1] * rs;
                    s1 += (v0[0] + v0[1]) + (v0[2] + v0[3]) + (v1[0] + v1[1]) + (v1[2] + v1[3]);
                    s2 += (v0[0] * v0[0] + v0[1] * v0[1]) + (v0[2] * v0[2] + v0[3] * v0[3]) + (v1[0] * v1[0] + v1[1] * v1[1]) + (v1[2] * v1[2] + v1[3] * v1[3]);
                    u32x4 w; w.x = cvt_pk_bf16(v0[0], v0[1]); w.y = cvt_pk_bf16(v0[2], v0[3]); w.z = cvt_pk_bf16(v1[0], v1[1]); w.w = cvt_pk_bf16(v1[2], v1[3]);
                    *(u32x4*)(base + (size_t)i * 2048 + bj * HALF) = w; }
                s1 += __shfl_xor(s1, 16); s1 += __shfl_xor(s1, 32); s2 += __shfl_xor(s2, 16); s2 += __shfl_xor(s2, 32);
                if (fq == 0) *(f32x2*)(gb + (size_t)i * 128) = (f32x2){s1, s2}; }
    }
};
struct EpiGate1 {
    static constexpr bool PERM = false;
    bf16_t* MIX; const bf16_t* OF; const bf16_t* OB; const f32x2* st;
    __device__ __forceinline__ void operator()(const Acc& acc, const Unit& u, int wr, int wc, int fr_in, int fq_in) const {
        int fr = fr_in, fq = fq_in; asm volatile("" : "+v"(fr), "+v"(fq));
        const int row0 = u.pm * BM + wr * 64 + fr;
#pragma unroll
        for (int bj = 0; bj < 2; ++bj) { const int cgi = (u.pn * BM + bj * HALF + wc * 32) >> 5, j0 = cgi * 16 + 4 * fq, h = j0 >> 9;
#pragma unroll
            for (int ai = 0; ai < 2; ++ai)
#pragma unroll
                for (int mp = 0; mp < 2; ++mp) { u32x2 wm[2];
                    const size_t lo = (size_t)(row0 + ai * HALF + (2 * mp + (fq & 1)) * 16) * 2048 + cgi * 16 + (fq >> 1) * 8;
                    const u32x4 lf = *(const u32x4*)(OF + lo), lb = *(const u32x4*)(OB + lo);
                    const auto f0 = __builtin_amdgcn_permlane16_swap(lf.x, lf.z, false, false), f1 = __builtin_amdgcn_permlane16_swap(lf.y, lf.w, false, false);
                    const auto b0 = __builtin_amdgcn_permlane16_swap(lb.x, lb.z, false, false), b1 = __builtin_amdgcn_permlane16_swap(lb.y, lb.w, false, false);
#pragma unroll
                    for (int e = 0; e < 2; ++e) { const int m = 2 * mp + e, row = row0 + ai * HALF + m * 16; const f32x4 sv = *(const f32x4*)(st + (size_t)row * 8 + h * 2); const f32x2 sf = {sv[0], sv[1]}, sb = {sv[2], sv[3]};
                        const u32x2 of = {f0[e], f1[e]}, ob = {b0[e], b1[e]};
                        const float fo[4] = {bflo(of.x), bfhi(of.x), bflo(of.y), bfhi(of.y)}, bo[4] = {bflo(ob.x), bfhi(ob.x), bflo(ob.y), bfhi(ob.y)}; float r[4];
#pragma unroll
                        for (int j = 0; j < 4; ++j) r[j] = silu_f(acc[ai][bj][m][0][j]) * (fo[j] - sf.x) * sf.y + silu_f(acc[ai][bj][m][1][j]) * (bo[j] - sb.x) * sb.y;
                        wm[e].x = cvt_pk_bf16(r[0], r[1]); wm[e].y = cvt_pk_bf16(r[2], r[3]); }
                    const int srow = row0 + ai * HALF + (2 * mp + (fq & 1)) * 16;
                    *(u32x4*)(MIX + (size_t)srow * 2048 + cgi * 16 + (fq >> 1) * 8) = widen16(wm[0], wm[1]); } }
    }
};
}


namespace attn {
typedef float f32x16 __attribute__((ext_vector_type(16)));
constexpr int KROW = 208, VROW = 144, KBYTES = 64 * KROW, VBYTES = 64 * VROW, BUF = KBYTES + VBYTES;
__device__ __forceinline__ void unit(LAS unsigned char* lds, const bf16_t* QB, const bf16_t* KB, const bf16_t* VT, bf16_t* MIX, int b, int h, int qrow0, int nkeys, int tid) {
    const int wave = __builtin_amdgcn_readfirstlane(tid >> 6), lane = tid & 63, r32 = lane & 31, hh = lane >> 5;
    bf16x8 qf[6];
    { const bf16_t* qp = QB + (size_t)(qrow0 + 32 * wave + r32) * 768 + h * 96 + 8 * hh;
#pragma unroll
      for (int s6 = 0; s6 < 6; ++s6) qf[s6] = *(const bf16x8*)(qp + 16 * s6); }
    f32x16 o0, o1;
#pragma unroll
    for (int i = 0; i < 16; ++i) { o0[i] = 0.f; o1[i] = 0.f; }
    float mrun = 0.f, lrun = 0.f;
    bf16x8 aone, qm;
#pragma unroll
    for (int i = 0; i < 8; ++i) { aone[i] = 0; qm[i] = 0; }
    if (hh == 0) aone[0] = (short)0x3F80;
    const bf16_t* kbase = KB + ((size_t)b * SKEYS * 8 + h) * 96;
    const bf16_t* vbase = VT + ((size_t)(b * 8 + h) * 64) * SKEYS;
    const int kc0 = tid, kc1 = 512 + tid;
    const int kk0 = kc0 / 12, kp0 = kc0 % 12, kk1 = kc1 / 12, kp1 = kc1 % 12, vd = tid >> 3, vp = tid & 7;
    u32x4 ra0, ra1, rav, rb0, rb1, rbv;
    const int ntile = nkeys / 64;
#define ATT_LOAD(t, r0, r1, rv_) do { const int s0 = (t) * 64; r0 = *(const u32x4*)(kbase + (size_t)(s0 + kk0) * 768 + kp0 * 8); \
        if (tid < 256) r1 = *(const u32x4*)(kbase + (size_t)(s0 + kk1) * 768 + kp1 * 8); rv_ = *(const u32x4*)(vbase + (size_t)vd * SKEYS + s0 + vp * 8); } while (0)
#define ATT_STORE(buf, r0, r1, rv_) do { LAS unsigned char* kb_ = lds + (buf) * BUF; *(LAS u32x4*)(kb_ + kk0 * KROW + kp0 * 16) = r0; \
        if (tid < 256) *(LAS u32x4*)(kb_ + kk1 * KROW + kp1 * 16) = r1; *(LAS u32x4*)(kb_ + KBYTES + vd * VROW + vp * 16) = rv_; } while (0)
    const int krow = ((r32 & 0x13) | ((r32 & 4) << 1) | ((r32 & 8) >> 1));
#define ATT_COMPUTE(t) do { \
        LAS unsigned char* kb = lds + ((t) & 1) * BUF; LAS unsigned char* vb = kb + KBYTES; \
        f32x16 s0, s1; \
        _Pragma("unroll") for (int i = 0; i < 16; ++i) { s0[i] = 0.f; s1[i] = 0.f; } \
        _Pragma("unroll") for (int s6 = 0; s6 < 6; ++s6) { \
            const bf16x8 a0 = *(const LAS bf16x8*)(kb + krow * KROW + (16 * s6 + 8 * hh) * 2); \
            const bf16x8 a1 = *(const LAS bf16x8*)(kb + (32 + krow) * KROW + (16 * s6 + 8 * hh) * 2); \
            s0 = __builtin_amdgcn_mfma_f32_32x32x16_bf16(a0, qf[s6], s0, 0, 0, 0); \
            s1 = __builtin_amdgcn_mfma_f32_32x32x16_bf16(a1, qf[s6], s1, 0, 0, 0); } \
        s0 = __builtin_amdgcn_mfma_f32_32x32x16_bf16(aone, qm, s0, 0, 0, 0); s1 = __builtin_amdgcn_mfma_f32_32x32x16_bf16(aone, qm, s1, 0, 0, 0);     \
        float mx = s0[0];                                     \
        _Pragma("unroll") for (int i = 1; i < 16; ++i) mx = fmaxf(mx, s0[i]); \
        _Pragma("unroll") for (int i = 0; i < 16; ++i) mx = fmaxf(mx, s1[i]); \
        mx = fmaxf(mx, __shfl_xor(mx, 32)); \
        if ((t) == 0 || __any(mx > 8.f)) {                    \
            const float mnew = bflo(f2bf(mrun + ((t) == 0 ? mx : fmaxf(mx, 0.f)))), d = mnew - mrun; \
            if ((t) != 0) { const float alpha = __builtin_amdgcn_exp2f(-d); \
                _Pragma("unroll") for (int i = 0; i < 16; ++i) { o0[i] *= alpha; o1[i] *= alpha; } lrun *= alpha; } \
            mrun = mnew; if (hh == 0) qm[0] = (short)f2bf(-mnew); \
            _Pragma("unroll") for (int i = 0; i < 16; ++i) { s0[i] -= d; s1[i] -= d; } } \
        float ps = 0.f; \
        _Pragma("unroll") for (int i = 0; i < 16; ++i) { s0[i] = __builtin_amdgcn_exp2f(s0[i]); s1[i] = __builtin_amdgcn_exp2f(s1[i]); ps += s0[i] + s1[i]; } \
        lrun += ps; \
        bf16x8 pf[4]; \
        _Pragma("unroll") for (int g = 0; g < 2; ++g) { u32x4 w0, w1; \
            w0.x = cvt_pk_bf16(s0[8 * g + 0], s0[8 * g + 1]); w0.y = cvt_pk_bf16(s0[8 * g + 2], s0[8 * g + 3]); w0.z = cvt_pk_bf16(s0[8 * g + 4], s0[8 * g + 5]); w0.w = cvt_pk_bf16(s0[8 * g + 6], s0[8 * g + 7]); \
            w1.x = cvt_pk_bf16(s1[8 * g + 0], s1[8 * g + 1]); w1.y = cvt_pk_bf16(s1[8 * g + 2], s1[8 * g + 3]); w1.z = cvt_pk_bf16(s1[8 * g + 4], s1[8 * g + 5]); w1.w = cvt_pk_bf16(s1[8 * g + 6], s1[8 * g + 7]); \
            pf[g] = __builtin_bit_cast(bf16x8, w0); pf[2 + g] = __builtin_bit_cast(bf16x8, w1); } \
        _Pragma("unroll") for (int ks = 0; ks < 4; ++ks) { \
            const bf16x8 v0 = *(const LAS bf16x8*)(vb + r32 * VROW + (16 * ks + 8 * hh) * 2); \
            const bf16x8 v1 = *(const LAS bf16x8*)(vb + (32 + r32) * VROW + (16 * ks + 8 * hh) * 2); \
            o0 = __builtin_amdgcn_mfma_f32_32x32x16_bf16(v0, pf[ks], o0, 0, 0, 0); \
            o1 = __builtin_amdgcn_mfma_f32_32x32x16_bf16(v1, pf[ks], o1, 0, 0, 0); } } while (0)
    ATT_LOAD(0, ra0, ra1, rav); ATT_STORE(0, ra0, ra1, rav);
    ATT_LOAD(1, rb0, rb1, rbv);
    __syncthreads();
    for (int t = 0; t < ntile; t += 2) {
        if (t + 2 < ntile) ATT_LOAD(t + 2, ra0, ra1, rav);
        ATT_COMPUTE(t);
        ATT_STORE(1, rb0, rb1, rbv);
        __syncthreads();
        if (t + 3 < ntile) ATT_LOAD(t + 3, rb0, rb1, rbv);
        ATT_COMPUTE(t + 1);
        if (t + 2 < ntile) ATT_STORE(0, ra0, ra1, rav);
        __syncthreads();
    }
#undef ATT_COMPUTE
#undef ATT_LOAD
#undef ATT_STORE
    const float linv = 1.f / (lrun + __shfl_xor(lrun, 32));
    bf16_t* op = MIX + (size_t)(qrow0 + 32 * wave + r32) * 1024 + h * 64 + 4 * hh;
#pragma unroll
    for (int g = 0; g < 4; ++g) {
        u32x2 w0; w0.x = cvt_pk_bf16(o0[4 * g] * linv, o0[4 * g + 1] * linv); w0.y = cvt_pk_bf16(o0[4 * g + 2] * linv, o0[4 * g + 3] * linv); *(u32x2*)(op + 8 * g) = w0;
        u32x2 w1; w1.x = cvt_pk_bf16(o1[4 * g] * linv, o1[4 * g + 1] * linv); w1.y = cvt_pk_bf16(o1[4 * g + 2] * linv, o1[4 * g + 3] * linv); *(u32x2*)(op + 32 + 8 * g) = w1;
    }
}
}


namespace rwkv {
constexpr int C = 32, NCH = SKEYS / C, NCS = 2 * NB * 8 * NCH;
constexpr int TC = 144, CT = 80;
constexpr int O_A = 0, O_B = 4608, O_K = 9216, O_R = 13824, O_BH = 18432, O_KH = 23552, O_VT = 28672, O_WT = 33792, O_UT = 38912, O_GT = 44032,
              O_AAB = 49152, O_AAK = 53248, O_ARB = 55808, O_ARK = 58368, O_TOT = 60928, O_WSUM = 61184, ITEM_BYTES = 62464;
__device__ __forceinline__ int token_row(int dir, int b, int p) {
    if (p < CTX) return NLAT + b * CTX + (dir ? CTX - 1 - p : p);
    const int t = p - CTX; return b * SEQ + (dir ? SEQ - 1 - t : t);
}
__device__ __forceinline__ f32x4 mfma16(bf16x8 a, bf16x8 b, f32x4 c) { return __builtin_amdgcn_mfma_f32_16x16x32_bf16(a, b, c, 0, 0, 0); }
__device__ __forceinline__ bf16x8 ldfrag(const LAS unsigned char* img, int stride, int row, int kbyte) { return *(const LAS bf16x8*)(img + row * stride + kbyte); }

__device__ __forceinline__ void prep_item(LAS unsigned char* L, int cs, bool valid, int tid4, int solve_base, const bf16_t* RKV, const float* LD, const bf16_t* LR, const float* k_k, const float* k_a,
                                          bf16_t* MT, bf16_t* NT, bf16_t* QC, bf16_t* Y0) {
    const int w = tid4 >> 6, lane = tid4 & 63, l15 = lane & 15, q4 = lane >> 4;
    const int chunk = cs % NCH, sq = cs / NCH, h = sq & 7, b = (sq >> 3) & 1, dir = sq >> 4;
    { const int t = tid4 >> 3, c0 = (tid4 & 7) * 8; const int m = token_row(dir, b, chunk * C + t);
      const u32x4 xr = *(const u32x4*)(RKV + (size_t)m * 1536 + h * 64 + c0), xk = *(const u32x4*)(RKV + (size_t)m * 1536 + 512 + h * 64 + c0), xv = *(const u32x4*)(RKV + (size_t)m * 1536 + 1024 + h * 64 + c0);
      const u32x4 xl = *(const u32x4*)(LR + (size_t)dir * MR * 512 + (size_t)m * 512 + h * 64 + c0);
      const float* ldp = LD + (size_t)dir * MR * 512 + (size_t)m * 512 + h * 64 + c0; const f32x4 l0 = *(const f32x4*)ldp, l1 = *(const f32x4*)(ldp + 4);
      const f32x4 kk0 = *(const f32x4*)(k_k + h * 64 + c0), kk1 = *(const f32x4*)(k_k + h * 64 + c0 + 4), ka0 = *(const f32x4*)(k_a + h * 64 + c0), ka1 = *(const f32x4*)(k_a + h * 64 + c0 + 4);
      float r[8] = {bflo(xr.x), bfhi(xr.x), bflo(xr.y), bfhi(xr.y), bflo(xr.z), bfhi(xr.z), bflo(xr.w), bfhi(xr.w)};
      float k[8] = {bflo(xk.x), bfhi(xk.x), bflo(xk.y), bfhi(xk.y), bflo(xk.z), bfhi(xk.z), bflo(xk.w), bfhi(xk.w)};
      float v[8] = {bflo(xv.x), bfhi(xv.x), bflo(xv.y), bfhi(xv.y), bflo(xv.z), bfhi(xv.z), bflo(xv.w), bfhi(xv.w)};
      float lr[8] = {bflo(xl.x), bfhi(xl.x), bflo(xl.y), bfhi(xl.y), bflo(xl.z), bfhi(xl.z), bflo(xl.w), bfhi(xl.w)};
      float ld[8] = {l0.x, l0.y, l0.z, l0.w, l1.x, l1.y, l1.z, l1.w};
      const float kkv[8] = {kk0.x, kk0.y, kk0.z, kk0.w, kk1.x, kk1.y, kk1.z, kk1.w}, kav[8] = {ka0.x, ka0.y, ka0.z, ka0.w, ka1.x, ka1.y, ka1.z, ka1.w};
      float cum[8];
#pragma unroll
      for (int j = 0; j < 8; ++j) { float x = ld[j];
#pragma unroll
          for (int d = 8; d < 64; d <<= 1) { const float y = __shfl_up(x, d); if (lane >= d) x += y; }
          cum[j] = x; }
      LAS float* wsum = (LAS float*)(L + O_WSUM);
      if (lane >= 56) {
#pragma unroll
          for (int j = 0; j < 8; ++j) wsum[w * 64 + c0 + j] = cum[j]; }
      __syncthreads();
      float tot[8];
#pragma unroll
      for (int j = 0; j < 8; ++j) { float pre = 0.f, all = 0.f;
#pragma unroll
          for (int ww = 0; ww < 4; ++ww) { const float x = wsum[ww * 64 + c0 + j]; all += x; pre += (ww < w) ? x : 0.f; }
          cum[j] += pre; tot[j] = all; }
      if (t == 0) {
#pragma unroll
          for (int j = 0; j < 8; ++j) ((LAS float*)(L + O_TOT))[c0 + j] = tot[j]; }
      float x2 = 0.f; float xs[8];
#pragma unroll
      for (int j = 0; j < 8; ++j) { xs[j] = k[j] * kkv[j]; x2 += xs[j] * xs[j]; }
      x2 += __shfl_xor(x2, 1); x2 += __shfl_xor(x2, 2); x2 += __shfl_xor(x2, 4);
      const float inv = 1.f / fmaxf(sqrtf(x2), 1e-12f);
      float ia[8], ib[8], ik[8], ir[8], hb[8], hk[8];
#pragma unroll
      for (int j = 0; j < 8; ++j) { const float kkn = xs[j] * inv, bb = kkn * lr[j], kd = k[j] * (1.f + (lr[j] - 1.f) * kav[j]);
          const float ec = __expf(cum[j]), ece = __expf(cum[j] - ld[j]), em = __expf(-cum[j]), eh = __expf(tot[j] - cum[j]);
          ia[j] = -kkn * ece; ib[j] = bb * em; ik[j] = kd * em; ir[j] = r[j] * ec; hb[j] = bb * eh; hk[j] = kd * eh; }
      u32x4 wv;
      wv.x = cvt_pk_bf16(ia[0], ia[1]); wv.y = cvt_pk_bf16(ia[2], ia[3]); wv.z = cvt_pk_bf16(ia[4], ia[5]); wv.w = cvt_pk_bf16(ia[6], ia[7]); *(LAS u32x4*)(L + O_A + t * TC + c0 * 2) = wv;
      wv.x = cvt_pk_bf16(ib[0], ib[1]); wv.y = cvt_pk_bf16(ib[2], ib[3]); wv.z = cvt_pk_bf16(ib[4], ib[5]); wv.w = cvt_pk_bf16(ib[6], ib[7]); *(LAS u32x4*)(L + O_B + t * TC + c0 * 2) = wv;
      wv.x = cvt_pk_bf16(ik[0], ik[1]); wv.y = cvt_pk_bf16(ik[2], ik[3]); wv.z = cvt_pk_bf16(ik[4], ik[5]); wv.w = cvt_pk_bf16(ik[6], ik[7]); *(LAS u32x4*)(L + O_K + t * TC + c0 * 2) = wv;
      wv.x = cvt_pk_bf16(ir[0], ir[1]); wv.y = cvt_pk_bf16(ir[2], ir[3]); wv.z = cvt_pk_bf16(ir[4], ir[5]); wv.w = cvt_pk_bf16(ir[6], ir[7]); *(LAS u32x4*)(L + O_R + t * TC + c0 * 2) = wv;
#pragma unroll
      for (int j = 0; j < 8; ++j) { *(LAS unsigned short*)(L + O_BH + (c0 + j) * CT + t * 2) = (unsigned short)f2bf(hb[j]); *(LAS unsigned short*)(L + O_KH + (c0 + j) * CT + t * 2) = (unsigned short)f2bf(hk[j]);
          *(LAS unsigned short*)(L + O_VT + (c0 + j) * CT + t * 2) = (unsigned short)f2bf(v[j]); }
    }
    __syncthreads();
    { const int offI = (w == 0 || w == 2) ? O_B : O_K, offT = (w < 2) ? O_A : O_R; const bool strict = w < 2;
#pragma unroll
      for (int mi = 0; mi < 2; ++mi)
#pragma unroll
          for (int nt = 0; nt < 2; ++nt) { f32x4 d = {0.f, 0.f, 0.f, 0.f};
#pragma unroll
              for (int ks = 0; ks < 2; ++ks) d = mfma16(ldfrag(L + offI, TC, 16 * mi + l15, (32 * ks + 8 * q4) * 2), ldfrag(L + offT, TC, 16 * nt + l15, (32 * ks + 8 * q4) * 2), d);
              const int t = 16 * nt + l15, i0 = 16 * mi + 4 * q4;
#pragma unroll
              for (int j = 0; j < 4; ++j) { const int i = i0 + j; if (strict ? !(i < t) : !(i <= t)) d[j] = 0.f; }
              if (w == 0) *(LAS f32x4*)(L + O_AAB + t * 128 + i0 * 4) = d;
              else { u32x2 o; o.x = cvt_pk_bf16(d[0], d[1]); o.y = cvt_pk_bf16(d[2], d[3]); *(LAS u32x2*)(L + (w == 1 ? O_AAK : w == 2 ? O_ARB : O_ARK) + t * CT + i0 * 2) = o; } }
    }
    __syncthreads();
    {
#pragma unroll
      for (int mt = 0; mt < 2; ++mt) { f32x4 d = {0.f, 0.f, 0.f, 0.f};
          d = mfma16(ldfrag(L + O_AAK, CT, 16 * mt + l15, 16 * q4), ldfrag(L + O_VT, CT, 16 * w + l15, 16 * q4), d);
          u32x2 o; o.x = cvt_pk_bf16(d[0], d[1]); o.y = cvt_pk_bf16(d[2], d[3]); *(LAS u32x2*)(L + O_GT + (16 * w + l15) * CT + (16 * mt + 4 * q4) * 2) = o; }
    }
    __syncthreads();
    const int sw = w - solve_base;
    if (sw == 0 || sw == 1) {
        float x[32];
        if (sw == 0) {
#pragma unroll
            for (int t = 0; t < 32; ++t) x[t] = bf2f(*(const LAS unsigned short*)(L + O_A + t * TC + lane * 2));
        } else {
#pragma unroll
            for (int g = 0; g < 4; ++g) { const u32x4 y = *(const LAS u32x4*)(L + O_GT + lane * CT + g * 16);
                x[8 * g + 0] = bflo(y.x); x[8 * g + 1] = bfhi(y.x); x[8 * g + 2] = bflo(y.y); x[8 * g + 3] = bfhi(y.y); x[8 * g + 4] = bflo(y.z); x[8 * g + 5] = bfhi(y.z); x[8 * g + 6] = bflo(y.w); x[8 * g + 7] = bfhi(y.w); }
        }
#pragma unroll
        for (int t = 1; t < 32; ++t) { float acc = x[t];
#pragma unroll
            for (int i4 = 0; i4 < (t + 3) / 4; ++i4) { const f32x4 a = *(const LAS f32x4*)(L + O_AAB + t * 128 + i4 * 16);
                acc += a.x * x[4 * i4]; if (4 * i4 + 1 < t) acc += a.y * x[4 * i4 + 1]; if (4 * i4 + 2 < t) acc += a.z * x[4 * i4 + 2]; if (4 * i4 + 3 < t) acc += a.w * x[4 * i4 + 3]; }
            x[t] = acc; }
        LAS unsigned char* dst = L + (sw == 0 ? O_WT : O_UT) + lane * CT;
#pragma unroll
        for (int g = 0; g < 4; ++g) { u32x4 o; o.x = cvt_pk_bf16(x[8 * g], x[8 * g + 1]); o.y = cvt_pk_bf16(x[8 * g + 2], x[8 * g + 3]); o.z = cvt_pk_bf16(x[8 * g + 4], x[8 * g + 5]); o.w = cvt_pk_bf16(x[8 * g + 6], x[8 * g + 7]);
            *(LAS u32x4*)(dst + g * 16) = o; }
    }
    __syncthreads();
    if (valid) {
        const int kb = w >> 1, hf = w & 1;
#pragma unroll
        for (int nt = 0; nt < 2; ++nt) { f32x4 d = {0.f, 0.f, 0.f, 0.f};
            d = mfma16(ldfrag(L + O_WT, CT, 16 * w + l15, 16 * q4), ldfrag(L + O_ARB, CT, 16 * nt + l15, 16 * q4), d);
            const int t = 16 * nt + l15; const u32x2 rr = *(const LAS u32x2*)(L + O_R + t * TC + (16 * w + 4 * q4) * 2);
            u32x2 o; o.x = cvt_pk_bf16(d[0] + bflo(rr.x), d[1] + bfhi(rr.x)); o.y = cvt_pk_bf16(d[2] + bflo(rr.y), d[3] + bfhi(rr.y));
            *(u32x2*)(QC + (size_t)cs * 2048 + t * 64 + 32 * kb + 8 * q4 + 4 * hf) = o; }
#pragma unroll
        for (int mt = 0; mt < 2; ++mt) { f32x4 d = {0.f, 0.f, 0.f, 0.f};
            d = mfma16(ldfrag(L + O_ARK, CT, 16 * mt + l15, 16 * q4), ldfrag(L + O_VT, CT, 16 * w + l15, 16 * q4), d);
            d = mfma16(ldfrag(L + O_ARB, CT, 16 * mt + l15, 16 * q4), ldfrag(L + O_UT, CT, 16 * w + l15, 16 * q4), d);
            u32x2 o; o.x = cvt_pk_bf16(d[0], d[1]); o.y = cvt_pk_bf16(d[2], d[3]); *(u32x2*)(Y0 + (size_t)cs * 2048 + ((w * 2 + mt) * 64 + lane) * 4) = o; }
#pragma unroll
        for (int m1 = 0; m1 < 4; ++m1) { f32x4 d = {0.f, 0.f, 0.f, 0.f};
            d = mfma16(ldfrag(L + O_WT, CT, 16 * m1 + l15, 16 * q4), ldfrag(L + O_BH, CT, 16 * w + l15, 16 * q4), d);
            const int c2 = 16 * w + l15, c1 = 16 * m1 + 4 * q4;
#pragma unroll
            for (int j = 0; j < 4; ++j) if (c1 + j == c2) d[j] += __expf(((const LAS float*)(L + O_TOT))[c2]);
            u32x2 o; o.x = cvt_pk_bf16(d[0], d[1]); o.y = cvt_pk_bf16(d[2], d[3]);
            *(u32x2*)(MT + (size_t)cs * 4096 + c2 * 64 + 32 * (m1 >> 1) + 8 * q4 + 4 * (m1 & 1)) = o; }
#pragma unroll
        for (int mc = 0; mc < 4; ++mc) { f32x4 d = {0.f, 0.f, 0.f, 0.f};
            d = mfma16(ldfrag(L + O_BH, CT, 16 * mc + l15, 16 * q4), ldfrag(L + O_UT, CT, 16 * w + l15, 16 * q4), d);
            d = mfma16(ldfrag(L + O_KH, CT, 16 * mc + l15, 16 * q4), ldfrag(L + O_VT, CT, 16 * w + l15, 16 * q4), d);
            u32x2 o; o.x = cvt_pk_bf16(d[0], d[1]); o.y = cvt_pk_bf16(d[2], d[3]);
            *(u32x2*)(NT + (size_t)cs * 4096 + ((w * 4 + mc) * 64 + lane) * 4) = o; }
    }
    __syncthreads();
}

constexpr int RING = 8;
struct StateData { bf16x8 mf[4][2]; u32x2 nt[4]; };
struct OutData { bf16x8 qf[2][2]; u32x2 y0[2]; };
__device__ __forceinline__ void state_load(StateData& d, size_t cs, int slab, int lane, const bf16_t* MT, const bf16_t* NT) {
    const int l15 = lane & 15, q4 = lane >> 4;
#pragma unroll
    for (int mt = 0; mt < 4; ++mt)
#pragma unroll
        for (int kb = 0; kb < 2; ++kb) d.mf[mt][kb] = *(const bf16x8*)(MT + cs * 4096 + (16 * mt + l15) * 64 + 32 * kb + 8 * q4);
#pragma unroll
    for (int mc = 0; mc < 4; ++mc) d.nt[mc] = *(const u32x2*)(NT + cs * 4096 + ((slab * 4 + mc) * 64 + lane) * 4);
}
__device__ __forceinline__ void state_step(const StateData& d, bf16x8 (&sb)[2], int ch, int lane, LAS unsigned char* ring, volatile LAS int* prog, volatile LAS int* ydone) {
    { int guard = 0; while (ch >= *ydone + RING && guard < (1 << 22)) { __builtin_amdgcn_s_sleep(1); ++guard; } }
    LAS bf16x8* slot = (LAS bf16x8*)(ring + (ch & (RING - 1)) * 2048) + lane * 2;
    slot[0] = sb[0]; slot[1] = sb[1];
    __builtin_amdgcn_fence(__ATOMIC_RELEASE, "workgroup");
    if (lane == 0) *prog = ch + 1;
    f32x4 an[4];
#pragma unroll
    for (int mc = 0; mc < 4; ++mc) an[mc] = (f32x4){bflo(d.nt[mc].x), bfhi(d.nt[mc].x), bflo(d.nt[mc].y), bfhi(d.nt[mc].y)};
#pragma unroll
    for (int kb = 0; kb < 2; ++kb)
#pragma unroll
        for (int mt = 0; mt < 4; ++mt) an[mt] = mfma16(d.mf[mt][kb], sb[kb], an[mt]);
#pragma unroll
    for (int kb = 0; kb < 2; ++kb) { u32x4 o; o.x = cvt_pk_bf16(an[2 * kb][0], an[2 * kb][1]); o.y = cvt_pk_bf16(an[2 * kb][2], an[2 * kb][3]); o.z = cvt_pk_bf16(an[2 * kb + 1][0], an[2 * kb + 1][1]); o.w = cvt_pk_bf16(an[2 * kb + 1][2], an[2 * kb + 1][3]);
        sb[kb] = __builtin_bit_cast(bf16x8, o); }
}
__device__ __forceinline__ void state_wave(int sq, int slab, int lane, const bf16_t* MT, const bf16_t* NT, LAS unsigned char* ring, volatile LAS int* prog, volatile LAS int* ydone) {
    bf16x8 sb[2]; { const u32x4 z = {0u, 0u, 0u, 0u}; sb[0] = __builtin_bit_cast(bf16x8, z); sb[1] = sb[0]; }
    const size_t cs0 = (size_t)sq * NCH;
    StateData d0, d1, d2, d3;
    state_load(d0, cs0, slab, lane, MT, NT); state_load(d1, cs0 + 1, slab, lane, MT, NT); state_load(d2, cs0 + 2, slab, lane, MT, NT); state_load(d3, cs0 + 3, slab, lane, MT, NT);
    for (int ch = 0; ch < NCH; ch += 4) {
        const size_t nb = cs0 + (ch + 4 < NCH ? ch + 4 : ch);
        state_step(d0, sb, ch, lane, ring, prog, ydone);     state_load(d0, nb, slab, lane, MT, NT);
        state_step(d1, sb, ch + 1, lane, ring, prog, ydone); state_load(d1, nb + 1, slab, lane, MT, NT);
        state_step(d2, sb, ch + 2, lane, ring, prog, ydone); state_load(d2, nb + 2, slab, lane, MT, NT);
        state_step(d3, sb, ch + 3, lane, ring, prog, ydone); state_load(d3, nb + 3, slab, lane, MT, NT);
    }
}
__device__ __forceinline__ void out_load(OutData& d, size_t cs, int slab, int lane, const bf16_t* QC, const bf16_t* Y) {
    const int l15 = lane & 15, q4 = lane >> 4;
#pragma unroll
    for (int mt = 0; mt < 2; ++mt)
#pragma unroll
        for (int kb = 0; kb < 2; ++kb) d.qf[mt][kb] = *(const bf16x8*)(QC + cs * 2048 + (16 * mt + l15) * 64 + 32 * kb + 8 * q4);
#pragma unroll
    for (int mt = 0; mt < 2; ++mt) d.y0[mt] = *(const u32x2*)(Y + cs * 2048 + ((slab * 2 + mt) * 64 + lane) * 4);
}
__device__ __forceinline__ void out_step(const OutData& d, size_t cs, int ch, int slab, int lane, bf16_t* YS, const LAS unsigned char* ring, volatile LAS int* prog, volatile LAS int* ydone) {
    { int guard = 0; while (*prog <= ch && guard < (1 << 22)) { __builtin_amdgcn_s_sleep(1); ++guard; } }
    __builtin_amdgcn_fence(__ATOMIC_ACQUIRE, "workgroup");
    const LAS bf16x8* slot = (const LAS bf16x8*)(ring + (ch & (RING - 1)) * 2048) + lane * 2;
    const bf16x8 s0 = slot[0], s1 = slot[1];
    f32x4 ay[2] = {(f32x4){bflo(d.y0[0].x), bfhi(d.y0[0].x), bflo(d.y0[0].y), bfhi(d.y0[0].y)}, (f32x4){bflo(d.y0[1].x), bfhi(d.y0[1].x), bflo(d.y0[1].y), bfhi(d.y0[1].y)}};
#pragma unroll
    for (int mt = 0; mt < 2; ++mt) { ay[mt] = mfma16(d.qf[mt][0], s0, ay[mt]); ay[mt] = mfma16(d.qf[mt][1], s1, ay[mt]); }
    __builtin_amdgcn_fence(__ATOMIC_RELEASE, "workgroup");
    if (lane == 0) *ydone = ch + 1;
#pragma unroll
    for (int mt = 0; mt < 2; ++mt) { u32x2 o; o.x = cvt_pk_bf16(ay[mt][0], ay[mt][1]); o.y = cvt_pk_bf16(ay[mt][2], ay[mt][3]); *(u32x2*)(YS + cs * 2048 + ((slab * 2 + mt) * 64 + lane) * 4) = o; }
}
__device__ __forceinline__ void out_wave(int sq, int slab, int lane, const bf16_t* QC, const bf16_t* Y, bf16_t* YS, const LAS unsigned char* ring, volatile LAS int* prog, volatile LAS int* ydone) {
    const size_t cs0 = (size_t)sq * NCH;
    OutData d0, d1, d2, d3, d4, d5;
    out_load(d0, cs0, slab, lane, QC, Y); out_load(d1, cs0 + 1, slab, lane, QC, Y); out_load(d2, cs0 + 2, slab, lane, QC, Y);
    out_load(d3, cs0 + 3, slab, lane, QC, Y); out_load(d4, cs0 + 4, slab, lane, QC, Y); out_load(d5, cs0 + 5, slab, lane, QC, Y);
    for (int ch = 0; ch < NCH; ch += 6) {
        const size_t nb = cs0 + (ch + 6 < NCH ? ch + 6 : ch);
        out_step(d0, cs0 + ch, ch, slab, lane, YS, ring, prog, ydone);         out_load(d0, nb, slab, lane, QC, Y);
        out_step(d1, cs0 + ch + 1, ch + 1, slab, lane, YS, ring, prog, ydone); out_load(d1, nb + 1, slab, lane, QC, Y);
        out_step(d2, cs0 + ch + 2, ch + 2, slab, lane, YS, ring, prog, ydone); out_load(d2, nb + 2, slab, lane, QC, Y);
        out_step(d3, cs0 + ch + 3, ch + 3, slab, lane, YS, ring, prog, ydone); out_load(d3, nb + 3, slab, lane, QC, Y);
        out_step(d4, cs0 + ch + 4, ch + 4, slab, lane, YS, ring, prog, ydone); out_load(d4, nb + 4, slab, lane, QC, Y);
        out_step(d5, cs0 + ch + 5, ch + 5, slab, lane, YS, ring, prog, ydone); out_load(d5, nb + 5, slab, lane, QC, Y);
    }
}
}

constexpr int NWAVES = 8;
struct Frame {
    LAS unsigned char* lds; volatile LAS unsigned* MISC; unsigned* ctl;
    int tid, lane, wave, vcu, G;
    float* out; unsigned char* ws;
};
enum { I_X = 0, I_C, I_CTX, I_CCTX,
       I0_MODW, I0_MODB, I0_WIN, I0_QNORM, I0_WQUP, I0_KVNORM, I0_WKVUP, I0_CONV, I0_W0F, I0_W2F, I0_W0B, I0_W2B, I0_A0F, I0_A2F, I0_A0B, I0_A2B, I0_G2,
       I0_KK, I0_KA, I0_RK, I0_LNXG, I0_LNXB, I0_WOUT, I0_LN1G, I0_LN1B, I0_FFG, I0_FFU, I0_FFD, I0_LN2G, I0_LN2B,
       I1_MODW, I1_MODB, I1_WIN, I1_DECF, I1_DECB, I1_WOUT, I1_LN1G, I1_LN1B, I1_ROUTER, I1_MOEG, I1_MOEU, I1_MOED, I1_LN2G, I1_LN2B, N_IN };

template <class RowMap>
__device__ __forceinline__ void transpose_item(const float* W, int ldw, int k0, int n0, bf16_t* WT, int ldt, int kofs, const RowMap& rm, LAS float* scr, int lane) {
    float wv[32];
#pragma unroll
    for (int i = 0; i < 32; ++i) { const int kk = 2 * i + (lane >> 5); wv[i] = W[(size_t)(k0 + kk) * ldw + n0 + (lane & 31)]; }
#pragma unroll
    for (int i = 0; i < 32; ++i) { const int kk = 2 * i + (lane >> 5); scr[kk * 33 + (lane & 31)] = wv[i]; }
    asm volatile("s_waitcnt lgkmcnt(0)" ::: "memory");
    const int c = lane & 7;
#pragma unroll
    for (int j = 0; j < 4; ++j) { const int n = (lane >> 3) + 8 * j; const LAS float* s = scr + (8 * c) * 33 + n;
        u32x4 o; o.x = pk2(s[0 * 33], s[1 * 33]); o.y = pk2(s[2 * 33], s[3 * 33]); o.z = pk2(s[4 * 33], s[5 * 33]); o.w = pk2(s[6 * 33], s[7 * 33]);
        *(u32x4*)(WT + (size_t)rm(n0 + n) * ldt + kofs + k0 + 8 * c) = o; }
    asm volatile("s_waitcnt lgkmcnt(0)" ::: "memory");
}
struct RmPlain { int off; __device__ int operator()(int n) const { return off + n; } };
struct RmGU { int off; __device__ int operator()(int n) const { return off + (n >> 7) * 256 + (n & 127); } };

struct RmRope1 { int off; __device__ int operator()(int n) const { const int hf = n & ~127, u = n & 127, i = u & 63; return off + hf + (i >> 4) * 32 + (u >= 64 ? 16 : 0) + (i & 15); } };
struct RmGate1 { __device__ int operator()(int n) const { const int j = n & 2047, isb = n >> 11; return 4096 + (j >> 4) * 32 + isb * 16 + (j & 15); } };
struct RmMlaQ { __device__ int operator()(int n) const { const int h = n / 96, u = n % 96; if (u < 64) return h * 96 + u; const int up = u - 64, f = up >> 4, w = up & 15, i = w & 7, sec = w >> 3; return h * 96 + 64 + sec * 16 + f * 8 + i; } };
struct RmKV2 { __device__ int operator()(int n) const { const int h = n >> 7, d = n & 127; return d < 64 ? h * 64 + d : 512 + h * 64 + (d - 64); } };
struct RmMlaKV { __device__ int operator()(int n) const { const int h = n >> 7, d = n & 127; return d < 64 ? 768 + h * 64 + d : 1280 + h * 64 + (d - 64); } };
__device__ __forceinline__ void sincos_tab(double a, float& sn, float& cs) {
    const double k = rint(a * 0.63661977236758134308);
    const double r = (a - k * 1.57079632679489655800) - k * 6.123233995736766e-17;
    const int q = ((int)k) & 3; const double r2 = r * r;
    const double sv = r * (1.0 - r2 / 6.0 * (1.0 - r2 / 20.0 * (1.0 - r2 / 42.0 * (1.0 - r2 / 72.0 * (1.0 - r2 / 110.0 * (1.0 - r2 / 156.0))))));
    const double cv = 1.0 - r2 / 2.0 * (1.0 - r2 / 12.0 * (1.0 - r2 / 30.0 * (1.0 - r2 / 56.0 * (1.0 - r2 / 90.0 * (1.0 - r2 / 132.0)))));
    const double ss = (q == 0) ? sv : (q == 1) ? cv : (q == 2) ? -sv : -cv;
    const double cc = (q == 0) ? cv : (q == 1) ? -sv : (q == 2) ? -cv : sv;
    sn = (float)ss; cs = (float)cc;
}
__device__ __forceinline__ void rope_tables(Frame& F) {
    f32x2* t0 = (f32x2*)(F.ws + WS_SMALL + SM_ROPE0); f32x2* t1 = (f32x2*)(F.ws + WS_SMALL + SM_ROPE1);
    const int gt = (F.vcu * NWAVES + F.wave) * 64 + F.lane, NGT = F.G * NWAVES * 64;
    for (int i = gt; i < 128 * 8 + 128 * 64; i += NGT) {
        const bool first = i < 1024; const int j = first ? i : i - 1024, nf = first ? 8 : 64, pos = j / nf, fi = j % nf;
        const float invf = (float)exp2(-(double)fi / (double)nf * 13.287712379549449);
        const float ang = (float)pos * invf; float sn, cs; sincos_tab((double)ang, sn, cs);
        (first ? t0 : t1)[j] = (f32x2){cs, sn};
    }
}
template <class RowMap>
__device__ __forceinline__ void convert_matrix(Frame& F, int& cursor, const float* W, int K, int N, int ldw, bf16_t* WT, int ldt, int kofs, const RowMap& rm, int gw = -1, int NGW = 0) {
    LAS float* scr = (LAS float*)(F.lds + F.wave * 16384);
    if (gw < 0) { gw = F.vcu * NWAVES + F.wave; NGW = F.G * NWAVES; }
    const int nblk = N / 32, nit = (K / 64) * nblk;
    int first = (gw - cursor % NGW + NGW) % NGW;
    for (int it = first; it < nit; it += NGW) transpose_item(W, ldw, 64 * (it / nblk), 32 * (it % nblk), WT, ldt, kofs, rm, scr, F.lane);
    cursor += nit;
}
__device__ __forceinline__ void zero_rect(Frame& F, bf16_t* base, int ld, int r0, int nr, int c0, int nc) {
    const int per_row = nc / 8, total = nr * per_row, gt = (F.vcu * NWAVES + F.wave) * 64 + F.lane, NGT = F.G * NWAVES * 64;
    for (int i = gt; i < total; i += NGT) { const int r = i / per_row, c = (i % per_row) * 8; *(u32x4*)(base + (size_t)(r0 + r) * ld + c0 + c) = (u32x4){0u, 0u, 0u, 0u}; }
}

__device__ __forceinline__ void mod_vectors(Frame& F, const float* modw0, const float* modb0, const float* modw1, const float* modb1, const float* cvec, const float* cctx) {
    if (blockIdx.x >= 96) return;
    const int layer = blockIdx.x / 48, cb = blockIdx.x % 48;
    const float* W = layer ? modw1 : modw0; const float* bias = layer ? modb1 : modb0;
    LAS float* sc = (LAS float*)F.lds;
    LAS float* red = sc + 3 * 1024;
    for (int i = F.tid; i < 3 * 1024; i += 512) { const int cls = i / 1024, k = i % 1024; const float v = cls < 2 ? cvec[cls * 1024 + k] : cctx[k]; sc[i] = silu_f(v); }
    __syncthreads();
    const int col = cb * 128 + 2 * F.lane;
    float a[3][2] = {{0.f, 0.f}, {0.f, 0.f}, {0.f, 0.f}};
    for (int k0 = F.wave * 128; k0 < F.wave * 128 + 128; k0 += 16) {
        f32x2 w[16];
#pragma unroll
        for (int i = 0; i < 16; ++i) w[i] = *(const f32x2*)(W + (size_t)(k0 + i) * 6144 + col);
#pragma unroll
        for (int i = 0; i < 16; ++i)
#pragma unroll
            for (int c = 0; c < 3; ++c) { const float s = sc[c * 1024 + k0 + i]; a[c][0] += s * w[i].x; a[c][1] += s * w[i].y; }
    }
#pragma unroll
    for (int c = 0; c < 3; ++c) { red[(F.wave * 3 + c) * 128 + 2 * F.lane] = a[c][0]; red[(F.wave * 3 + c) * 128 + 2 * F.lane + 1] = a[c][1]; }
    __syncthreads();
    float* mod = (float*)(F.ws + WS_SMALL + SM_MOD) + (size_t)layer * 3 * 6144;
    if (F.tid < 384) { const int c = F.tid / 128, j = F.tid % 128; float s = bias[cb * 128 + j];
#pragma unroll
        for (int w = 0; w < 8; ++w) s += red[(w * 3 + c) * 128 + j];
        mod[c * 6144 + cb * 128 + j] = s; }
    __syncthreads();
}

struct Row4 { f32x4 v[4]; };
__device__ __forceinline__ Row4 row_load(const float* p, int lane) { Row4 r; const f32x4* q = (const f32x4*)p + lane;
#pragma unroll
    for (int j = 0; j < 4; ++j) r.v[j] = q[64 * j]; return r; }
__device__ __forceinline__ Row4 row_load_bf16(const bf16_t* p, int lane) { Row4 r; const u32x2* q = (const u32x2*)p + lane;
#pragma unroll
    for (int j = 0; j < 4; ++j) { const u32x2 a = q[64 * j]; r.v[j] = (f32x4){bflo(a.x), bfhi(a.x), bflo(a.y), bfhi(a.y)}; } return r; }
__device__ __forceinline__ void row_store(float* p, int lane, const Row4& r) { f32x4* q = (f32x4*)p + lane;
#pragma unroll
    for (int j = 0; j < 4; ++j) q[64 * j] = r.v[j]; }
__device__ __forceinline__ void row_store_bf16(bf16_t* p, int lane, const Row4& r) { u32x2* q = (u32x2*)p + lane;
#pragma unroll
    for (int j = 0; j < 4; ++j) { u32x2 w; w.x = pk2(r.v[j].x, r.v[j].y); w.y = pk2(r.v[j].z, r.v[j].w); q[64 * j] = w; } }
__device__ __forceinline__ Row4 row_ln(const Row4& a, const float* g, const float* b, int lane) {
    float s = 0.f;
#pragma unroll
    for (int j = 0; j < 4; ++j) s += (a.v[j].x + a.v[j].y) + (a.v[j].z + a.v[j].w);
    const float mean = wave_sum(s) * (1.f / DM); float s2 = 0.f; Row4 d;
#pragma unroll
    for (int j = 0; j < 4; ++j) { d.v[j] = a.v[j] - mean; s2 += (d.v[j].x * d.v[j].x + d.v[j].y * d.v[j].y) + (d.v[j].z * d.v[j].z + d.v[j].w * d.v[j].w); }
    const float rstd = 1.f / sqrtf(wave_sum(s2) * (1.f / DM) + LN_EPS);
    const Row4 gg = row_load(g, lane), bb = row_load(b, lane); Row4 o;
#pragma unroll
    for (int j = 0; j < 4; ++j) o.v[j] = d.v[j] * rstd * gg.v[j] + bb.v[j];
    return o;
}
__device__ __forceinline__ Row4 row_ln_v(const Row4& a, const Row4& gg, const Row4& bb) {
    float s = 0.f;
#pragma unroll
    for (int j = 0; j < 4; ++j) s += (a.v[j].x + a.v[j].y) + (a.v[j].z + a.v[j].w);
    const float mean = wave_sum(s) * (1.f / DM); float s2 = 0.f; Row4 d;
#pragma unroll
    for (int j = 0; j < 4; ++j) { d.v[j] = a.v[j] - mean; s2 += (d.v[j].x * d.v[j].x + d.v[j].y * d.v[j].y) + (d.v[j].z * d.v[j].z + d.v[j].w * d.v[j].w); }
    const float rstd = 1.f / sqrtf(wave_sum(s2) * (1.f / DM) + LN_EPS);
    Row4 o;
#pragma unroll
    for (int j = 0; j < 4; ++j) o.v[j] = d.v[j] * rstd * gg.v[j] + bb.v[j];
    return o;
}
struct ModVec { int cls; Row4 sh, sc; };
__device__ __forceinline__ void modvec_get(ModVec& mv, int cls, const float* mod, int shift_off, int scale_off, int lane) {
    if (cls != mv.cls) { mv.cls = cls; mv.sh = row_load(mod + (size_t)cls * 6144 + shift_off, lane); mv.sc = row_load(mod + (size_t)cls * 6144 + scale_off, lane); }
}
__device__ __forceinline__ Row4 row_mod_v(const Row4& a, const ModVec& mv) { Row4 o;
#pragma unroll
    for (int j = 0; j < 4; ++j) o.v[j] = a.v[j] * (mv.sc.v[j] + 1.f) + mv.sh.v[j];
    return o; }
__device__ __forceinline__ void ctx_fix(Row4& p, const float* part, int nsl, int lane) {
#pragma unroll
    for (int j = 0; j < 4; ++j) p.v[j] = p.v[j] * ALPHA;
    for (int sl = 0; sl < nsl; ++sl) { const Row4 q = row_load(part + (size_t)sl * NCTX * 1024, lane);
#pragma unroll
        for (int j = 0; j < 4; ++j) p.v[j] = p.v[j] + q.v[j]; }
}
__device__ __forceinline__ Row4 row_mod(const Row4& a, const float* shift, const float* scale, int lane) {
    const Row4 sh = row_load(shift, lane), sc = row_load(scale, lane); Row4 o;
#pragma unroll
    for (int j = 0; j < 4; ++j) o.v[j] = a.v[j] * (sc.v[j] + 1.f) + sh.v[j];
    return o;
}

struct Args { const float* in[N_IN]; float* out; unsigned char* ws; int ph_lo, ph_hi; };
constexpr int N_PHASES = 32;

__global__ void __launch_bounds__(NWAVES * 64, 2) mk_fwd(Args args) {
    extern __shared__ __attribute__((aligned(16))) unsigned char lds_raw[];
    Frame F;
    F.lds = (LAS unsigned char*)lds_raw; F.MISC = (volatile LAS unsigned*)(F.lds + MISC_OFF);
    F.tid = threadIdx.x; F.lane = F.tid & 63; F.wave = __builtin_amdgcn_readfirstlane(F.tid >> 6);
    F.G = gridDim.x; { const int bx = blockIdx.x; F.vcu = (F.G % 8 == 0) ? (bx % 8) * (F.G / 8) + bx / 8 : bx; }
    F.out = args.out; F.ws = args.ws; F.ctl = (unsigned*)(args.ws + WS_CTL);
    for (int u = F.tid; u < (LDS_BYTES - LDSCTL_OFF) / 4; u += NWAVES * 64) ((LAS unsigned*)(F.lds + LDSCTL_OFF))[u] = 0u;
    __syncthreads();
    XcdBarrier bar = xcd_barrier_post(F.ctl + CW_BAR, F.MISC + 8);
    const int lo = args.ph_lo, hi = args.ph_hi;
#ifndef ONLY_PH
#define ONLY_PH -1
#endif
#define IN(k) ((ONLY_PH < 0 || ONLY_PH == (k)) && lo <= (k) && (k) < hi)
#define INP(i) (args.in[i])
#ifndef DBL_PH
#define DBL_PH -1
#endif
#define REPS(k) (((k) == DBL_PH) ? 2 : 1)
#define SEAM(k) do { if (IN(k) && IN((k) + 1)) xcd_barrier(bar); } while (0)
    unsigned char* ws = args.ws;
    const float* mod0 = (const float*)(ws + WS_SMALL + SM_MOD);
    const float* mod1 = mod0 + 3 * 6144;
    const int gw = F.vcu * NWAVES + F.wave, NGW = F.G * NWAVES;

    if (IN(0)) {
        for (int r_ = 0; r_ < REPS(0); ++r_) mod_vectors(F, INP(I0_MODW), INP(I0_MODB), INP(I1_MODW), INP(I1_MODB), INP(I_C), INP(I_CCTX));
        int cur = 0;
        if (DBL_PH == 29) for (int r_ = 0; r_ < 2; ++r_) { convert_matrix(F, cur, INP(I1_WIN), 1024, 1024, ODD_IN, (bf16_t*)(ws + WS_W1IN), 1024, 0, RmRope1{0}); convert_matrix(F, cur, INP(I1_WIN) + 4096, 1024, 4096, ODD_IN, (bf16_t*)(ws + WS_W1IN), 1024, 0, RmGate1{}); convert_matrix(F, cur, INP(I0_FFD), FF, 1024, 1024, (bf16_t*)(ws + WS_W0DN), FF, 0, RmPlain{0}); }
        rope_tables(F);
        if (blockIdx.x == 100) { float* b4 = (float*)(ws + WS_SMALL + SM_BIAS4); b4[F.tid] = INP(I0_W0F)[F.tid]; b4[512 + F.tid] = INP(I0_W0B)[F.tid]; b4[1024 + F.tid] = INP(I0_A0F)[F.tid]; b4[1536 + F.tid] = INP(I0_A0B)[F.tid]; }
        convert_matrix(F, cur, INP(I0_WIN), 1024, E_IN, E_IN, (bf16_t*)(ws + WS_W0IN), 1024, 0, RmPlain{0});
        zero_rect(F, (bf16_t*)(ws + WS_W0IN), 1024, E_IN, E_INP - E_IN, 0, 1024);
        convert_matrix(F, cur, INP(I0_WQUP), 256, 768, 768, (bf16_t*)(ws + WS_WMLAQ), 256, 0, RmMlaQ{});
        convert_matrix(F, cur, INP(I0_WKVUP), 128, 1024, 1024, (bf16_t*)(ws + WS_WKV), 128, 0, RmKV2{});
        { bf16_t* WL = (bf16_t*)(ws + WS_WLORA);
          convert_matrix(F, cur, INP(I0_W2F), 64, 512, 512, WL, 128, 0, RmPlain{0});
          convert_matrix(F, cur, INP(I0_W2B), 64, 512, 512, WL, 128, 0, RmPlain{512});
          convert_matrix(F, cur, INP(I0_A2F), 64, 512, 512, WL, 128, 0, RmPlain{1024});
          convert_matrix(F, cur, INP(I0_A2B), 64, 512, 512, WL, 128, 0, RmPlain{1536});
          convert_matrix(F, cur, INP(I0_G2), 128, 512, 512, WL, 128, 0, RmPlain{2048});
          zero_rect(F, WL, 128, 0, 2048, 64, 64); }
    }
    SEAM(0);


    if (IN(1)) {
        ModVec mv; mv.cls = -1;
        for (int m_ = gw; m_ < MR * REPS(1); m_ += NGW) { const int m = m_ % MR;
            const Row4 xr = row_load(m < NLAT ? INP(I_X) + (size_t)m * 1024 : INP(I_CTX) + (size_t)(m - NLAT) * 1024, F.lane);
            modvec_get(mv, row_class(m), mod0, 0, 1024, F.lane);
            row_store_bf16((bf16_t*)(ws + WS_XMOD) + (size_t)m * 1024, F.lane, row_mod_v(xr, mv));
        }
    }
    SEAM(1);

    if (IN(2)) {
        pg8::DenseOrder S; S.init((const bf16_t*)(ws + WS_XMOD), 1024, (const bf16_t*)(ws + WS_W0IN), 1024, MR, E_INP, 1024, F.G, (int)blockIdx.x); S.reps = REPS(2);
        pg8::EpiBf16 E{(bf16_t*)(ws + WS_Z0), E_INP};
        pg8::gemm_phase<pg8::EpiBf16, pg8::DenseOrder, true, false>(F.lds, 1024, 1024, S, E);
    }
    SEAM(2);

    if (IN(3)) {
        LAS unsigned short* wscr = (LAS unsigned short*)(F.lds + F.wave * 128);
        const f32x2* rope0 = (const f32x2*)(ws + WS_SMALL + SM_ROPE0);
        bf16_t* AM = (bf16_t*)(ws + WS_AMLA); bf16_t* AL = (bf16_t*)(ws + WS_ALORA); bf16_t* RKV = (bf16_t*)(ws + WS_RKV); bf16_t* KBp = (bf16_t*)(ws + WS_KB);
        const float* convw = INP(I0_CONV);
        f32x4 cw[3][2][3];
#pragma unroll
        for (int g = 0; g < 3; ++g)
#pragma unroll
            for (int q = 0; q < 2; ++q)
#pragma unroll
                for (int k = 0; k < 3; ++k) cw[g][q][k] = *(const f32x4*)(convw + k * 1536 + 8 * (F.lane + 64 * g) + 4 * q);
        const f32x4 gq = *(const f32x4*)(INP(I0_QNORM) + 4 * F.lane); const f32x2 gkv = *(const f32x2*)(INP(I0_KVNORM) + 2 * F.lane);
        for (int m_ = gw; m_ < MR * REPS(3); m_ += NGW) { const int m = m_ % MR;
            const bf16_t* Z = (const bf16_t*)(ws + WS_Z0) + (size_t)m * E_INP;
            const bool lat = m < NLAT;
            const int b = lat ? (m >> 13) : ((m - NLAT) >> 8), tpos = lat ? (m & (SEQ - 1)) : ((m - NLAT) & (CTX - 1)), slen = lat ? SEQ : CTX;
            const u32x2 wa = *(const u32x2*)(Z + 4 * F.lane);
            const unsigned wb = *(const unsigned*)(Z + 256 + 2 * F.lane);
            const int rf = (F.lane >> 3) & 1, ri = F.lane & 7;
            const unsigned short rt1 = Z[384 + rf * 16 + ri], rt2 = Z[384 + rf * 16 + ri + 8];
            const f32x2 rcs = rope0[(rf ? (tpos & 63) : (tpos >> 6)) * 8 + ri];
            const bf16_t* R0 = Z + 416; const bool hp = tpos > 0, hn = tpos < slen - 1;
            u32x4 xc[3], xp[3], xn[3];
#pragma unroll
            for (int g = 0; g < 3; ++g) { const int c = 8 * (F.lane + 64 * g);
                xc[g] = *(const u32x4*)(R0 + c);
                xp[g] = hp ? *(const u32x4*)(R0 - E_INP + c) : (u32x4){0u, 0u, 0u, 0u};
                xn[g] = hn ? *(const u32x4*)(R0 + E_INP + c) : (u32x4){0u, 0u, 0u, 0u}; }
            const u32x4 xe = *(const u32x4*)(Z + 1952 + 8 * (F.lane < 48 ? F.lane : 47));
            { const float v0 = bflo(wa.x), v1 = bfhi(wa.x), v2 = bflo(wa.y), v3 = bfhi(wa.y);
              const float r = rsqrtf(wave_sum(v0 * v0 + v1 * v1 + v2 * v2 + v3 * v3) * (1.f / 256.f) + 1e-6f);
              u32x2 o; o.x = pk2(v0 * r * gq.x, v1 * r * gq.y); o.y = pk2(v2 * r * gq.z, v3 * r * gq.w); *(u32x2*)(AM + (size_t)m * 384 + 4 * F.lane) = o; }
            { const float v0 = bflo(wb), v1 = bfhi(wb);
              const float r = rsqrtf(wave_sum(v0 * v0 + v1 * v1) * (1.f / 128.f) + 1e-6f);
              *(unsigned*)(AM + (size_t)m * 384 + 256 + 2 * F.lane) = pk2(v0 * r * gkv.x, v1 * r * gkv.y); }
            { if (F.lane < 16) { const float t1 = bf2f(rt1), t2 = bf2f(rt2);
                  float o1 = t1, o2 = t2;
                  if (lat) { o1 = t1 * rcs.x - t2 * rcs.y; o2 = t1 * rcs.y + t2 * rcs.x; }
                  wscr[F.lane] = (unsigned short)f2bf(o1); wscr[16 + F.lane] = (unsigned short)f2bf(o2); }
              asm volatile("s_waitcnt lgkmcnt(0)" ::: "memory");
              if (F.lane < 32) { const u32x4 c = *(const LAS u32x4*)((const LAS unsigned char*)wscr + (F.lane & 3) * 16);
                  const int sk = lat ? CTX + tpos : tpos;
                  *(u32x4*)(KBp + ((size_t)(b * SKEYS + sk) * 8 + (F.lane >> 2)) * 96 + 64 + (F.lane & 3) * 8) = c; }
              asm volatile("s_waitcnt lgkmcnt(0)" ::: "memory"); }
            {
#pragma unroll
              for (int g = 0; g < 3; ++g) { const int c = 8 * (F.lane + 64 * g);
                  float o[8];
#pragma unroll
                  for (int q = 0; q < 2; ++q) { const f32x4 w0 = cw[g][q][0], w1 = cw[g][q][1], w2 = cw[g][q][2];
                      const unsigned p0 = q ? xp[g].z : xp[g].x, p1 = q ? xp[g].w : xp[g].y, c0 = q ? xc[g].z : xc[g].x, c1 = q ? xc[g].w : xc[g].y, n0 = q ? xn[g].z : xn[g].x, n1 = q ? xn[g].w : xn[g].y;
                      o[4 * q + 0] = bflo(p0) * w0.x + bflo(c0) * w1.x + bflo(n0) * w2.x; o[4 * q + 1] = bfhi(p0) * w0.y + bfhi(c0) * w1.y + bfhi(n0) * w2.y;
                      o[4 * q + 2] = bflo(p1) * w0.z + bflo(c1) * w1.z + bflo(n1) * w2.z; o[4 * q + 3] = bfhi(p1) * w0.w + bfhi(c1) * w1.w + bfhi(n1) * w2.w; }
                  u32x4 w; w.x = pk2(o[0], o[1]); w.y = pk2(o[2], o[3]); w.z = pk2(o[4], o[5]); w.w = pk2(o[6], o[7]);
                  *(u32x4*)(RKV + (size_t)m * 1536 + c) = w; } }
            { if (F.lane < 48) { const u32x4 x = xe; float v[8] = {bflo(x.x), bfhi(x.x), bflo(x.y), bfhi(x.y), bflo(x.z), bfhi(x.z), bflo(x.w), bfhi(x.w)};
#pragma unroll
                  for (int j = 0; j < 8; ++j) { if (F.lane < 16) { const float e = __expf(2.f * v[j]); v[j] = 1.f - 2.f / (e + 1.f); } else if (F.lane >= 32) v[j] = sigmoid_f(v[j]); }
                  u32x4 w; w.x = pk2(v[0], v[1]); w.y = pk2(v[2], v[3]); w.z = pk2(v[4], v[5]); w.w = pk2(v[6], v[7]);
                  *(u32x4*)(AL + (size_t)m * 384 + 8 * F.lane) = w; } }
        }
    }
    SEAM(3);

    if (IN(4)) {
        { pg8::BlockOrder S{(const bf16_t*)(ws + WS_ALORA), (const bf16_t*)(ws + WS_WLORA), 384, 128, 128, MR / 256, 2, 5, 64, F.G, (int)blockIdx.x, REPS(4)};
          pg8::EpiLora E{(float*)(ws + WS_LDF), (bf16_t*)(ws + WS_LRF), (const float*)(ws + WS_SMALL + SM_BIAS4)};
          pg8::gemm_phase<pg8::EpiLora, pg8::BlockOrder, true, false>(F.lds, 384, 128, S, E); }
        { pg8::EpiMlaQK E{(bf16_t*)(ws + WS_QB), (bf16_t*)(ws + WS_KB), (const f32x2*)(ws + WS_SMALL + SM_ROPE0), 0.10206207261596577f * 1.4426950408889634f};
          { pg8::DenseOrder S; S.init((const bf16_t*)(ws + WS_AMLA), 384, (const bf16_t*)(ws + WS_WMLAQ), 256, MR, 768, 256, F.G, (int)blockIdx.x); S.reps = REPS(4);
            pg8::gemm_phase<pg8::EpiMlaQK, pg8::DenseOrder, true, false>(F.lds, 384, 256, S, E); }
          { pg8::BlockOrder S{(const bf16_t*)(ws + WS_AMLA) + 256 - 3 * 0, (const bf16_t*)(ws + WS_WKV) - (size_t)3 * 256 * 128, 384, 128, 128, MR / 256, 2, 1, 0, F.G, (int)blockIdx.x, REPS(4)}; S.nblk = 1;
            pg8::gemm_phase<pg8::EpiMlaQK, pg8::KnopeOrder, true, false>(F.lds, 384, 128, pg8::KnopeOrder{S}, E); } }
        { pg8::DenseOrder S; S.init((const bf16_t*)(ws + WS_WKV) + (size_t)512 * 128, 128, (const bf16_t*)(ws + WS_AMLA) + 256, 384, 512, MR, 128, F.G, (int)blockIdx.x); S.reps = REPS(4);
          pg8::EpiVT E{(bf16_t*)(ws + WS_VT)};
          pg8::gemm_phase<pg8::EpiVT, pg8::DenseOrder, true, false>(F.lds, 128, 384, S, E); }
    }
    SEAM(4);


    if (IN(5)) {
        const int grp = F.tid >> 8, tid4 = F.tid & 255;
        for (int it0 = F.vcu * 2 + grp; it0 < ((rwkv::NCS * REPS(5) + 2 * F.G - 1) / (2 * F.G)) * 2 * F.G; it0 += 2 * F.G) {
            const bool valid = it0 < rwkv::NCS * REPS(5); const int it = it0 % rwkv::NCS; const int cs = valid ? it : rwkv::NCS - 1;
            rwkv::prep_item(F.lds + grp * rwkv::ITEM_BYTES, cs, valid, tid4, 2 * grp, (const bf16_t*)(ws + WS_RKV), (const float*)(ws + WS_LDF), (const bf16_t*)(ws + WS_LRF), INP(I0_KK), INP(I0_KA),
                            (bf16_t*)(ws + WS_MT), (bf16_t*)(ws + WS_NT), (bf16_t*)(ws + WS_QC), (bf16_t*)(ws + WS_Y0));
        }
    }
    SEAM(5);

    if (IN(6)) {
        const bf16_t* QBp = (const bf16_t*)(ws + WS_QB); const bf16_t* KBp = (const bf16_t*)(ws + WS_KB); const bf16_t* VTp = (const bf16_t*)(ws + WS_VT); bf16_t* MIX = (bf16_t*)(ws + WS_MIX0);
        for (int uu = F.vcu; uu < (512 + 32) * REPS(6); uu += F.G) { const int u = uu % 544; if (u >= 512 && !(u & 1)) continue;
            if (u < 512) { const int bh = u >> 5, qb = u & 31, b = bh >> 3, h = bh & 7; attn::unit(F.lds, QBp, KBp, VTp, MIX, b, h, b * SEQ + qb * 256, SKEYS, F.tid); }
            else { const int bh = (u - 512) >> 1, b = bh >> 3, h = bh & 7; attn::unit(F.lds, QBp, KBp, VTp, MIX, b, h, NLAT + b * CTX, CTX, F.tid); }
        }
        __syncthreads();
        { volatile LAS int* prog = (volatile LAS int*)(F.lds + 0);
          if (F.tid == 0) { *prog = 0; *(prog + 16) = 0; }
          __syncthreads();
          if ((F.vcu & 1) == 0) { const int k = F.vcu >> 1; volatile LAS int* ydone = prog + 16; LAS unsigned char* ring = F.lds + 1024;
              if (F.wave == 0) rwkv::state_wave(k >> 2, k & 3, F.lane, (const bf16_t*)(ws + WS_MT), (const bf16_t*)(ws + WS_NT), ring, prog, ydone);
              else if (F.wave == 1) rwkv::out_wave(k >> 2, k & 3, F.lane, (const bf16_t*)(ws + WS_QC), (const bf16_t*)(ws + WS_Y0), (bf16_t*)(ws + WS_YS), ring, prog, ydone);
          }
          if (F.vcu & 1) {
              const int gwo = (F.vcu >> 1) * NWAVES + F.wave, NGWo = (F.G >> 1) * NWAVES; int cur = 0;
              convert_matrix(F, cur, INP(I0_WOUT), 1024, 1024, 1024, (bf16_t*)(ws + WS_W0OUT), 1024, 0, RmPlain{0}, gwo, NGWo);
              convert_matrix(F, cur, INP(I0_FFG), 1024, FF, FF, (bf16_t*)(ws + WS_W0GU), 1024, 0, RmGU{0}, gwo, NGWo);
              convert_matrix(F, cur, INP(I0_FFU), 1024, FF, FF, (bf16_t*)(ws + WS_W0GU), 1024, 0, RmGU{128}, gwo, NGWo);
              convert_matrix(F, cur, INP(I0_FFD), FF, 1024, 1024, (bf16_t*)(ws + WS_W0DN), FF, 0, RmPlain{0}, gwo, NGWo);
              convert_matrix(F, cur, INP(I1_WOUT), RET_VD, 1024, 1024, (bf16_t*)(ws + WS_W1OUT), RET_VD, 0, RmPlain{0}, gwo, NGWo);
              convert_matrix(F, cur, INP(I1_WIN), 1024, 1024, ODD_IN, (bf16_t*)(ws + WS_W1IN), 1024, 0, RmRope1{0}, gwo, NGWo);
              convert_matrix(F, cur, INP(I1_WIN) + 1024, 1024, 1024, ODD_IN, (bf16_t*)(ws + WS_W1IN), 1024, 0, RmRope1{1024}, gwo, NGWo);
              convert_matrix(F, cur, INP(I1_WIN) + 2048, 1024, 2048, ODD_IN, (bf16_t*)(ws + WS_W1IN), 1024, 0, RmPlain{2048}, gwo, NGWo);
              convert_matrix(F, cur, INP(I1_WIN) + 4096, 1024, 4096, ODD_IN, (bf16_t*)(ws + WS_W1IN), 1024, 0, RmGate1{}, gwo, NGWo); } }
    }
    SEAM(6);

    if (IN(7)) {
        const bf16_t* Y = (const bf16_t*)(ws + WS_YS); const bf16_t* RKV = (const bf16_t*)(ws + WS_RKV); const bf16_t* LRF = (const bf16_t*)(ws + WS_LRF); const bf16_t* GG = (const bf16_t*)(ws + WS_GG);
        const float* k_a = INP(I0_KA); const float* r_k = INP(I0_RK); const float* lnx_g = INP(I0_LNXG); const float* lnx_b = INP(I0_LNXB);
        const int ch0w = (4 * (gw & 1) + (F.lane >> 4)) * 64 + 4 * (F.lane & 15);
        const f32x4 lg = *(const f32x4*)(lnx_g + ch0w), lbv = *(const f32x4*)(lnx_b + ch0w), ka = *(const f32x4*)(k_a + ch0w), rk = *(const f32x4*)(r_k + ch0w);
        for (int it_ = gw; it_ < (MR / 4) * 2 * REPS(7); it_ += NGW) { const int it = it_ % ((MR / 4) * 2), hgp = it & 1, m0 = (it >> 1) * 4;
            const bool lat = m0 < NLAT; const int b = lat ? (m0 >> 13) : ((m0 - NLAT) >> 8), tp = lat ? (m0 & (SEQ - 1)) : ((m0 - NLAT) & (CTX - 1));
            const int pf = lat ? CTX + tp : tp, pb3 = lat ? CTX + (SEQ - 1 - (tp + 3)) : (CTX - 1 - (tp + 3));
            const int hg = F.lane >> 4, cl = F.lane & 15, h = 4 * hgp + hg, ch0 = h * 64 + 4 * cl, tf = pf & 31, tb = pb3 & 31;
            const size_t lo_ = (size_t)(cl >> 2) * 512 + 16 * (cl & 3);
            const bf16_t* yfp = Y + ((size_t)((0 * 2 + b) * 8 + h) * rwkv::NCH + (pf >> 5)) * 2048 + lo_ + (tf >> 4) * 256 + ((tf & 15) >> 2) * 64;
            const bf16_t* ybp = Y + ((size_t)((1 * 2 + b) * 8 + h) * rwkv::NCH + (pb3 >> 5)) * 2048 + lo_ + (tb >> 4) * 256 + ((tb & 15) >> 2) * 64;
            const u32x4 yf0 = *(const u32x4*)yfp, yf1 = *(const u32x4*)(yfp + 8), yb0 = *(const u32x4*)ybp, yb1 = *(const u32x4*)(ybp + 8);
            u32x2 rr[4], kk[4], vv[4], lf[4], lb[4], gg[4];
#pragma unroll
            for (int j = 0; j < 4; ++j) { const size_t m = (size_t)(m0 + j);
                rr[j] = *(const u32x2*)(RKV + m * 1536 + ch0); kk[j] = *(const u32x2*)(RKV + m * 1536 + 512 + ch0); vv[j] = *(const u32x2*)(RKV + m * 1536 + 1024 + ch0);
                lf[j] = *(const u32x2*)(LRF + m * 512 + ch0); lb[j] = *(const u32x2*)(LRF + (size_t)MR * 512 + m * 512 + ch0); gg[j] = *(const u32x2*)(GG + m * 512 + ch0); }
            const unsigned yfw[8] = {yf0.x, yf0.y, yf0.z, yf0.w, yf1.x, yf1.y, yf1.z, yf1.w}, ybw[8] = {yb0.x, yb0.y, yb0.z, yb0.w, yb1.x, yb1.y, yb1.z, yb1.w};
#pragma unroll
            for (int j = 0; j < 4; ++j) {
                float ys[4];
#pragma unroll
                for (int i = 0; i < 4; ++i) { const int ef = 4 * i + j, eb = 4 * i + 3 - j;
                    ys[i] = ((ef & 1) ? bfhi(yfw[ef >> 1]) : bflo(yfw[ef >> 1])) + ((eb & 1) ? bfhi(ybw[eb >> 1]) : bflo(ybw[eb >> 1])); }
                float s1 = (ys[0] + ys[1]) + (ys[2] + ys[3]);
#pragma unroll
                for (int o = 1; o < 16; o <<= 1) s1 += __shfl_xor(s1, o);
                const float mean = s1 * (1.f / 64.f); float dv[4], s2 = 0.f;
#pragma unroll
                for (int i = 0; i < 4; ++i) { dv[i] = ys[i] - mean; s2 += dv[i] * dv[i]; }
#pragma unroll
                for (int o = 1; o < 16; o <<= 1) s2 += __shfl_xor(s2, o);
                const float rstd = rsqrtf(s2 * (1.f / 64.f) + 64e-5f);
                const float r4[4] = {bflo(rr[j].x), bfhi(rr[j].x), bflo(rr[j].y), bfhi(rr[j].y)}, k4[4] = {bflo(kk[j].x), bfhi(kk[j].x), bflo(kk[j].y), bfhi(kk[j].y)};
                const float v4[4] = {bflo(vv[j].x), bfhi(vv[j].x), bflo(vv[j].y), bfhi(vv[j].y)}, f4[4] = {bflo(lf[j].x), bfhi(lf[j].x), bflo(lf[j].y), bfhi(lf[j].y)};
                const float b4[4] = {bflo(lb[j].x), bfhi(lb[j].x), bflo(lb[j].y), bfhi(lb[j].y)}, g4[4] = {bflo(gg[j].x), bfhi(gg[j].x), bflo(gg[j].y), bfhi(gg[j].y)};
                float bs = 0.f;
#pragma unroll
                for (int i = 0; i < 4; ++i) { const float ksum = k4[i] * (2.f + (f4[i] + b4[i] - 2.f) * ka[i]); bs += r4[i] * ksum * rk[i]; }
#pragma unroll
                for (int o = 1; o < 16; o <<= 1) bs += __shfl_xor(bs, o);
                float res[4];
#pragma unroll
                for (int i = 0; i < 4; ++i) res[i] = (dv[i] * rstd * lg[i] + lbv[i] + bs * v4[i]) * g4[i];
                u32x2 w; w.x = pk2(res[0], res[1]); w.y = pk2(res[2], res[3]);
                *(u32x2*)((bf16_t*)(ws + WS_MIX0) + (size_t)(m0 + j) * 1024 + 512 + ch0) = w; }
        }
    }
    SEAM(7);

    if (IN(8)) {
        { pg8::DenseOrder S; S.init((const bf16_t*)(ws + WS_MIX0), 1024, (const bf16_t*)(ws + WS_W0OUT), 1024, NLAT, 1024, 1024, F.G, (int)blockIdx.x); S.reps = REPS(8);
          pg8::EpiResGateB<false> E{(bf16_t*)(ws + WS_PRE), INP(I_X), mod0 + 2 * 1024, 1024, 0};
          pg8::gemm_phase<pg8::EpiResGateB<false>, pg8::DenseOrder, true, false>(F.lds, 1024, 1024, S, E); }
        { pg8::CtxSliceOrder S{(const bf16_t*)(ws + WS_MIX0) + (size_t)NLAT * 1024, (const bf16_t*)(ws + WS_W0OUT), 1024, 1024, 4, 4, F.G, (int)blockIdx.x, REPS(8)};
          pg8::EpiCtxPart E{(float*)(ws + WS_PART8), mod0 + 2 * 6144 + 2 * 1024};
          pg8::gemm_phase<pg8::EpiCtxPart, pg8::CtxSliceOrder, true, false>(F.lds, 1024, 1024, S, E); }
    }
    SEAM(8);

    if (IN(9)) {
        ModVec mv; mv.cls = -1; const Row4 lng = row_load(INP(I0_LN1G), F.lane), lnb = row_load(INP(I0_LN1B), F.lane);
        for (int m_ = gw; m_ < MR * REPS(9); m_ += NGW) { const int m = m_ % MR;
            const bool isctx = m >= NLAT;
            Row4 p = isctx ? row_load(INP(I_CTX) + (size_t)(m - NLAT) * 1024, F.lane) : row_load_bf16((const bf16_t*)(ws + WS_PRE) + (size_t)m * 1024, F.lane);
            if (isctx) ctx_fix(p, (const float*)(ws + WS_PART8) + (size_t)(m - NLAT) * 1024, 4, F.lane);
            const Row4 x1 = row_ln_v(p, lng, lnb);
            row_store_bf16((bf16_t*)(ws + WS_X1) + (size_t)m * 1024, F.lane, x1);
            modvec_get(mv, row_class(m), mod0, 3 * 1024, 4 * 1024, F.lane);
            row_store_bf16((bf16_t*)(ws + WS_XMOD) + (size_t)m * 1024, F.lane, row_mod_v(x1, mv));
        }
    }
    SEAM(9);

    if (IN(10)) {
        pg8::DenseOrder S; S.init((const bf16_t*)(ws + WS_XMOD), 1024, (const bf16_t*)(ws + WS_W0GU), 1024, MR, 2 * FF, 1024, F.G, (int)blockIdx.x); S.reps = REPS(10);
        pg8::EpiSwiGLU E{(bf16_t*)(ws + WS_HFF), FF};
        pg8::gemm_phase<pg8::EpiSwiGLU, pg8::DenseOrder, true, false>(F.lds, 1024, 1024, S, E);
    }
    SEAM(10);

    if (IN(11)) {
        { pg8::DenseOrder S; S.init((const bf16_t*)(ws + WS_HFF), FF, (const bf16_t*)(ws + WS_W0DN), FF, NLAT, 1024, FF, F.G, (int)blockIdx.x); S.reps = REPS(11);
          pg8::EpiResGateB<true> E{(bf16_t*)(ws + WS_PRE), (const bf16_t*)(ws + WS_X1), mod0 + 5 * 1024, 1024, 0};
          pg8::gemm_phase<pg8::EpiResGateB<true>, pg8::DenseOrder, true, false>(F.lds, FF, FF, S, E); }
        { pg8::CtxSliceOrder S{(const bf16_t*)(ws + WS_HFF) + (size_t)NLAT * FF, (const bf16_t*)(ws + WS_W0DN), FF, FF, 4, 11, F.G, (int)blockIdx.x, REPS(11)};
          pg8::EpiCtxPart E{(float*)(ws + WS_PART11), mod0 + 2 * 6144 + 5 * 1024};
          pg8::gemm_phase<pg8::EpiCtxPart, pg8::CtxSliceOrder, true, false>(F.lds, FF, FF, S, E); }
    }
    SEAM(11);

    if (IN(12)) {
        ModVec mv; mv.cls = -1; const Row4 lng = row_load(INP(I0_LN2G), F.lane), lnb = row_load(INP(I0_LN2B), F.lane);
        for (int m_ = gw; m_ < MR * REPS(12); m_ += NGW) { const int m = m_ % MR;
            const bool isctx = m >= NLAT;
            Row4 p = row_load_bf16((const bf16_t*)(ws + (isctx ? WS_X1 : WS_PRE)) + (size_t)m * 1024, F.lane);
            if (isctx) ctx_fix(p, (const float*)(ws + WS_PART11) + (size_t)(m - NLAT) * 1024, 11, F.lane);
            const Row4 x2 = row_ln_v(p, lng, lnb);
            if (m < NLAT) row_store_bf16((bf16_t*)F.out + (size_t)m * 1024, F.lane, x2);
            modvec_get(mv, row_class(m), mod1, 0, 1024, F.lane);
            row_store_bf16((bf16_t*)(ws + WS_XMOD1) + (size_t)m * 1024, F.lane, row_mod_v(x2, mv));
        }
    }
    SEAM(12);


    if (IN(13)) {
        { pg8::DenseOrder S; S.init((const bf16_t*)(ws + WS_XMOD1), 1024, (const bf16_t*)(ws + WS_W1IN), 1024, NLAT, 2048, 1024, F.G, (int)blockIdx.x); S.reps = REPS(13);
          pg8::EpiQK1 E{(bf16_t*)(ws + WS_Q1), (bf16_t*)(ws + WS_K1), (const f32x2*)(ws + WS_SMALL + SM_ROPE1)};
          pg8::gemm_phase<pg8::EpiQK1, pg8::DenseOrder, true, false>(F.lds, 1024, 1024, S, E); }
        { pg8::DenseOrder S; S.init((const bf16_t*)(ws + WS_W1IN) + (size_t)1024 * 1024, 1024, (const bf16_t*)(ws + WS_XMOD1), 1024, 3072, MR, 1024, F.G, (int)blockIdx.x); S.reps = REPS(13);
          pg8::EpiKVT E{(bf16_t*)(ws + WS_KDT), (bf16_t*)(ws + WS_VT1), (const f32x2*)(ws + WS_SMALL + SM_ROPE1), INP(I1_DECF), INP(I1_DECB)};
          pg8::gemm_phase<pg8::EpiKVT, pg8::DenseOrder, true, false>(F.lds, 1024, 1024, S, E); }
    }
    SEAM(13);

    if (IN(14)) {
#ifndef SKIP_SCORE
        { pg8::ScoreOrder S{(const bf16_t*)(ws + WS_Q1), (const bf16_t*)(ws + WS_K1), F.G, (int)blockIdx.x, REPS(14)};
          pg8::EpiScore E{(bf16_t*)(ws + WS_PFB), INP(I1_DECF), INP(I1_DECB)};
          pg8::gemm_phase<pg8::EpiScore, pg8::ScoreOrder, true, false>(F.lds, 1024, 1024, S, E); }
#endif
#ifndef SKIP_STATE
        { pg8::StateOrder S{(const bf16_t*)(ws + WS_VT1), (const bf16_t*)(ws + WS_KDT), F.G, F.vcu, REPS(14)};
          pg8::EpiBf16 E{(bf16_t*)(ws + WS_ST), 256};
          pg8::gemm_phase<pg8::EpiBf16, pg8::StateOrder, true, false>(F.lds, 256, 256, S, E); }
#endif
    }
    SEAM(14);

    if (IN(15)) {
        const int gt = gw * 64 + F.lane, NGT = NGW * 64; bf16_t* ST = (bf16_t*)(ws + WS_ST);
        for (int it = gt; it < 2 * 8 * 16384; it += NGT) { const int e8 = it & 16383, bh = (it >> 14) & 7, dir = it >> 17, h = bh & 3;
            const float g256 = exp2f(256.f * pg8::lg2gamma(dir ? INP(I1_DECB) : INP(I1_DECF), h));
            bf16_t* p = ST + ((size_t)dir * 8 * RCH + bh * RCH) * 131072 + (size_t)e8 * 8;
            float run[8]; { const u32x4 x = *(const u32x4*)p; run[0] = bflo(x.x); run[1] = bfhi(x.x); run[2] = bflo(x.y); run[3] = bfhi(x.y); run[4] = bflo(x.z); run[5] = bfhi(x.z); run[6] = bflo(x.w); run[7] = bfhi(x.w); }
#pragma unroll 1
            for (int g8 = 0; g8 < 4; ++g8) {
                u32x4 x[8];
#pragma unroll
                for (int q = 0; q < 8; ++q) { const int sl = dir ? RCH - 1 - (8 * g8 + q) : 1 + 8 * g8 + q; x[q] = *(const u32x4*)(p + (size_t)sl * 131072); }
#pragma unroll
                for (int q = 0; q < 8; ++q) { const int sl = dir ? RCH - 1 - (8 * g8 + q) : 1 + 8 * g8 + q;
                    const float kv[8] = {bflo(x[q].x), bfhi(x[q].x), bflo(x[q].y), bfhi(x[q].y), bflo(x[q].z), bfhi(x[q].z), bflo(x[q].w), bfhi(x[q].w)};
                    if (dir) { u32x4 w; w.x = pk2(run[0], run[1]); w.y = pk2(run[2], run[3]); w.z = pk2(run[4], run[5]); w.w = pk2(run[6], run[7]); *(u32x4*)(p + (size_t)sl * 131072) = w; }
#pragma unroll
                    for (int j = 0; j < 8; ++j) run[j] = run[j] * g256 + kv[j];
                    if (!dir) { u32x4 w; w.x = pk2(run[0], run[1]); w.y = pk2(run[2], run[3]); w.z = pk2(run[4], run[5]); w.w = pk2(run[6], run[7]); *(u32x4*)(p + (size_t)sl * 131072) = w; } } }
        }
    }
    SEAM(15);

    if (IN(16)) {
        pg8::OutOrder S{(const bf16_t*)(ws + WS_PFB), (const bf16_t*)(ws + WS_Q1), (const bf16_t*)(ws + WS_VT1), (const bf16_t*)(ws + WS_ST), F.G, F.vcu, REPS(16)};
        pg8::EpiRetOut E{(bf16_t*)(ws + WS_OF), (bf16_t*)(ws + WS_OB), INP(I1_DECF), INP(I1_DECB), (float*)(ws + WS_GNP)};
        pg8::gemm_phase<pg8::EpiRetOut, pg8::OutOrder, true, false>(F.lds, 1024, 256, S, E);
    }
    SEAM(16);

    if (IN(17)) {
        const int gt = gw * 64 + F.lane, NGT = NGW * 64; const f32x4* gp = (const f32x4*)(ws + WS_GNP); f32x2* st = (f32x2*)(ws + WS_GNS);
        for (int i = gt; i < NLAT * 8; i += NGT) { float s1 = 0.f, s2 = 0.f;
#pragma unroll
            for (int q = 0; q < 4; ++q) { const f32x4 v = gp[(size_t)i * 4 + q]; s1 += v.x + v.z; s2 += v.y + v.w; }
            const float mean = s1 * (1.f / 512.f); st[i] = (f32x2){mean, rsqrtf(fmaxf(s2 * (1.f / 512.f) - mean * mean, 0.f) + 1e-6f)}; }
    }
    SEAM(17);

    if (IN(18)) {
        pg8::DenseOrder S; S.init((const bf16_t*)(ws + WS_XMOD1), 1024, (const bf16_t*)(ws + WS_W1IN) + (size_t)4096 * 1024, 1024, NLAT, 4096, 1024, F.G, (int)blockIdx.x); S.reps = REPS(18);
        pg8::EpiGate1 E{(bf16_t*)(ws + WS_MIX1), (const bf16_t*)(ws + WS_OF), (const bf16_t*)(ws + WS_OB), (const f32x2*)(ws + WS_GNS)};
        pg8::gemm_phase<pg8::EpiGate1, pg8::DenseOrder, true, false>(F.lds, 1024, 1024, S, E);
    }
    SEAM(18);

    if (IN(19)) {
        pg8::DenseOrder S; S.init((const bf16_t*)(ws + WS_MIX1), RET_VD, (const bf16_t*)(ws + WS_W1OUT), RET_VD, NLAT, 1024, RET_VD, F.G, (int)blockIdx.x); S.reps = REPS(19);
        pg8::EpiResGateB<true> E{(bf16_t*)(ws + WS_OF), (const bf16_t*)F.out, mod1 + 2 * 1024, 1024, 0};
        pg8::gemm_phase<pg8::EpiResGateB<true>, pg8::DenseOrder, true, false>(F.lds, RET_VD, RET_VD, S, E);
    }
    SEAM(19);

    if (IN(20)) {
        const float* router = INP(I1_ROUTER);
        int* tok_e = (int*)(ws + WS_SMALL + SM_TOKE); float* tok_g = (float*)(ws + WS_SMALL + SM_TOKG); int* tok_p = (int*)(ws + WS_SMALL + SM_TOKP);
        LAS unsigned* lcnt = (LAS unsigned*)(F.lds + 64); LAS unsigned* lbase = lcnt + 8;
        if (F.tid < 8) lcnt[F.tid] = 0u;
        __syncthreads();
        f32x4 rt[16][2];
#pragma unroll
        for (int j = 0; j < 4; ++j)
#pragma unroll
            for (int q = 0; q < 4; ++q) { const int k = 4 * F.lane + 256 * j + q; rt[4 * j + q][0] = *(const f32x4*)(router + (size_t)k * 8); rt[4 * j + q][1] = *(const f32x4*)(router + (size_t)k * 8 + 4); }
        ModVec mv; mv.cls = -1; const Row4 lng = row_load(INP(I1_LN1G), F.lane), lnb = row_load(INP(I1_LN1B), F.lane);
        for (int m = gw; m < NLAT; m += NGW) {
            const Row4 p = row_load_bf16((const bf16_t*)(ws + WS_OF) + (size_t)m * 1024, F.lane);
            const Row4 x3 = row_ln_v(p, lng, lnb);
            row_store_bf16((bf16_t*)(ws + WS_X3) + (size_t)m * 1024, F.lane, x3);
            modvec_get(mv, row_class(m), mod1, 3 * 1024, 4 * 1024, F.lane);
            const Row4 h = row_mod_v(x3, mv);
            row_store_bf16((bf16_t*)(ws + WS_HMOE) + (size_t)m * 1024, F.lane, h);
            float lg[8] = {0.f, 0.f, 0.f, 0.f, 0.f, 0.f, 0.f, 0.f};
#pragma unroll
            for (int j = 0; j < 4; ++j)
#pragma unroll
                for (int q = 0; q < 4; ++q) { const f32x4 r0 = rt[4 * j + q][0], r1 = rt[4 * j + q][1]; const float hv = h.v[j][q];
                    lg[0] += hv * r0.x; lg[1] += hv * r0.y; lg[2] += hv * r0.z; lg[3] += hv * r0.w; lg[4] += hv * r1.x; lg[5] += hv * r1.y; lg[6] += hv * r1.z; lg[7] += hv * r1.w; }
#pragma unroll
            for (int e = 0; e < 8; ++e) lg[e] = wave_sum(lg[e]);
            int e0 = 0; float v0 = lg[0];
#pragma unroll
            for (int e = 1; e < 8; ++e) if (lg[e] > v0) { v0 = lg[e]; e0 = e; }
            int e1 = -1; float v1 = -3.0e38f;
#pragma unroll
            for (int e = 0; e < 8; ++e) if (e != e0 && lg[e] > v1) { v1 = lg[e]; e1 = e; }
            const float g0 = 1.f / (1.f + __expf(v1 - v0));
            if (F.lane == 0) {
                const int p0 = (int)__hip_atomic_fetch_add(lcnt + e0, 1u, __ATOMIC_RELAXED, __HIP_MEMORY_SCOPE_WORKGROUP), p1 = (int)__hip_atomic_fetch_add(lcnt + e1, 1u, __ATOMIC_RELAXED, __HIP_MEMORY_SCOPE_WORKGROUP);
                tok_e[2 * m] = e0; tok_e[2 * m + 1] = e1; tok_g[2 * m] = g0; tok_g[2 * m + 1] = 1.f - g0; tok_p[2 * m] = p0; tok_p[2 * m + 1] = p1; }
        }
        __syncthreads();
        if (F.tid < 8) lbase[F.tid] = atomicAdd(F.ctl + CW_MOECNT + 64 * F.tid, lcnt[F.tid]);
        __syncthreads();
        for (int m = gw; m < NLAT; m += NGW) { if (F.lane < 2) { const int i = 2 * m + F.lane; tok_p[i] += (int)lbase[tok_e[i]]; } }
        __syncthreads();
        int cur = 0;
        for (int e_ = 0; e_ < 8 * REPS(20); ++e_) { const int e = e_ & 7;
            convert_matrix(F, cur, INP(I1_MOEG) + (size_t)e * 1024 * DFE, 1024, DFE, DFE, (bf16_t*)(ws + WS_MOEGU) + (size_t)e * 2 * DFE * 1024, 1024, 0, RmGU{0});
            convert_matrix(F, cur, INP(I1_MOEU) + (size_t)e * 1024 * DFE, 1024, DFE, DFE, (bf16_t*)(ws + WS_MOEGU) + (size_t)e * 2 * DFE * 1024, 1024, 0, RmGU{128});
            convert_matrix(F, cur, INP(I1_MOED) + (size_t)e * DFE * 1024, DFE, 1024, 1024, (bf16_t*)(ws + WS_MOEDN) + (size_t)e * 1024 * DFE, DFE, 0, RmPlain{0});
        }
    }
    SEAM(20);

    if (IN(21)) {
        int* tok_e = (int*)(ws + WS_SMALL + SM_TOKE); int* tok_p = (int*)(ws + WS_SMALL + SM_TOKP); int* slot_tok = (int*)(ws + WS_SMALL + SM_SLOT);
        int pst[8], cn[8]; { int bs = 0;
#pragma unroll
            for (int e = 0; e < 8; ++e) { cn[e] = (int)__hip_atomic_load(F.ctl + CW_MOECNT + 64 * e, RLX_AGENT); pst[e] = bs; bs += ((cn[e] + 255) >> 8) << 8; } }
        const int gt = gw * 64 + F.lane, NGT = NGW * 64;
        for (int i = gt; i < 2 * NLAT; i += NGT) { const int e = tok_e[i]; int ps = 0;
#pragma unroll
            for (int j = 0; j < 8; ++j) ps = (e == j) ? pst[j] : ps;
            const int slot = ps + tok_p[i]; ((int*)(ws + WS_SMALL + SM_TOKS))[i] = slot; slot_tok[slot] = i >> 1; }
        if (gt < 8 * 256) { const int e = gt >> 8, j = gt & 255; int ps = 0, c = 0;
#pragma unroll
            for (int q = 0; q < 8; ++q) { ps = (e == q) ? pst[q] : ps; c = (e == q) ? cn[q] : c; }
            if (c + j < (((c + 255) >> 8) << 8)) slot_tok[ps + c + j] = 0; }
    }
    SEAM(21);

#define MOE_HALF_PHASES(PHGU, PHDN, B0_, B1_) \
    if (IN(PHGU)) { pg8::MoeOrder S; S.A = (const char*)(ws + WS_HMOE); S.W = (const char*)(ws + WS_MOEGU); S.slot_tok = (const int*)(ws + WS_SMALL + SM_SLOT); S.wstride = (size_t)2 * DFE * 1024 * 2; \
        S.lda = 1024; S.ldb = 1024; S.K = 1024; S.npn = 2 * DFE / 256; S.G = F.G; S.c = (F.G == 256) ? 16 * (4 * ((F.vcu >> 5) >> 1) + ((F.vcu & 31) >> 3)) + 8 * ((F.vcu >> 5) & 1) + (F.vcu & 7) : F.vcu; S.gather = true;     S.reps = REPS(PHGU); S.init(F.ctl + CW_MOECNT, B0_, B1_); \
        pg8::EpiSwiGLU E{(bf16_t*)(ws + WS_HMID), DFE}; \
        pg8::gemm_phase<pg8::EpiSwiGLU, pg8::MoeOrder, true, true>(F.lds, 1024, 1024, S, E); } \
    SEAM(PHGU); \
    if (IN(PHDN)) { pg8::MoeOrder S; S.A = (const char*)(ws + WS_HMID); S.W = (const char*)(ws + WS_MOEDN); S.slot_tok = (const int*)(ws + WS_SMALL + SM_SLOT); S.wstride = (size_t)1024 * DFE * 2; \
        S.lda = DFE; S.ldb = DFE; S.K = DFE; S.npn = 4; S.G = F.G; S.c = (int)blockIdx.x; S.gather = false; S.reps = REPS(PHDN); S.ksplit = 2; S.init(F.ctl + CW_MOECNT, B0_, B1_); \
        pg8::EpiBf16Sel E{(bf16_t*)(ws + WS_YB), 1024, ((long)WS_YB2 - (long)WS_YB) / 2}; \
        pg8::gemm_phase<pg8::EpiBf16Sel, pg8::MoeOrder, true, false>(F.lds, DFE, DFE, S, E); } \
    SEAM(PHDN);
    MOE_HALF_PHASES(22, 23, 0, MOE_MAXBLK)
#undef MOE_HALF_PHASES

    if (IN(26)) {
        const float* tok_g = (const float*)(ws + WS_SMALL + SM_TOKG); const int* tok_s = (const int*)(ws + WS_SMALL + SM_TOKS); const bf16_t* YB = (const bf16_t*)(ws + WS_YB);
        const Row4 lng = row_load(INP(I1_LN2G), F.lane), lnb = row_load(INP(I1_LN2B), F.lane);
        Row4 gate; int gcls = -1;
        for (int m = gw; m < NLAT; m += NGW) {
            if (row_class(m) != gcls) { gcls = row_class(m); gate = row_load(mod1 + (size_t)gcls * 6144 + 5 * 1024, F.lane); }
            const Row4 x3 = row_load_bf16((const bf16_t*)(ws + WS_X3) + (size_t)m * 1024, F.lane);
            const float g0 = tok_g[2 * m], g1 = tok_g[2 * m + 1]; const int s0 = tok_s[2 * m], s1 = tok_s[2 * m + 1];
            const u32x2* y0 = (const u32x2*)(YB + (size_t)s0 * 1024) + F.lane; const u32x2* y1 = (const u32x2*)(YB + (size_t)s1 * 1024) + F.lane;
            const u32x2* z0 = (const u32x2*)((const bf16_t*)(ws + WS_YB2) + (size_t)s0 * 1024) + F.lane; const u32x2* z1 = (const u32x2*)((const bf16_t*)(ws + WS_YB2) + (size_t)s1 * 1024) + F.lane;
            Row4 q;
#pragma unroll
            for (int j = 0; j < 4; ++j) { const u32x2 a = y0[64 * j], b = y1[64 * j], a2 = z0[64 * j], b2 = z1[64 * j];
                const f32x4 y = ((f32x4){bflo(a.x), bfhi(a.x), bflo(a.y), bfhi(a.y)} + (f32x4){bflo(a2.x), bfhi(a2.x), bflo(a2.y), bfhi(a2.y)}) * g0
                              + ((f32x4){bflo(b.x), bfhi(b.x), bflo(b.y), bfhi(b.y)} + (f32x4){bflo(b2.x), bfhi(b2.x), bflo(b2.y), bfhi(b2.y)}) * g1;
                q.v[j] = x3.v[j] * ALPHA + gate.v[j] * y; }
            row_store(F.out + (size_t)m * 1024, F.lane, row_ln_v(q, lng, lnb));
        }
    }
    if (DBL_PH == 28) { for (int i_ = 0; i_ < 20; ++i_) xcd_barrier(bar); }
#undef IN
#undef INP
#undef SEAM
}

extern "C" void kernel_launch(void* const* d_in, const int* in_sizes, int n_in, void* d_out, int out_size, void* d_ws, size_t ws_size, hipStream_t stream) {
    static int grid = 0;
    if (grid == 0) {
        if (n_in != N_IN || out_size != NLAT * DM || ws_size < WS_END) { fprintf(stderr, "kernel_launch: unexpected shapes: n_in %d out %d ws %zu (need %zu)\n", n_in, out_size, ws_size, (size_t)WS_END); }
        int dev = 0, cus = 0, per_cu = 0;
        hipGetDevice(&dev); hipDeviceGetAttribute(&cus, hipDeviceAttributeMultiprocessorCount, dev);
        hipFuncSetAttribute((const void*)mk_fwd, hipFuncAttributeMaxDynamicSharedMemorySize, LDS_BYTES);
        hipOccupancyMaxActiveBlocksPerMultiprocessor(&per_cu, (const void*)mk_fwd, NWAVES * 64, LDS_BYTES);
        (void)hipGetLastError();
        grid = cus > 0 ? cus : 256;
        if (per_cu < 1) fprintf(stderr, "kernel_launch: occupancy query reports %d\n", per_cu);
    }
    hipMemsetAsync((char*)d_ws + WS_CTL, 0, CTL_BYTES, stream);
    Args a{};
    for (int i = 0; i < N_IN; ++i) a.in[i] = (const float*)d_in[i];
    a.out = (float*)d_out; a.ws = (unsigned char*)d_ws; a.ph_lo = 0; a.ph_hi = N_PHASES;
    hipLaunchKernelGGL(mk_fwd, dim3(grid), dim3(NWAVES * 64), LDS_BYTES, stream, a);
}
```
